# Optimizing an MI355X kernel written in HIP

```python
import jax, jax.numpy as jnp
from jax import lax
import numpy as np

D_MODEL = 2048
BATCH = 4
SEQ = 4096
DEPTH = 4

N_META = 16
NORM_EPS = 1e-6
ROPE_BASE = 10000.0

RW_HEADS = 16
RW_HEAD_DIM = 64
RW_WIDTH = RW_HEADS * RW_HEAD_DIM
RW_DECAY_LORA = 96
RW_A_LORA = 96
RW_GATE_LORA = 256
RW_COLS = 3 * RW_WIDTH + RW_DECAY_LORA + RW_A_LORA + RW_GATE_LORA
RW_GN_EPS = RW_HEAD_DIM * 1e-5

RET_HEADS = 8
RET_HEAD_DIM = 128
RET_WIDTH = RET_HEADS * RET_HEAD_DIM
RET_CHUNK = 128
RET_COLS = 4 * RET_WIDTH

MLA_HEADS = 8
MLA_NOPE = 128
MLA_ROPE = 64
MLA_V = 128
MLA_Q_RANK = 512
MLA_KV_RANK = 256
MLA_WIDTH = MLA_HEADS * MLA_V
MLA_COLS = MLA_Q_RANK + MLA_KV_RANK + MLA_ROPE
ATTN_BLOCK = 128

N_BRANCH = 3
GATE_COLS = N_BRANCH * D_MODEL
IN_COLS = RW_COLS + RET_COLS + MLA_COLS + GATE_COLS

FFN_HIDDEN = -(-8 * D_MODEL // (3 * 256)) * 256

kernel_name = 'hybrid_rwkv7_retention_mla_trunk'

F32 = jnp.float32


def split_last(x, sizes):
    idx, acc = [], 0
    for s in sizes[:-1]:
        acc += s
        idx.append(acc)
    return jnp.split(x, idx, axis=-1)


def rms_norm(x, g, eps=NORM_EPS):
    xf = x.astype(F32)
    y = xf * lax.rsqrt(jnp.mean(xf * xf, axis=-1, keepdims=True) + eps)
    return (y * g.astype(F32)).astype(x.dtype)


def rope_tables(positions, dim):
    inv = ROPE_BASE ** (-jnp.arange(0, dim, 2, dtype=F32) / dim)
    ang = positions.astype(F32)[:, None] * inv[None, :]
    return jnp.cos(ang), jnp.sin(ang)


def apply_rope(x, cos, sin):
    xf = x.astype(F32)
    half = x.shape[-1] // 2
    x1, x2 = xf[..., :half], xf[..., half:]
    return jnp.concatenate([x1 * cos - x2 * sin, x2 * cos + x1 * sin], axis=-1).astype(x.dtype)


def rwkv7_mix(z, mu, w0, w_up, a0, a_up, g_up, k_k, k_a, r_k, ln_w, ln_b):
    B, L, _ = z.shape
    H, N = RW_HEADS, RW_HEAD_DIM
    z_prev = jnp.pad(z, ((0, 0), (1, 0), (0, 0)))[:, :-1]
    z = z + (z_prev - z) * mu
    r, k, v, wd, ad, gd = split_last(z, [RW_WIDTH, RW_WIDTH, RW_WIDTH, RW_DECAY_LORA, RW_A_LORA, RW_GATE_LORA])
    w_log = -jax.nn.softplus(-(w0 + jnp.tanh(wd) @ w_up).astype(F32)) - 0.5
    decay = jnp.exp(-jnp.exp(w_log))
    a = jax.nn.sigmoid(a0 + ad @ a_up)
    g = jax.nn.sigmoid(gd) @ g_up
    kk = (k * k_k).astype(F32).reshape(B, L, H, N)
    kk = kk / jnp.maximum(jnp.sqrt(jnp.sum(kk * kk, axis=-1, keepdims=True)), 1e-12)
    k = k * (1.0 + (a - 1.0) * k_a)

    def heads_t(t):
        return jnp.moveaxis(t.astype(F32).reshape(B, L, H, N), 1, 0)

    xs = (heads_t(r), heads_t(decay), heads_t(k), heads_t(v), jnp.moveaxis(kk, 1, 0), heads_t(a))

    def step(S, inp):
        r_t, w_t, k_t, v_t, kk_t, a_t = inp
        s_kk = jnp.einsum('bhvk,bhk->bhv', S, kk_t)
        S = (S * w_t[:, :, None, :] - s_kk[..., None] * (kk_t * a_t)[:, :, None, :]
             + v_t[..., None] * k_t[:, :, None, :])
        return S, jnp.einsum('bhvk,bhk->bhv', S, r_t)

    S0 = jnp.zeros((B, H, N, N), F32)
    _, y = lax.scan(step, S0, xs)
    y = jnp.moveaxis(y, 0, 1)
    mean = jnp.mean(y, axis=-1, keepdims=True)
    var = jnp.mean(jnp.square(y - mean), axis=-1, keepdims=True)
    y = (y - mean) * lax.rsqrt(var + RW_GN_EPS)
    y = y * ln_w.astype(F32).reshape(H, N) + ln_b.astype(F32).reshape(H, N)
    rh = r.astype(F32).reshape(B, L, H, N)
    kh = k.astype(F32).reshape(B, L, H, N)
    vh = v.astype(F32).reshape(B, L, H, N)
    bonus = jnp.sum(rh * kh * r_k.astype(F32).reshape(H, N), axis=-1, keepdims=True) * vh
    y = (y + bonus).reshape(B, L, RW_WIDTH).astype(z.dtype)
    return y * g


def _ret_chunk(R, q, k, v, log_gamma):
    C = q.shape[1]
    idx = jnp.arange(C, dtype=F32)
    diff = idx[:, None] - idx[None, :]
    causal = diff >= 0
    dmat = jnp.where(causal[None], jnp.exp(log_gamma[:, None, None] * jnp.maximum(diff, 0.0)[None]), 0.0)
    s = jnp.einsum('bihd,bjhd->bhij', q, k) * dmat[None]
    o = jnp.einsum('bhij,bjhe->bihe', s, v)
    cross_decay = jnp.exp(log_gamma[None, :] * (idx[:, None] + 1.0))
    o = o + jnp.einsum('bihd,bhde->bihe', q, R) * cross_decay[None, :, :, None]
    k_decay = jnp.exp(log_gamma[None, :] * (C - 1.0 - idx)[:, None])
    R = (R * jnp.exp(log_gamma * C)[None, :, None, None]
         + jnp.einsum('bjhd,bjhe->bhde', k * k_decay[None, :, :, None], v))
    return R, o


def retention_mix(z, cos, sin):
    B, L, _ = z.shape
    H, d = RET_HEADS, RET_HEAD_DIM
    q, k, v, g = split_last(z, [RET_WIDTH] * 4)
    q = apply_rope(q.reshape(B, L, H, d), cos, sin).astype(F32)
    k = apply_rope(k.reshape(B, L, H, d), cos, sin).astype(F32) * (d ** -0.5)
    v = v.reshape(B, L, H, d).astype(F32)
    log_gamma = jnp.log1p(-jnp.exp2(-5.0 - jnp.arange(H, dtype=F32)))
    R0 = jnp.zeros((B, H, d, d), F32)
    R, o_meta = _ret_chunk(R0, q[:, :N_META], k[:, :N_META], v[:, :N_META], log_gamma)
    n_chunks = (L - N_META) // RET_CHUNK

    def chunks(t):
        return jnp.moveaxis(t[:, N_META:].reshape(B, n_chunks, RET_CHUNK, H, d), 1, 0)

    _, o_real = lax.scan(lambda c, xs: _ret_chunk(c, xs[0], xs[1], xs[2], log_gamma), R,
                         (chunks(q), chunks(k), chunks(v)))
    o_real = jnp.moveaxis(o_real, 0, 1).reshape(B, L - N_META, H, d)
    o = jnp.concatenate([o_meta, o_real], axis=1)
    o = o * lax.rsqrt(jnp.mean(o * o, axis=-1, keepdims=True) + NORM_EPS)
    o = o.reshape(B, L, RET_WIDTH).astype(z.dtype)
    return jax.nn.silu(g) * o


def _attend(qb, k, v, q_pos, scale):
    s = jnp.einsum('bqhd,bkhd->bhqk', qb, k).astype(F32) * scale
    mask = jnp.arange(k.shape[1])[None, :] <= q_pos[:, None]
    s = jnp.where(mask[None, None], s, -jnp.inf)
    p = jax.nn.softmax(s, axis=-1).astype(v.dtype)
    return jnp.einsum('bhqk,bkhd->bqhd', p, v)


def mla_mix(qd, kvd, krd, norm_q, norm_kv, w_uq, w_ukv, cos, sin):
    B, L, _ = qd.shape
    H = MLA_HEADS
    q = (rms_norm(qd, norm_q) @ w_uq).reshape(B, L, H, MLA_NOPE + MLA_ROPE)
    q = jnp.concatenate([q[..., :MLA_NOPE], apply_rope(q[..., MLA_NOPE:], cos[:, None], sin[:, None])], axis=-1)
    kv = (rms_norm(kvd, norm_kv) @ w_ukv).reshape(B, L, H, MLA_NOPE + MLA_V)
    k_nope, v = kv[..., :MLA_NOPE], kv[..., MLA_NOPE:]
    k_rope = apply_rope(krd, cos, sin)
    k = jnp.concatenate([k_nope, jnp.broadcast_to(k_rope[:, :, None, :], (B, L, H, MLA_ROPE))], axis=-1)
    scale = (MLA_NOPE + MLA_ROPE) ** -0.5
    o_meta = _attend(q[:, :N_META], k[:, :N_META], v[:, :N_META], jnp.arange(N_META), scale)
    n_blocks = (L - N_META) // ATTN_BLOCK
    q_blocks = jnp.moveaxis(q[:, N_META:].reshape(B, n_blocks, ATTN_BLOCK, H, MLA_NOPE + MLA_ROPE), 1, 0)
    o_real = lax.map(lambda a: _attend(a[0], k, v, N_META + a[1] * ATTN_BLOCK + jnp.arange(ATTN_BLOCK), scale),
                     (q_blocks, jnp.arange(n_blocks)))
    o_real = jnp.moveaxis(o_real, 0, 1).reshape(B, L - N_META, H, MLA_V)
    return jnp.concatenate([o_meta, o_real], axis=1).reshape(B, L, MLA_WIDTH)


def hybrid_layer(h, cos_ret, sin_ret, cos_mla, sin_mla, norm_mix, w_in, rw_mu, rw_w0, rw_w_up, rw_a0,
                 rw_a_up, rw_g_up, rw_k_k, rw_k_a, rw_r_k, rw_ln_w, rw_ln_b, mla_norm_q, mla_norm_kv,
                 mla_w_uq, mla_w_ukv, w_br_rwkv, w_br_ret, w_br_mla, w_out, norm_ffn, w_gate_up, w_down):
    u = rms_norm(h, norm_mix)
    p = u @ w_in
    z_rw, z_ret, qd, kvd, krd, gates = split_last(p, [RW_COLS, RET_COLS, MLA_Q_RANK, MLA_KV_RANK, MLA_ROPE, GATE_COLS])
    y_a = rwkv7_mix(z_rw, rw_mu, rw_w0, rw_w_up, rw_a0, rw_a_up, rw_g_up, rw_k_k, rw_k_a, rw_r_k, rw_ln_w, rw_ln_b)
    y_b = retention_mix(z_ret, cos_ret, sin_ret)
    y_c = mla_mix(qd, kvd, krd, mla_norm_q, mla_norm_kv, mla_w_uq, mla_w_ukv, cos_mla, sin_mla)
    g_a, g_b, g_c = jnp.split(jax.nn.sigmoid(gates), N_BRANCH, axis=-1)
    merged = g_a * (y_a @ w_br_rwkv) + g_b * (y_b @ w_br_ret) + g_c * (y_c @ w_br_mla)
    h = h + merged @ w_out
    u = rms_norm(h, norm_ffn)
    hg, hu = jnp.split(u @ w_gate_up, 2, axis=-1)
    return h + (jax.nn.silu(hg) * hu) @ w_down


def setup_inputs(seed: int = 0) -> dict:
    key = jax.random.key(seed)
    ks = iter(jax.random.split(key, 40))

    def nrm(shape, scale):
        return jax.random.normal(next(ks), shape, F32) * scale

    def gain(shape):
        return 1.0 + nrm(shape, 0.02)

    L_ = DEPTH
    return {
        'x': nrm((BATCH, SEQ, D_MODEL), 1.0),
        'meta_tokens': nrm((N_META, D_MODEL), 1.0),
        'norm_mix': gain((L_, D_MODEL)),
        'w_in': nrm((L_, D_MODEL, IN_COLS), D_MODEL ** -0.5),
        'rw_mu': jax.random.uniform(next(ks), (L_, RW_COLS), F32),
        'rw_w0': jax.random.uniform(next(ks), (L_, RW_WIDTH), F32, minval=-6.0, maxval=1.0),
        'rw_w_up': nrm((L_, RW_DECAY_LORA, RW_WIDTH), RW_DECAY_LORA ** -0.5),
        'rw_a0': nrm((L_, RW_WIDTH), 0.1),
        'rw_a_up': nrm((L_, RW_A_LORA, RW_WIDTH), RW_A_LORA ** -0.5),
        'rw_g_up': nrm((L_, RW_GATE_LORA, RW_WIDTH), RW_GATE_LORA ** -0.5),
        'rw_k_k': 0.85 + nrm((L_, RW_WIDTH), 0.02),
        'rw_k_a': 1.0 + nrm((L_, RW_WIDTH), 0.02),
        'rw_r_k': nrm((L_, RW_WIDTH), 0.1),
        'rw_ln_w': gain((L_, RW_WIDTH)),
        'rw_ln_b': nrm((L_, RW_WIDTH), 0.02),
        'mla_norm_q': gain((L_, MLA_Q_RANK)),
        'mla_norm_kv': gain((L_, MLA_KV_RANK)),
        'mla_w_uq': nrm((L_, MLA_Q_RANK, MLA_HEADS * (MLA_NOPE + MLA_ROPE)), MLA_Q_RANK ** -0.5),
        'mla_w_ukv': nrm((L_, MLA_KV_RANK, MLA_HEADS * (MLA_NOPE + MLA_V)), MLA_KV_RANK ** -0.5),
        'w_br_rwkv': nrm((L_, RW_WIDTH, D_MODEL), RW_WIDTH ** -0.5),
        'w_br_ret': nrm((L_, RET_WIDTH, D_MODEL), RET_WIDTH ** -0.5),
        'w_br_mla': nrm((L_, MLA_WIDTH, D_MODEL), MLA_WIDTH ** -0.5),
        'w_out': nrm((L_, D_MODEL, D_MODEL), D_MODEL ** -0.5),
        'norm_ffn': gain((L_, D_MODEL)),
        'w_gate_up': nrm((L_, D_MODEL, 2 * FFN_HIDDEN), D_MODEL ** -0.5),
        'w_down': nrm((L_, FFN_HIDDEN, D_MODEL), FFN_HIDDEN ** -0.5),
        'final_norm': gain((D_MODEL,)),
    }


def reference(x, meta_tokens, norm_mix, w_in, rw_mu, rw_w0, rw_w_up, rw_a0, rw_a_up, rw_g_up, rw_k_k,
              rw_k_a, rw_r_k, rw_ln_w, rw_ln_b, mla_norm_q, mla_norm_kv, mla_w_uq, mla_w_ukv, w_br_rwkv,
              w_br_ret, w_br_mla, w_out, norm_ffn, w_gate_up, w_down, final_norm):
    B = x.shape[0]
    meta = jnp.broadcast_to(meta_tokens[None].astype(x.dtype), (B, N_META, x.shape[-1]))
    h = jnp.concatenate([meta, x], axis=1)
    pos = jnp.arange(h.shape[1])
    cos_ret, sin_ret = rope_tables(pos, RET_HEAD_DIM)
    cos_ret, sin_ret = cos_ret[:, None, :], sin_ret[:, None, :]
    cos_mla, sin_mla = rope_tables(pos, MLA_ROPE)
    for l in range(DEPTH):
        h = hybrid_layer(h, cos_ret, sin_ret, cos_mla, sin_mla, norm_mix[l], w_in[l], rw_mu[l], rw_w0[l],
                         rw_w_up[l], rw_a0[l], rw_a_up[l], rw_g_up[l], rw_k_k[l], rw_k_a[l], rw_r_k[l],
                         rw_ln_w[l], rw_ln_b[l], mla_norm_q[l], mla_norm_kv[l], mla_w_uq[l], mla_w_ukv[l],
                         w_br_rwkv[l], w_br_ret[l], w_br_mla[l], w_out[l], norm_ffn[l], w_gate_up[l], w_down[l])
    return rms_norm(h[:, N_META:], final_norm)
```

```cpp
#include <hip/hip_runtime.h>
#include <cstdio>
#include <cstdint>

#define LAS __attribute__((address_space(3)))
#define GAS __attribute__((address_space(1)))
typedef unsigned short bf16_t;
typedef short bf16x8 __attribute__((ext_vector_type(8)));
typedef float f32x4 __attribute__((ext_vector_type(4)));
typedef float f32x2 __attribute__((ext_vector_type(2)));
typedef float f32x16 __attribute__((ext_vector_type(16)));
typedef unsigned u32x4 __attribute__((ext_vector_type(4)));
typedef unsigned u32x2 __attribute__((ext_vector_type(2)));

constexpr int DM = 2048, NB = 4, SEQ = 4096, NMETA = 16, LSEQ = 4112, M = NB * LSEQ  , MP = 16640  , DEPTH = 4;
constexpr int RWW = 1024, RW_COLS = 3520, IN_COLS = 14592, PN = 13568  ;
constexpr int P_QRET = 3520, P_KRET = 4544, P_GRET = 5568, P_QD = 6592, P_KVD = 7104, P_KRD = 7360, P_GATES = 7424;
constexpr int FFN = 5632, LORA_K = 512, LORA_N = 3072;
constexpr float NORM_EPS = 1e-6f, GN_EPS = 64.0f * 1e-5f;

constexpr size_t MiB = 1u << 20;
constexpr size_t al(size_t x) { return (x + MiB - 1) / MiB * MiB; }
constexpr size_t WS_CTL = 0, CTL_BYTES = 2 * MiB;
constexpr size_t WS_WIN = WS_CTL + CTL_BYTES;
constexpr size_t WS_WVRET = WS_WIN + al((size_t)PN * DM * 2);
constexpr size_t WS_WLORA = WS_WVRET + al((size_t)1024 * DM * 2);
constexpr size_t WS_WUQ = WS_WLORA + al((size_t)LORA_N * LORA_K * 2);
constexpr size_t WS_WUK = WS_WUQ + al((size_t)1536 * 512 * 2);
constexpr size_t WS_WUV = WS_WUK + al((size_t)1024 * 256 * 2);
constexpr size_t WS_WBR = WS_WUV + al((size_t)1024 * 256 * 2);
constexpr size_t WS_WOUT = WS_WBR + al((size_t)6144 * 1024 * 2);
constexpr size_t WS_WGU = WS_WOUT + al((size_t)2048 * 6144 * 2);
constexpr size_t WS_WD = WS_WGU + al((size_t)11264 * 2048 * 2);
constexpr size_t WS_ROPE = WS_WD + al((size_t)2048 * FFN * 2);
constexpr size_t WS_H = WS_ROPE + al((size_t)LSEQ * 192 * 4);
constexpr size_t WS_U = WS_H + al((size_t)MP * DM * 4);
constexpr size_t WS_P = WS_U + al((size_t)MP * DM * 2);
constexpr size_t WS_VTRET = WS_P + al((size_t)MP * PN * 2);
constexpr size_t WS_XL = WS_VTRET + al((size_t)1024 * MP * 2);
constexpr size_t WS_RW = WS_XL + al((size_t)MP * 512 * 2);
constexpr size_t RW_WDEC = 0;
constexpr size_t RW_A = RW_WDEC + (size_t)MP * 1024 * 4;
constexpr size_t RW_ARR = (size_t)MP * 1024 * 2;
constexpr size_t RW_YRAW = RW_A + 7 * RW_ARR;
constexpr size_t RW_BYTES = RW_YRAW + (size_t)MP * 1024 * 4;
static_assert(RW_BYTES >= (size_t)MP * 6144 * 2, "GT overlay");
constexpr size_t WS_YBR = WS_RW + al(RW_BYTES);
constexpr size_t WS_QN = WS_YBR + al(3 * RW_ARR);
constexpr size_t WS_KVN = WS_QN + al((size_t)MP * 512 * 2);
constexpr size_t WS_KR = WS_KVN + al((size_t)MP * 256 * 2);
constexpr size_t WS_Q = WS_KR + al((size_t)MP * 64 * 2);
constexpr size_t WS_KNOPE = WS_Q + al((size_t)MP * 1536 * 2);
constexpr size_t WS_VTMLA = WS_KNOPE + al((size_t)MP * 1024 * 2);
constexpr size_t WS_KVT = WS_VTMLA + al((size_t)1024 * MP * 2);
constexpr int NCHUNK = LSEQ / 16;
constexpr int RC_B1 = 0, RC_B2 = 5632, RC_VT = 10752, RC_G = 13824, RC_STRIDE = 14336;
constexpr size_t WS_RCH = WS_KVT + al((size_t)NB * 8 * 16 * 128 * 128 * 4);
constexpr size_t WS_END = WS_RCH + al((size_t)NB * 16 * NCHUNK * RC_STRIDE);
static_assert((size_t)MP * FFN * 2 <= (size_t)MP * PN * 2, "ACT overlay");

constexpr int CW_QUEUE = 1024;
constexpr int CW_BAR = 4096;
constexpr int XCD_BAR_WORDS_C = 3456;
constexpr int MAX_BAR_REGIONS = 64;
#ifndef N_LAUNCH_MODE
#define N_LAUNCH_MODE 1
#endif
constexpr size_t CTL_ZERO_BYTES = (N_LAUNCH_MODE == 1) ? (size_t)(CW_BAR + XCD_BAR_WORDS_C) * 4 : CTL_BYTES;

constexpr int LDS_BYTES = 147456;
constexpr int LDS_MISC = 131072;

__device__ __forceinline__ float bf2f(unsigned short v) { return __uint_as_float(((unsigned)v) << 16); }
__device__ __forceinline__ float bflo(unsigned v) { return __uint_as_float(v << 16); }
__device__ __forceinline__ float bfhi(unsigned v) { return __uint_as_float(v & 0xffff0000u); }
__device__ __forceinline__ unsigned cvt_pk_bf16(float lo, float hi) { unsigned r; asm volatile("v_cvt_pk_bf16_f32 %0, %1, %2" : "=v"(r) : "v"(lo), "v"(hi)); return r; }
__device__ __forceinline__ unsigned short f2bf(float x) { return (unsigned short)(cvt_pk_bf16(x, 0.f) & 0xffffu); }
template <int X> __device__ __forceinline__ float sw_xor(float x) { return __int_as_float(__builtin_amdgcn_ds_swizzle(__float_as_int(x), 0x1f | (X << 10))); }
__device__ __forceinline__ float hsum32(float x) { const int v = __float_as_int(x); auto r = __builtin_amdgcn_permlane32_swap(v, v, false, false); return __int_as_float(r[0]) + __int_as_float(r[1]); }
__device__ __forceinline__ float hmax32(float x) { const int v = __float_as_int(x); auto r = __builtin_amdgcn_permlane32_swap(v, v, false, false); return fmaxf(__int_as_float(r[0]), __int_as_float(r[1])); }
__device__ __forceinline__ float wsum32(float x) { x += sw_xor<16>(x); x += sw_xor<8>(x); x += sw_xor<4>(x); x += sw_xor<2>(x); x += sw_xor<1>(x); return x; }
__device__ __forceinline__ float wsum64(float x) { x = wsum32(x); return hsum32(x); }
__device__ __forceinline__ float dpp_xor1(float x) { return __int_as_float(__builtin_amdgcn_update_dpp(0, __float_as_int(x), 0xB1, 0xF, 0xF, true)); }
__device__ __forceinline__ float dpp_xor2(float x) { return __int_as_float(__builtin_amdgcn_update_dpp(0, __float_as_int(x), 0x4E, 0xF, 0xF, true)); }
__device__ __forceinline__ float dpp_mirror(float x) { return __int_as_float(__builtin_amdgcn_update_dpp(0, __float_as_int(x), 0x140, 0xF, 0xF, true)); }
__device__ __forceinline__ float dpp_hmirror(float x) { return __int_as_float(__builtin_amdgcn_update_dpp(0, __float_as_int(x), 0x141, 0xF, 0xF, true)); }
__device__ __forceinline__ float wsum64_dpp(float x) {
    x += dpp_xor1(x); x += dpp_xor2(x); x += dpp_hmirror(x); x += dpp_mirror(x);
    x += __int_as_float(__builtin_amdgcn_update_dpp(0, __float_as_int(x), 0x142, 0xA, 0xF, false));
    x += __int_as_float(__builtin_amdgcn_update_dpp(0, __float_as_int(x), 0x143, 0xC, 0xF, false));
    return __int_as_float(__builtin_amdgcn_readlane(__float_as_int(x), 63));
}
__device__ __forceinline__ float sigmoidf_(float x) { return 1.0f / (1.0f + __expf(-x)); }
__device__ __forceinline__ u32x4 zero4u() { unsigned z; asm volatile("v_mov_b32 %0, 0" : "=v"(z)); return (u32x4){z, z, z, z}; }

#define XB_TMO      128
#define XB_XCNT(j)  (256  + 64 * (j))
#define XB_XSUB(j)  (1280 + 64 * (j))
#define XB_XGEN(j)  (2304 + 64 * (j))
#define XB_TOP      3328
#define XB_TOPGEN   3392
#define XCD_BAR_WORDS 3456
#define XB_SPIN_CAP (1u << 18)

__device__ __forceinline__ unsigned xb_ld(unsigned* p)              { return __hip_atomic_load(p, __ATOMIC_RELAXED, __HIP_MEMORY_SCOPE_AGENT); }
__device__ __forceinline__ unsigned xb_add(unsigned* p, unsigned v) { return __hip_atomic_fetch_add(p, v, __ATOMIC_RELAXED, __HIP_MEMORY_SCOPE_AGENT); }
__device__ __forceinline__ unsigned xb_xcc_id() { return (unsigned)__builtin_amdgcn_s_getreg((3 << 11) | 20) & 0xFu; }
#define XB_SPIN(cond, bar) do { unsigned _sp = 0; while (cond) { __builtin_amdgcn_s_sleep(1); \
    if ((++_sp & 255u) == 0u) { if (xb_ld(&(bar)[XB_TMO])) break; if (_sp > XB_SPIN_CAP) { atomicAdd(&(bar)[XB_TMO], 1u); break; } } } } while (0)

struct XcdBarrier { unsigned* bar; unsigned x; volatile LAS unsigned* st; };

__device__ __forceinline__ XcdBarrier xcd_barrier_post(unsigned* bar, volatile LAS unsigned* st) {
    XcdBarrier b; b.bar = bar; b.x = xb_xcc_id(); b.st = st;
    if (threadIdx.x == 0) (void)xb_add(&bar[XB_XCNT(b.x)], 1u);
    return b;
}
__device__ __forceinline__ void xcd_barrier_complete(unsigned* bar, unsigned x, unsigned& nloc, unsigned& nx) {
    const unsigned G = gridDim.x * gridDim.y * gridDim.z;
    unsigned sum, cnt, mine, sp = 0u;
    for (;;) {
        sum = 0u; cnt = 0u; mine = 0u;
#pragma unroll
        for (unsigned j = 0; j < 16; ++j) { const unsigned c = xb_ld(&bar[XB_XCNT(j)]); sum += c; cnt += (c > 0u) ? 1u : 0u; mine = (j == x) ? c : mine; }
        if (sum == G) break;
        __builtin_amdgcn_s_sleep(1);
        if ((++sp & 255u) == 0u) { if (xb_ld(&bar[XB_TMO])) break; if (sp > XB_SPIN_CAP) { atomicAdd(&bar[XB_TMO], 1u); break; } }
    }
    nloc = mine > 0u ? mine : 1u; nx = cnt > 0u ? cnt : 1u;
}
__device__ __forceinline__ void xcd_barrier(const XcdBarrier& b, const bool leader) {
    asm volatile("s_waitcnt vmcnt(0)" ::: "memory");
    __syncthreads();
    if (leader) {
        unsigned* bar = b.bar;
        __builtin_amdgcn_s_waitcnt(0);
        unsigned nloc = b.st[0], nx = b.st[1];
        if (nloc == 0u) { xcd_barrier_complete(bar, b.x, nloc, nx); b.st[0] = nloc; b.st[1] = nx; }
        const unsigned old = xb_add(&bar[XB_XSUB(b.x)], 1u);
        const unsigned gen = old / nloc;
        if (old + 1u == (gen + 1u) * nloc) {
            __builtin_amdgcn_fence(__ATOMIC_RELEASE, "agent");
            asm volatile("s_waitcnt vmcnt(0)" ::: "memory");
            const unsigned og = xb_add(&bar[XB_TOP], 1u);
            const unsigned tg = og / nx;
            if (og + 1u == (tg + 1u) * nx) xb_add(&bar[XB_TOPGEN], 1u);
            else XB_SPIN(xb_ld(&bar[XB_TOPGEN]) == tg, bar);
            __builtin_amdgcn_fence(__ATOMIC_ACQUIRE, "agent");
            xb_add(&bar[XB_XGEN(b.x)], 1u);
            asm volatile("s_waitcnt vmcnt(0)" ::: "memory");
        } else {
            XB_SPIN(xb_ld(&bar[XB_XGEN(b.x)]) == gen, bar);
            __builtin_amdgcn_fence(__ATOMIC_ACQUIRE, "agent");
            asm volatile("s_waitcnt vmcnt(0)" ::: "memory");
        }
    }
    __syncthreads();
}

__device__ __forceinline__ void unpack8(const u32x4 w, float (&x)[8]);
__device__ __forceinline__ u32x4 pack8(const float (&x)[8]);
__device__ __forceinline__ void ld8f(const float* p, float (&x)[8]);
namespace pg8 {
constexpr int BM = 256, BK = 64, HALF = 128, HTB = HALF * BK * 2, STAGE_BYTES = 8 * HTB, NXCD = 8, WGM = 8;
__host__ __device__ __forceinline__ int lds_byte(int r, int c) { const int st = (r >> 4) * 2 + (c >> 5), rr = r & 15, cc = c & 31, ob = rr * 64 + cc * 2; return st * 1024 + (ob ^ (((ob >> 9) & 1) << 5)); }
__host__ __device__ __forceinline__ void stage_rc(int b, int& R, int& C) { const int st = b / 1024, sb = b % 1024, swz = sb ^ (((sb >> 9) & 1) << 5); R = (st >> 1) * 16 + swz / 64; C = (st & 1) * 32 + (swz % 64) / 2; }
__host__ __device__ __forceinline__ int perm32(int rho) { const int n = rho >> 4, i = rho & 15; return 8 * (i >> 2) + 4 * n + (i & 3); }

struct Unit { int pm, pn; };
struct Gemm { const bf16_t* A; const bf16_t* Bt; int M, N, K; int asel_tiles; size_t asel_stride; };

struct StaticOrder {
    int nM, nN, nwg, G, c;
    __host__ __device__ void init(int M_, int N_, int G_, int c_) { nM = M_ / BM; nN = N_ / BM; nwg = nM * nN; G = G_; c = c_; }
    __host__ __device__ bool next(int i, Unit& u) const {
        const long L = (long)i * G + c; if (L >= nwg) return false;
        int wgid = (int)L; { const int q = nwg / NXCD, r = nwg % NXCD, xcd = wgid % NXCD, off = wgid / NXCD; wgid = (xcd < r ? xcd * (q + 1) : r * (q + 1) + (xcd - r) * q) + off; }
        const int nig = WGM * nN, gid = wgid / nig, fm = gid * WGM, gsz = (nM - fm) < WGM ? (nM - fm) : WGM;
        u.pm = fm + ((wgid % nig) % gsz); u.pn = (wgid % nig) / gsz; return true;
    }
    __device__ __forceinline__ void a_ready(const Unit&) const {}
    __device__ __forceinline__ void done(const Unit&) const {}
};

template <class Epi, class Sched, bool ALIGN_EPI = false, bool SP2 = false>
__device__ __forceinline__ void gemm_phase(LAS unsigned char* lds, const Gemm g, const Sched& S, const Epi& E, const int tid) {
    const int wid = __builtin_amdgcn_readfirstlane(tid >> 6), lane = tid & 63, wr = wid >> 2, wc = wid & 3, fr = lane & 15, fq = lane >> 4;
    const int K = g.K, nt = K / BK;
    unsigned voffA[2], voffB[2];
#pragma unroll
    for (int i = 0; i < 2; ++i) { int R, C; stage_rc(tid * 16 + i * 8192, R, C); const int Rb = Epi::PERM ? ((R & ~31) + perm32(R & 31)) : R;
        voffA[i] = (unsigned)(R * K + C) * 2u; voffB[i] = (unsigned)(Rb * K + C) * 2u; }
    const size_t kstep = (size_t)(BK * 2);
    const size_t hstep = (size_t)HALF * K * 2;
    const size_t tstep = 2 * hstep;
    const unsigned ldsw = (unsigned)wid * 1024u;
    const int aoff = lds_byte(wr * 64 + fr, fq * 8), boff = lds_byte(wc * 32 + fr, fq * 8);
#define PG8_SA(b, h) (((b) * 2 + (h)) * HTB)
#define PG8_SB(b, h) ((4 + (b) * 2 + (h)) * HTB)
#define PG8_STAGE(bufoff, gbase, voff) do { _Pragma("unroll") for (int _i = 0; _i < 2; ++_i) \
        __builtin_amdgcn_global_load_lds((const unsigned*)((const char*)(gbase) + (voff)[_i]), (LAS unsigned*)(lds + (bufoff) + ldsw + _i * 8192), 16, 0, 0); } while (0)
#define PG8_LDA(dst, b, h) do { _Pragma("unroll") for (int m = 0; m < 4; ++m) _Pragma("unroll") for (int k = 0; k < 2; ++k) dst[m][k] = *(const LAS bf16x8*)(lds + PG8_SA(b, h) + aoff + m * 2048 + k * 1024); } while (0)
#define PG8_LDB(dst, b, h) do { _Pragma("unroll") for (int n = 0; n < 2; ++n) _Pragma("unroll") for (int k = 0; k < 2; ++k) dst[n][k] = *(const LAS bf16x8*)(lds + PG8_SB(b, h) + boff + n * 2048 + k * 1024); } while (0)
#define PG8_MMA(ai, bj, At, Bt) do { __builtin_amdgcn_s_setprio(1); _Pragma("unroll") for (int m = 0; m < 4; ++m) _Pragma("unroll") for (int n = 0; n < 2; ++n) _Pragma("unroll") for (int k = 0; k < 2; ++k) \
        acc[ai][bj][m][n] = __builtin_amdgcn_mfma_f32_16x16x32_bf16(Bt[n][k], At[m][k], acc[ai][bj][m][n], 0, 0, 0); __builtin_amdgcn_s_setprio(0); } while (0)
#define PG8_WAIT_V(n) asm volatile("s_waitcnt vmcnt(" #n ")" ::: "memory")
#define PG8_WAIT_L(n) asm volatile("s_waitcnt lgkmcnt(" #n ")" ::: "memory")
#define PG8_BAR __builtin_amdgcn_s_barrier()
#define PG8_SCHED __builtin_amdgcn_sched_barrier(0)
#define PG8_ABASE(u) ((const char*)g.A + (g.asel_tiles ? (size_t)((u).pn / g.asel_tiles) * g.asel_stride : (size_t)0) + (size_t)(u).pm * tstep)
    Unit cur, nxt; int ui = 0;
    if (!S.next(0, cur)) return;
    f32x4 acc[2][2][4][2];
    { float zf; asm volatile("v_mov_b32 %0, 0" : "=v"(zf)); const f32x4 Z = {zf, zf, zf, zf};
#pragma unroll
    for (int a = 0; a < 2; ++a)
#pragma unroll
        for (int b = 0; b < 2; ++b)
#pragma unroll
            for (int m = 0; m < 4; ++m)
#pragma unroll
                for (int n = 0; n < 2; ++n) acc[a][b][m][n] = Z; }
    bf16x8 At[4][2], B0[2][2], B1[2][2];
    const char* cA = PG8_ABASE(cur); const char* cB = (const char*)g.Bt + (size_t)cur.pn * tstep;
    S.a_ready(cur);
    if constexpr (SP2) {
        PG8_STAGE(PG8_SB(0, 0), cB, voffB); PG8_STAGE(PG8_SB(0, 1), cB + hstep, voffB); PG8_STAGE(PG8_SA(0, 0), cA, voffA); PG8_STAGE(PG8_SA(0, 1), cA + hstep, voffA);
        if (wr == 1) PG8_BAR;
        PG8_WAIT_V(2); PG8_BAR;
        PG8_STAGE(PG8_SB(1, 0), cB + kstep, voffB); PG8_STAGE(PG8_SA(1, 0), cA + kstep, voffA); PG8_STAGE(PG8_SB(1, 1), cB + hstep + kstep, voffB);
        PG8_WAIT_V(6); PG8_BAR;
    } else {
        PG8_STAGE(PG8_SB(0, 0), cB, voffB); PG8_STAGE(PG8_SA(0, 0), cA, voffA); PG8_STAGE(PG8_SB(0, 1), cB + hstep, voffB); PG8_STAGE(PG8_SA(0, 1), cA + hstep, voffA);
        if (wr == 1) PG8_BAR;
        PG8_WAIT_V(4); PG8_BAR;
        PG8_STAGE(PG8_SB(1, 0), cB + kstep, voffB); PG8_STAGE(PG8_SA(1, 0), cA + kstep, voffA); PG8_STAGE(PG8_SB(1, 1), cB + hstep + kstep, voffB);
        PG8_WAIT_V(6); PG8_BAR;
    }
    for (;;) {
        const bool has_next = S.next(ui + 1, nxt);
        const char* nA = has_next ? PG8_ABASE(nxt) : cA; const char* nB = has_next ? (const char*)g.Bt + (size_t)nxt.pn * tstep : cB;
        for (int t = 0; t < nt; t += 2) {
            const bool last = (t == nt - 2);
            const char* a1 = cA + (size_t)(t + 1) * kstep;
            const char* a2 = last ? nA : cA + (size_t)(t + 2) * kstep; const char* b2 = last ? nB : cB + (size_t)(t + 2) * kstep;
            const char* a3 = a2 + kstep; const char* b3 = b2 + kstep;
            if (last && has_next) S.a_ready(nxt);
            if constexpr (SP2) {
            PG8_LDB(B0, 0, 0); PG8_LDB(B1, 0, 1); PG8_SCHED; PG8_LDA(At, 0, 0); PG8_STAGE(PG8_SA(1, 1), a1 + hstep, voffA);
            PG8_WAIT_V(8); PG8_WAIT_L(0); PG8_BAR; PG8_MMA(0, 0, At, B0); PG8_MMA(0, 1, At, B1); PG8_BAR; PG8_SCHED;
            PG8_LDA(At, 0, 1); PG8_STAGE(PG8_SB(0, 0), b2, voffB); PG8_STAGE(PG8_SB(0, 1), b2 + hstep, voffB); PG8_STAGE(PG8_SA(0, 0), a2, voffA);
            PG8_WAIT_V(8); PG8_WAIT_L(0); PG8_BAR; PG8_MMA(1, 0, At, B0); PG8_MMA(1, 1, At, B1); PG8_BAR; PG8_SCHED;
            PG8_LDB(B0, 1, 0); PG8_LDB(B1, 1, 1); PG8_SCHED; PG8_LDA(At, 1, 0); PG8_STAGE(PG8_SA(0, 1), a2 + hstep, voffA);
            PG8_WAIT_V(8); PG8_WAIT_L(0); PG8_BAR; PG8_MMA(0, 0, At, B0); PG8_MMA(0, 1, At, B1); PG8_BAR; PG8_SCHED;
            PG8_LDA(At, 1, 1); PG8_STAGE(PG8_SB(1, 0), b3, voffB); PG8_STAGE(PG8_SB(1, 1), b3 + hstep, voffB); PG8_STAGE(PG8_SA(1, 0), a3, voffA);
            PG8_WAIT_V(8); PG8_WAIT_L(0); PG8_BAR; PG8_MMA(1, 0, At, B0); PG8_MMA(1, 1, At, B1); PG8_BAR; PG8_SCHED;
            } else {
            PG8_LDB(B0, 0, 0); PG8_SCHED; PG8_LDA(At, 0, 0); PG8_STAGE(PG8_SA(1, 1), a1 + hstep, voffA);
            PG8_WAIT_L(8); PG8_BAR; PG8_WAIT_L(0); PG8_MMA(0, 0, At, B0); PG8_BAR; PG8_SCHED;
            PG8_LDB(B1, 0, 1); PG8_STAGE(PG8_SB(0, 0), b2, voffB);
            PG8_BAR; PG8_WAIT_L(0); PG8_MMA(0, 1, At, B1); PG8_BAR;
            PG8_LDA(At, 0, 1); PG8_STAGE(PG8_SA(0, 0), a2, voffA);
            PG8_BAR; PG8_WAIT_L(0); PG8_MMA(1, 0, At, B0); PG8_BAR; PG8_SCHED;
            PG8_STAGE(PG8_SB(0, 1), b2 + hstep, voffB);
            PG8_WAIT_V(6); PG8_BAR; PG8_MMA(1, 1, At, B1); PG8_BAR;
            PG8_LDB(B0, 1, 0); PG8_SCHED; PG8_LDA(At, 1, 0); PG8_STAGE(PG8_SA(0, 1), a2 + hstep, voffA);
            PG8_WAIT_L(8); PG8_BAR; PG8_WAIT_L(0); PG8_MMA(0, 0, At, B0); PG8_BAR; PG8_SCHED;
            PG8_LDB(B1, 1, 1); PG8_STAGE(PG8_SB(1, 0), b3, voffB);
            PG8_BAR; PG8_WAIT_L(0); PG8_MMA(0, 1, At, B1); PG8_BAR;
            PG8_LDA(At, 1, 1); PG8_STAGE(PG8_SA(1, 0), a3, voffA);
            PG8_BAR; PG8_WAIT_L(0); PG8_MMA(1, 0, At, B0); PG8_BAR; PG8_SCHED;
            PG8_STAGE(PG8_SB(1, 1), b3 + hstep, voffB);
            PG8_WAIT_V(6); PG8_BAR; PG8_MMA(1, 1, At, B1); PG8_BAR;
            }
        }
        if constexpr (ALIGN_EPI) { if (wr == 0) PG8_BAR; }
        E(acc, cur, wr, wc, fr, fq); S.done(cur);
        if (!has_next) break;
        { float zf; asm volatile("v_mov_b32 %0, 0" : "=v"(zf)); const f32x4 Z = {zf, zf, zf, zf};
#pragma unroll
        for (int a = 0; a < 2; ++a)
#pragma unroll
            for (int b = 0; b < 2; ++b)
#pragma unroll
                for (int m = 0; m < 4; ++m)
#pragma unroll
                    for (int n = 0; n < 2; ++n) acc[a][b][m][n] = Z; }
        cur = nxt; cA = nA; cB = nB; ++ui;
        if constexpr (ALIGN_EPI) { if (wr == 1) PG8_BAR; }
    }
    PG8_WAIT_V(0);
    if constexpr (!ALIGN_EPI) { if (wr == 0) PG8_BAR; }
    PG8_BAR;
#undef PG8_SA
#undef PG8_SB
#undef PG8_STAGE
#undef PG8_LDA
#undef PG8_LDB
#undef PG8_MMA
#undef PG8_WAIT_V
#undef PG8_WAIT_L
#undef PG8_BAR
#undef PG8_SCHED
#undef PG8_ABASE
}

struct EpiBf16Plain {
    static constexpr bool PERM = true;
    bf16_t* O; int ldc;
    __device__ __forceinline__ void operator()(const f32x4 (&acc)[2][2][4][2], const Unit& u, int wr, int wc, int fr, int fq) const {
        const int row0 = u.pm * BM + wr * 64 + fr; const int col0 = u.pn * BM + wc * 32 + 8 * fq;
#pragma unroll
        for (int ai = 0; ai < 2; ++ai)
#pragma unroll
            for (int m = 0; m < 4; ++m) { bf16_t* rowp = O + (size_t)(row0 + ai * HALF + m * 16) * ldc + col0;
#pragma unroll
                for (int bj = 0; bj < 2; ++bj) { const f32x4 v0 = acc[ai][bj][m][0], v1 = acc[ai][bj][m][1];
                    u32x4 w; w.x = cvt_pk_bf16(v0[0], v0[1]); w.y = cvt_pk_bf16(v0[2], v0[3]); w.z = cvt_pk_bf16(v1[0], v1[1]); w.w = cvt_pk_bf16(v1[2], v1[3]);
                    *(u32x4*)(rowp + bj * HALF) = w; } }
    }
};
struct EpiResid {
    static constexpr bool PERM = true;
    bf16_t* Hb;
    __device__ __forceinline__ void operator()(const f32x4 (&acc)[2][2][4][2], const Unit& u, int wr, int wc, int fr, int fq) const {
        const int row0 = u.pm * BM + wr * 64 + fr, col0 = u.pn * BM + wc * 32 + 8 * fq;
        bf16_t* base = Hb + (size_t)row0 * DM + col0;
        u32x4 hv[2][4][2];
#pragma unroll
        for (int ai = 0; ai < 2; ++ai)
#pragma unroll
            for (int m = 0; m < 4; ++m)
#pragma unroll
                for (int bj = 0; bj < 2; ++bj) hv[ai][m][bj] = *(const u32x4*)(base + (size_t)(ai * HALF + m * 16) * DM + bj * HALF);
#pragma unroll
        for (int ai = 0; ai < 2; ++ai)
#pragma unroll
            for (int m = 0; m < 4; ++m)
#pragma unroll
                for (int bj = 0; bj < 2; ++bj) { const f32x4 v0 = acc[ai][bj][m][0], v1 = acc[ai][bj][m][1]; float p[8]; unpack8(hv[ai][m][bj], p);
                    const float o[8] = {p[0] + v0[0], p[1] + v0[1], p[2] + v0[2], p[3] + v0[3], p[4] + v1[0], p[5] + v1[1], p[6] + v1[2], p[7] + v1[3]};
                    *(u32x4*)(base + (size_t)(ai * HALF + m * 16) * DM + bj * HALF) = pack8(o); }
    }
};
struct EpiLora {
    static constexpr bool PERM = true;
    float* wdec; bf16_t* abuf; bf16_t* gbuf; const float* w0; const float* a0;
    __device__ __forceinline__ void operator()(const f32x4 (&acc)[2][2][4][2], const Unit& u, int wr, int wc, int fr, int fq) const {
        const int row0 = u.pm * BM + wr * 64 + fr; const int type = u.pn >> 2; const int col0 = (u.pn & 3) * BM + wc * 32 + 8 * fq;
        if (type == 0) {
            f32x4 bv[2][2];
#pragma unroll
            for (int bj = 0; bj < 2; ++bj) { bv[bj][0] = *(const f32x4*)(w0 + col0 + bj * HALF); bv[bj][1] = *(const f32x4*)(w0 + col0 + bj * HALF + 4); }
#pragma unroll
            for (int ai = 0; ai < 2; ++ai)
#pragma unroll
                for (int m = 0; m < 4; ++m) { float* rowp = wdec + (size_t)(row0 + ai * HALF + m * 16) * 1024 + col0;
#pragma unroll
                    for (int bj = 0; bj < 2; ++bj)
#pragma unroll
                        for (int n = 0; n < 2; ++n) { f32x4 x = acc[ai][bj][m][n] + bv[bj][n]; f32x4 o;
#pragma unroll
                            for (int i = 0; i < 4; ++i) { const float y = -x[i]; const float sp = fmaxf(y, 0.f) + __logf(1.0f + __expf(-fabsf(y))); o[i] = __expf(-__expf(-sp - 0.5f)); }
                            *(f32x4*)(rowp + bj * HALF + 4 * n) = o; } }
        } else {
            bf16_t* ob = (type == 1) ? abuf : gbuf;
            f32x4 bv[2][2];
#pragma unroll
            for (int bj = 0; bj < 2; ++bj) { bv[bj][0] = *(const f32x4*)(a0 + col0 + bj * HALF); bv[bj][1] = *(const f32x4*)(a0 + col0 + bj * HALF + 4); }
#pragma unroll
            for (int ai = 0; ai < 2; ++ai)
#pragma unroll
                for (int m = 0; m < 4; ++m) { bf16_t* rowp = ob + (size_t)(row0 + ai * HALF + m * 16) * 1024 + col0;
#pragma unroll
                    for (int bj = 0; bj < 2; ++bj) { f32x4 v0 = acc[ai][bj][m][0], v1 = acc[ai][bj][m][1];
                        if (type == 1) { v0 = v0 + bv[bj][0]; v1 = v1 + bv[bj][1];
#pragma unroll
                            for (int i = 0; i < 4; ++i) { v0[i] = sigmoidf_(v0[i]); v1[i] = sigmoidf_(v1[i]); } }
                        u32x4 w; w.x = cvt_pk_bf16(v0[0], v0[1]); w.y = cvt_pk_bf16(v0[2], v0[3]); w.z = cvt_pk_bf16(v1[0], v1[1]); w.w = cvt_pk_bf16(v1[2], v1[3]);
                        *(u32x4*)(rowp + bj * HALF) = w; } }
        }
    }
};
struct EpiGate {
    static constexpr bool PERM = true;
    bf16_t* MG; const bf16_t* P;
    __device__ __forceinline__ void operator()(const f32x4 (&acc)[2][2][4][2], const Unit& u, int wr, int wc, int fr, int fq) const {
        const int br = u.pn >> 3; const int row0 = u.pm * BM + wr * 64 + fr; const int col0 = (u.pn & 7) * BM + wc * 32 + 8 * fq;
        const bf16_t* gbase = P + (size_t)row0 * PN + P_GATES + br * 2048 + col0; bf16_t* mbase = MG + (size_t)row0 * DM + col0;
#pragma unroll
        for (int ai = 0; ai < 2; ++ai) {
            u32x4 gv[4][2], mv[4][2];
#pragma unroll
            for (int m = 0; m < 4; ++m)
#pragma unroll
                for (int bj = 0; bj < 2; ++bj) { gv[m][bj] = *(const u32x4*)(gbase + (size_t)(ai * HALF + m * 16) * PN + bj * HALF);
                    if (br > 0) mv[m][bj] = *(const u32x4*)(mbase + (size_t)(ai * HALF + m * 16) * DM + bj * HALF); }
#pragma unroll
            for (int m = 0; m < 4; ++m)
#pragma unroll
                for (int bj = 0; bj < 2; ++bj) { const f32x4 v0 = acc[ai][bj][m][0], v1 = acc[ai][bj][m][1]; const u32x4 gt = gv[m][bj];
                    float o[8] = { v0[0] * sigmoidf_(bflo(gt.x)), v0[1] * sigmoidf_(bfhi(gt.x)), v0[2] * sigmoidf_(bflo(gt.y)), v0[3] * sigmoidf_(bfhi(gt.y)),
                                   v1[0] * sigmoidf_(bflo(gt.z)), v1[1] * sigmoidf_(bfhi(gt.z)), v1[2] * sigmoidf_(bflo(gt.w)), v1[3] * sigmoidf_(bfhi(gt.w)) };
                    if (br > 0) { float p[8]; unpack8(mv[m][bj], p);
#pragma unroll
                        for (int i = 0; i < 8; ++i) o[i] += p[i]; }
                    *(u32x4*)(mbase + (size_t)(ai * HALF + m * 16) * DM + bj * HALF) = pack8(o); }
        }
    }
};
struct BranchOrder {
    StaticOrder base;
    __device__ bool next(int i, Unit& u) const { Unit t; if (!base.next(i / 3, t)) return false; u.pm = t.pm; u.pn = (i % 3) * 8 + t.pn; return true; }
    __device__ __forceinline__ void a_ready(const Unit&) const {}
    __device__ __forceinline__ void done(const Unit&) const {}
};
struct EpiSwiglu {
    static constexpr bool PERM = true;
    bf16_t* ACT;
    __device__ __forceinline__ void operator()(const f32x4 (&acc)[2][2][4][2], const Unit& u, int wr, int wc, int fr, int fq) const {
        const int row0 = u.pm * BM + wr * 64 + fr; const int col0 = u.pn * BM + wc * 32 + 8 * fq;
#pragma unroll
        for (int ai = 0; ai < 2; ++ai)
#pragma unroll
            for (int m = 0; m < 4; ++m) { const size_t row = (size_t)(row0 + ai * HALF + m * 16);
#pragma unroll
                for (int bj = 0; bj < 2; ++bj) { const int hc = (col0 + bj * HALF) >> 1; const f32x4 g = acc[ai][bj][m][0], up = acc[ai][bj][m][1];
                    float o[4];
#pragma unroll
                    for (int i = 0; i < 4; ++i) o[i] = g[i] * sigmoidf_(g[i]) * up[i];
                    u32x2 w; w.x = cvt_pk_bf16(o[0], o[1]); w.y = cvt_pk_bf16(o[2], o[3]);
                    *(u32x2*)(ACT + row * FFN + hc) = w; } }
    }
};
}

struct Args {
    const float* in[27];
    float* out; unsigned char* ws;
    int s_lo, s_hi, bar_idx, pad;
};
struct Ctx {
    float* out; unsigned char* ws; LAS unsigned char* lds; unsigned* ctl;
    int tid, lane, wave, G, wg;
};
enum { IN_X = 0, IN_META, IN_NORM_MIX, IN_W_IN, IN_MU, IN_W0, IN_W_UP, IN_A0, IN_A_UP, IN_G_UP, IN_K_K, IN_K_A, IN_R_K, IN_LN_W, IN_LN_B, IN_NORM_Q, IN_NORM_KV, IN_W_UQ, IN_W_UKV,
       IN_BR_RWKV, IN_BR_RET, IN_BR_MLA, IN_W_OUT, IN_NORM_FFN, IN_W_GU, IN_W_DOWN, IN_FINAL_NORM };

#define WSP(T, off) ((T*)(C.ws + (off)))
constexpr int LDS_INTBL = LDS_MISC + 256;
__device__ __forceinline__ const float* inp(const Ctx& C, int i) {
    const unsigned long long v = ((volatile LAS unsigned long long*)(C.lds + LDS_INTBL))[i];
    const unsigned lo = __builtin_amdgcn_readfirstlane((unsigned)v), hi = __builtin_amdgcn_readfirstlane((unsigned)(v >> 32));
    return (const float*)(GAS const float*)(((unsigned long long)hi << 32) | lo);
}

__device__ __forceinline__ void ph_rope_tables(const Ctx& C) {
    float* rt = WSP(float, WS_ROPE);
    float* cm = rt; float* sm = rt + LSEQ * 32; float* cr = rt + LSEQ * 64; float* sr = rt + LSEQ * 128;
    for (int i = C.wg * 512 + C.tid; i < LSEQ * 96; i += C.G * 512) {
        const int pos = i / 96, j = i % 96;
        if (j < 32) { const float inv = powf(10000.0f, -((float)(2 * j) / 64.0f)); const float ang = (float)pos * inv; cm[pos * 32 + j] = cosf(ang); sm[pos * 32 + j] = sinf(ang); }
        else { const int jj = j - 32; const float inv = powf(10000.0f, -((float)(2 * jj) / 128.0f)); const float ang = (float)pos * inv; cr[pos * 64 + jj] = cosf(ang); sr[pos * 64 + jj] = sinf(ang); }
    }
}

template <class RowPtr>
__device__ __forceinline__ void conv_T(const Ctx& C, const float* __restrict__ src, int ld, int K, int c0, int ncols, const float* __restrict__ gain, const RowPtr& rowptr, int& tbase) {
    LAS float* tile = (LAS float*)C.lds;
    const int nkt = K / 64, ntile = nkt * (ncols / 64);
    const int t = C.tid, kk = t >> 3, n8 = (t & 7) * 8;
    int ti = (C.wg - (tbase % C.G) + C.G) % C.G;
    tbase += ntile;
    if (ti >= ntile) return;
    f32x4 a, b; float gn;
    { const int k0 = (ti % nkt) * 64, n0 = c0 + (ti / nkt) * 64; const float* sp = src + (size_t)(k0 + kk) * ld + n0 + n8; a = *(const f32x4*)sp; b = *(const f32x4*)(sp + 4); gn = gain ? gain[k0 + kk] : 1.0f; }
    for (; ti < ntile; ti += C.G) {
        const int k0 = (ti % nkt) * 64, n0 = c0 + (ti / nkt) * 64;
        { LAS float* tp = tile + kk * 65 + n8;
          tp[0] = a[0] * gn; tp[1] = a[1] * gn; tp[2] = a[2] * gn; tp[3] = a[3] * gn; tp[4] = b[0] * gn; tp[5] = b[1] * gn; tp[6] = b[2] * gn; tp[7] = b[3] * gn; }
        { const int tn = ti + C.G; if (tn < ntile) { const int k1 = (tn % nkt) * 64, n1 = c0 + (tn / nkt) * 64; const float* sp = src + (size_t)(k1 + kk) * ld + n1 + n8; a = *(const f32x4*)sp; b = *(const f32x4*)(sp + 4); gn = gain ? gain[k1 + kk] : 1.0f; } }
        __syncthreads();
        { const int n = t >> 3, k8 = (t & 7) * 8; bf16_t* dp = rowptr(n0 + n);
          if (dp) { float v[8];
#pragma unroll
              for (int i = 0; i < 8; ++i) v[i] = tile[(k8 + i) * 65 + n];
              u32x4 w; w.x = cvt_pk_bf16(v[0], v[1]); w.y = cvt_pk_bf16(v[2], v[3]); w.z = cvt_pk_bf16(v[4], v[5]); w.w = cvt_pk_bf16(v[6], v[7]);
              *(u32x4*)(dp + k0 + k8) = w; } }
        __syncthreads();
    }
}
struct RpLinear { bf16_t* base; int ldk; int coff; int roff; __device__ __forceinline__ bf16_t* operator()(int n) const { return base + (size_t)(n - coff + roff) * ldk; } };
struct RpWin { bf16_t* win; bf16_t* wvret; __device__ __forceinline__ bf16_t* operator()(int n) const {
    if (n < 5568) return win + (size_t)n * DM; if (n < 6592) return wvret + (size_t)(n - 5568) * DM; return win + (size_t)(n - 1024) * DM; } };
struct RpUkv { bf16_t* wuk; bf16_t* wuv; __device__ __forceinline__ bf16_t* operator()(int n) const { const int h = n >> 8, j = n & 255; return (j < 128 ? wuk + (size_t)(h * 128 + j) * 256 : wuv + (size_t)(h * 128 + j - 128) * 256); } };
struct RpOut3 { bf16_t* base; int seg; __device__ __forceinline__ bf16_t* operator()(int n) const { return base + (size_t)n * 6144 + seg * 2048; } };
struct RpGu { bf16_t* base; __device__ __forceinline__ bf16_t* operator()(int n) const { const int which = n >= FFN ? 1 : 0; const int j = n - which * FFN; return base + (size_t)(8 * (j >> 2) + 4 * which + (j & 3)) * DM; } };

__device__ __forceinline__ void ph_convB(const Ctx& C, int l) {
    int tb = 0;
    conv_T(C, inp(C, IN_W_DOWN) + (size_t)l * FFN * DM, DM, FFN, 0, DM, nullptr, RpLinear{WSP(bf16_t, WS_WD), FFN, 0, 0}, tb);
    conv_T(C, inp(C, IN_W_OUT) + (size_t)l * DM * DM, DM, DM, 0, DM, nullptr, RpLinear{WSP(bf16_t, WS_WOUT), DM, 0, 0}, tb);
    conv_T(C, inp(C, IN_BR_RWKV) + (size_t)l * 1024 * DM, DM, 1024, 0, DM, nullptr, RpLinear{WSP(bf16_t, WS_WBR), 1024, 0, 0}, tb);
    conv_T(C, inp(C, IN_BR_RET) + (size_t)l * 1024 * DM, DM, 1024, 0, DM, nullptr, RpLinear{WSP(bf16_t, WS_WBR), 1024, 0, 2048}, tb);
    conv_T(C, inp(C, IN_BR_MLA) + (size_t)l * 1024 * DM, DM, 1024, 0, DM, nullptr, RpLinear{WSP(bf16_t, WS_WBR), 1024, 0, 4096}, tb);
}

__device__ __forceinline__ void ph_conv(const Ctx& C, int l) {
    int tb = 0;
    conv_T(C, inp(C, IN_W_IN) + (size_t)l * DM * IN_COLS, IN_COLS, DM, 0, IN_COLS, inp(C, IN_NORM_MIX) + l * DM, RpWin{WSP(bf16_t, WS_WIN), WSP(bf16_t, WS_WVRET)}, tb);
    conv_T(C, inp(C, IN_W_GU) + (size_t)l * DM * 2 * FFN, 2 * FFN, DM, 0, 2 * FFN, inp(C, IN_NORM_FFN) + l * DM, RpGu{WSP(bf16_t, WS_WGU)}, tb);
    conv_T(C, inp(C, IN_W_UQ) + (size_t)l * 512 * 1536, 1536, 512, 0, 1536, inp(C, IN_NORM_Q) + l * 512, RpLinear{WSP(bf16_t, WS_WUQ), 512, 0, 0}, tb);
    conv_T(C, inp(C, IN_W_UKV) + (size_t)l * 256 * 2048, 2048, 256, 0, 2048, inp(C, IN_NORM_KV) + l * 256, RpUkv{WSP(bf16_t, WS_WUK), WSP(bf16_t, WS_WUV)}, tb);
    { bf16_t* wl = WSP(bf16_t, WS_WLORA); const float* wup = inp(C, IN_W_UP) + (size_t)l * 96 * 1024; const float* aup = inp(C, IN_A_UP) + (size_t)l * 96 * 1024; const float* gup = inp(C, IN_G_UP) + (size_t)l * 256 * 1024;
      static_assert((LORA_N * LORA_K) % 4 == 0, "lora conversion");
      for (int i0 = (C.wg * 512 + C.tid) * 4; i0 < LORA_N * LORA_K; i0 += C.G * 512 * 4) { float v[4];
#pragma unroll
          for (int e = 0; e < 4; ++e) { const int i = i0 + e, n = i / LORA_K, k = i % LORA_K; v[e] = 0.f;
              if (n < 1024) { if (k < 96) v[e] = wup[k * 1024 + n]; } else if (n < 2048) { if (k >= 96 && k < 192) v[e] = aup[(k - 96) * 1024 + (n - 1024)]; } else { if (k >= 192 && k < 448) v[e] = gup[(k - 192) * 1024 + (n - 2048)]; } }
          *(u32x2*)(wl + i0) = (u32x2){cvt_pk_bf16(v[0], v[1]), cvt_pk_bf16(v[2], v[3])}; } }
}

template <bool FIRST>
__device__ __forceinline__ void ph_norm(const Ctx& C) {
    bf16_t* H = WSP(bf16_t, WS_H); bf16_t* U = WSP(bf16_t, WS_U);
    for (int r0 = C.wg * 8 + C.wave; r0 < MP; r0 += C.G * 16) {
        int rows[2]; rows[0] = r0; rows[1] = r0 + C.G * 8;
        float v[2][4][8]; u32x4 raw[2][4];
#pragma unroll
        for (int rr = 0; rr < 2; ++rr)
#pragma unroll
            for (int i = 0; i < 4; ++i) raw[rr][i] = zero4u();
#pragma unroll
        for (int rr = 0; rr < 2; ++rr) { const int row = rows[rr]; if (row >= M) continue;
            if (FIRST) { const int b = row / LSEQ, pos = row % LSEQ; const float* sp = pos < NMETA ? inp(C, IN_META) + (size_t)pos * DM : inp(C, IN_X) + ((size_t)b * SEQ + (pos - NMETA)) * DM;
#pragma unroll
                for (int i = 0; i < 4; ++i) ld8f(sp + (i * 64 + C.lane) * 8, v[rr][i]); }
            else { const bf16_t* hp = H + (size_t)row * DM;
#pragma unroll
                for (int i = 0; i < 4; ++i) raw[rr][i] = *(const u32x4*)(hp + (i * 64 + C.lane) * 8); } }
        __builtin_amdgcn_sched_barrier(0);
        if (!FIRST) {
#pragma unroll
            for (int rr = 0; rr < 2; ++rr)
#pragma unroll
                for (int i = 0; i < 4; ++i) unpack8(raw[rr][i], v[rr][i]); }
#pragma unroll
        for (int rr = 0; rr < 2; ++rr) { const int row = rows[rr]; if (row >= MP) continue;
            bf16_t* up = U + (size_t)row * DM;
            if (row >= M) { const u32x4 z = zero4u(); for (int i = 0; i < 4; ++i) *(u32x4*)(up + (i * 64 + C.lane) * 8) = z; continue; }
            bf16_t* hp = H + (size_t)row * DM; float ss = 0.f;
#pragma unroll
            for (int i = 0; i < 4; ++i)
#pragma unroll
                for (int j = 0; j < 8; ++j) ss += v[rr][i][j] * v[rr][i][j];
            ss = wsum64(ss); const float rstd = rsqrtf(ss * (1.0f / DM) + NORM_EPS);
#pragma unroll
            for (int i = 0; i < 4; ++i) { if (FIRST) *(u32x4*)(hp + (i * 64 + C.lane) * 8) = pack8(v[rr][i]);
                float o[8];
#pragma unroll
                for (int j = 0; j < 8; ++j) o[j] = v[rr][i][j] * rstd;
                *(u32x4*)(up + (i * 64 + C.lane) * 8) = pack8(o); } }
    }
}
__device__ __forceinline__ void ph_final(const Ctx& C) {
    const bf16_t* H = WSP(bf16_t, WS_H); const float* fn = inp(C, IN_FINAL_NORM);
    f32x4 gn[4][2];
#pragma unroll
    for (int i = 0; i < 4; ++i) { gn[i][0] = *(const f32x4*)(fn + (i * 64 + C.lane) * 8); gn[i][1] = *(const f32x4*)(fn + (i * 64 + C.lane) * 8 + 4); }
    for (int r = C.wg * 8 + C.wave; r < NB * SEQ; r += C.G * 8) {
        const int b = r / SEQ, t = r % SEQ; const bf16_t* sp = H + ((size_t)b * LSEQ + NMETA + t) * DM; float* op = C.out + (size_t)r * DM;
        float v[4][8]; float ss = 0.f; u32x4 raw[4];
#pragma unroll
        for (int i = 0; i < 4; ++i) raw[i] = *(const u32x4*)(sp + (i * 64 + C.lane) * 8);
        __builtin_amdgcn_sched_barrier(0);
#pragma unroll
        for (int i = 0; i < 4; ++i) { unpack8(raw[i], v[i]);
#pragma unroll
            for (int j = 0; j < 8; ++j) ss += v[i][j] * v[i][j]; }
        ss = wsum64(ss); const float rstd = rsqrtf(ss * (1.0f / DM) + NORM_EPS);
#pragma unroll
        for (int i = 0; i < 4; ++i) { const int c = (i * 64 + C.lane) * 8; const f32x4 g0 = gn[i][0], g1 = gn[i][1];
            *(f32x4*)(op + c) = (f32x4){v[i][0] * rstd * g0[0], v[i][1] * rstd * g0[1], v[i][2] * rstd * g0[2], v[i][3] * rstd * g0[3]};
            *(f32x4*)(op + c + 4) = (f32x4){v[i][4] * rstd * g1[0], v[i][5] * rstd * g1[1], v[i][6] * rstd * g1[2], v[i][7] * rstd * g1[3]}; }
    }
}
__device__ __forceinline__ void unpack8(const u32x4 w, float (&x)[8]) { x[0] = bflo(w.x); x[1] = bfhi(w.x); x[2] = bflo(w.y); x[3] = bfhi(w.y); x[4] = bflo(w.z); x[5] = bfhi(w.z); x[6] = bflo(w.w); x[7] = bfhi(w.w); }
__device__ __forceinline__ u32x4 pack8(const float (&x)[8]) { u32x4 w; w.x = cvt_pk_bf16(x[0], x[1]); w.y = cvt_pk_bf16(x[2], x[3]); w.z = cvt_pk_bf16(x[4], x[5]); w.w = cvt_pk_bf16(x[6], x[7]); return w; }

__device__ __forceinline__ void ph_prepA(const Ctx& C, int l) {
    const bf16_t* P = WSP(bf16_t, WS_P); bf16_t* XL = WSP(bf16_t, WS_XL); bf16_t* QN = WSP(bf16_t, WS_QN); bf16_t* KVN = WSP(bf16_t, WS_KVN); bf16_t* KR = WSP(bf16_t, WS_KR);
    const float* mu = inp(C, IN_MU) + (size_t)l * RW_COLS; const float* rt = WSP(float, WS_ROPE); const float* cm = rt; const float* sm = rt + LSEQ * 32;
    const int lane = C.lane;
    for (int row = C.wg * 8 + C.wave; row < MP; row += C.G * 8) {
        if (row >= M) { const u32x4 z = zero4u(); *(u32x4*)(XL + (size_t)row * 512 + 8 * lane) = z; *(u32x4*)(QN + (size_t)row * 512 + 8 * lane) = z;
            if (lane < 32) *(u32x4*)(KVN + (size_t)row * 256 + 8 * lane) = z; KR[(size_t)row * 64 + lane] = (bf16_t)z.x; continue; }
        const int pos = row % LSEQ; const bf16_t* pr = P + (size_t)row * PN;
        const int khl = lane >> 3, kc8 = (lane & 7) * 8; bf16_t* kbase = WSP(bf16_t, WS_P) + (size_t)row * PN + P_KRET + khl * 128 + kc8;
        const u32x4 kx1 = *(const u32x4*)kbase, kx2 = *(const u32x4*)(kbase + 64);
        float kcc[8], kss[8]; ld8f(rt + LSEQ * 64 + pos * 64 + kc8, kcc); ld8f(rt + LSEQ * 128 + pos * 64 + kc8, kss);
        const bool lact = lane < 56; const int lc = 3072 + 8 * (lact ? lane : 0);
        const u32x4 lz = *(const u32x4*)(pr + lc), lpz = *(const u32x4*)((pos > 0 ? pr - PN : pr) + lc); const f32x4 lm0 = *(const f32x4*)(mu + lc), lm1 = *(const f32x4*)(mu + lc + 4);
        const u32x4 qdw = *(const u32x4*)(pr + P_QD + 8 * lane), kvw = *(const u32x4*)(pr + P_KVD + 8 * (lane & 31));
        const bf16_t kr1 = pr[P_KRD + (lane & 31)], kr2 = pr[P_KRD + 32 + (lane & 31)]; const float krc = cm[pos * 32 + (lane & 31)], krs = sm[pos * 32 + (lane & 31)];
        { u32x4 o = zero4u();
          if (lact) { float z[8], pz[8];
              unpack8(lz, z);
              if (pos > 0) unpack8(lpz, pz); else { for (int i = 0; i < 8; ++i) pz[i] = 0.f; }
              const float mm[8] = {lm0[0], lm0[1], lm0[2], lm0[3], lm1[0], lm1[1], lm1[2], lm1[3]};
              float x[8];
#pragma unroll
              for (int i = 0; i < 8; ++i) { const float zs = z[i] + (pz[i] - z[i]) * mm[i]; x[i] = (lane < 12) ? tanhf(zs) : (lane < 24 ? zs : sigmoidf_(zs)); }
              o = pack8(x); }
          *(u32x4*)(XL + (size_t)row * 512 + 8 * lane) = o; }
        { float x[8]; unpack8(qdw, x); float ss = 0.f;
#pragma unroll
          for (int i = 0; i < 8; ++i) ss += x[i] * x[i];
          ss = wsum64(ss); const float rstd = rsqrtf(ss * (1.0f / 512.0f) + NORM_EPS);
#pragma unroll
          for (int i = 0; i < 8; ++i) x[i] *= rstd;
          *(u32x4*)(QN + (size_t)row * 512 + 8 * lane) = pack8(x); }
        { float x[8]; if (lane < 32) unpack8(kvw, x); else { for (int i = 0; i < 8; ++i) x[i] = 0.f; }
          float ss = 0.f;
#pragma unroll
          for (int i = 0; i < 8; ++i) ss += x[i] * x[i];
          ss = wsum64(ss); const float rstd = rsqrtf(ss * (1.0f / 256.0f) + NORM_EPS);
#pragma unroll
          for (int i = 0; i < 8; ++i) x[i] *= rstd;
          if (lane < 32) *(u32x4*)(KVN + (size_t)row * 256 + 8 * lane) = pack8(x); }
        { float x1[8], x2[8], o1[8], o2[8]; unpack8(kx1, x1); unpack8(kx2, x2);
#pragma unroll
          for (int i = 0; i < 8; ++i) { o1[i] = (x1[i] * kcc[i] - x2[i] * kss[i]) * 0.08838834764831845f; o2[i] = (x2[i] * kcc[i] + x1[i] * kss[i]) * 0.08838834764831845f; }
          *(u32x4*)kbase = pack8(o1); *(u32x4*)(kbase + 64) = pack8(o2); }
        if (lane < 32) { const float x1 = bf2f(kr1), x2 = bf2f(kr2); const float c = krc, s = krs;
            KR[(size_t)row * 64 + lane] = f2bf(x1 * c - x2 * s); KR[(size_t)row * 64 + 32 + lane] = f2bf(x2 * c + x1 * s); }
    }
}
__device__ __forceinline__ float sum8(float x) { x += dpp_xor1(x); x += dpp_xor2(x); x += dpp_hmirror(x); return x; }
__device__ __forceinline__ void ld8f(const float* p, float (&x)[8]) { const f32x4 a = *(const f32x4*)p, b = *(const f32x4*)(p + 4); x[0] = a[0]; x[1] = a[1]; x[2] = a[2]; x[3] = a[3]; x[4] = b[0]; x[5] = b[1]; x[6] = b[2]; x[7] = b[3]; }
__device__ __forceinline__ void ph_qrope(const Ctx& C) {
    bf16_t* Q = WSP(bf16_t, WS_Q); const float* rt = WSP(float, WS_ROPE); const float* cm = rt; const float* sm = rt + LSEQ * 32;
    const int lane = C.lane, hl = lane >> 3;
    for (int r0 = C.wg * 8 + C.wave; r0 < M; r0 += C.G * 16) {
        int rows[2]; bool ok[2]; rows[0] = r0; ok[0] = true; rows[1] = r0 + C.G * 8; ok[1] = rows[1] < M; if (!ok[1]) rows[1] = r0;
        u32x2 m1w[2], m2w[2];
#pragma unroll
        for (int rr = 0; rr < 2; ++rr) { const bf16_t* mb = Q + (size_t)rows[rr] * 1536 + hl * 192 + 128 + (lane & 7) * 4; m1w[rr] = *(const u32x2*)mb; m2w[rr] = *(const u32x2*)(mb + 32); }
#pragma unroll
        for (int rr = 0; rr < 2; ++rr) { if (!ok[rr]) continue;
            const int pos = rows[rr] % LSEQ; bf16_t* base = Q + (size_t)rows[rr] * 1536 + hl * 192 + 128 + (lane & 7) * 4; const u32x2 w1 = m1w[rr], w2 = m2w[rr];
            const f32x4 c4 = *(const f32x4*)(cm + pos * 32 + (lane & 7) * 4), s4 = *(const f32x4*)(sm + pos * 32 + (lane & 7) * 4);
            const float x1[4] = {bflo(w1.x), bfhi(w1.x), bflo(w1.y), bfhi(w1.y)}, x2[4] = {bflo(w2.x), bfhi(w2.x), bflo(w2.y), bfhi(w2.y)};
            float o1[4], o2[4];
#pragma unroll
            for (int i = 0; i < 4; ++i) { o1[i] = x1[i] * c4[i] - x2[i] * s4[i]; o2[i] = x2[i] * c4[i] + x1[i] * s4[i]; }
            *(u32x2*)base = (u32x2){cvt_pk_bf16(o1[0], o1[1]), cvt_pk_bf16(o1[2], o1[3])}; *(u32x2*)(base + 32) = (u32x2){cvt_pk_bf16(o2[0], o2[1]), cvt_pk_bf16(o2[2], o2[3])}; }
    }
}
__device__ __forceinline__ void ph_post(const Ctx& C, int l) {
    unsigned char* rw = C.ws + WS_RW; const float* YR = (const float*)(rw + RW_YRAW);
    const bf16_t* Gb = (const bf16_t*)(rw + RW_A + 1 * RW_ARR); const float* BS = (const float*)(rw + RW_A + 2 * RW_ARR); const bf16_t* P = WSP(bf16_t, WS_P);
    bf16_t* YA = WSP(bf16_t, WS_YBR);
    const float* mu_v = inp(C, IN_MU) + (size_t)l * RW_COLS + 2048; const float* ln_w = inp(C, IN_LN_W) + l * 1024; const float* ln_b = inp(C, IN_LN_B) + l * 1024;
    const int lane = C.lane, hl = lane >> 3, c8 = (lane & 7) * 8;
    for (int r0 = C.wg * 8 + C.wave; r0 < MP; r0 += C.G * 16) {
        int rows[2]; bool live[2]; rows[0] = r0; rows[1] = r0 + C.G * 8; live[0] = rows[0] < M; live[1] = rows[1] < M;
#pragma unroll
        for (int rr = 0; rr < 2; ++rr) if (rows[rr] < MP && !live[rr]) { const u32x4 z = zero4u(); *(u32x4*)(YA + (size_t)rows[rr] * 1024 + 16 * lane) = z; *(u32x4*)(YA + (size_t)rows[rr] * 1024 + 16 * lane + 8) = z; }
        u32x4 wv_[2][2], wp_[2][2], wg_[2][2]; f32x4 ya[2][2], yb[2][2]; float bsv[2][2], hpf[2];
#pragma unroll
        for (int rr = 0; rr < 2; ++rr) { const int row = live[rr] ? rows[rr] : 0; const bool hp = (row % LSEQ) > 0; hpf[rr] = hp ? 1.0f : 0.0f;
            const bf16_t* pr = P + (size_t)row * PN + 2048; const bf16_t* pp = hp ? pr - PN : pr;
#pragma unroll
            for (int ps = 0; ps < 2; ++ps) { const int c = (8 * ps + hl) * 64 + c8; const size_t o = (size_t)row * 1024 + c;
                ya[rr][ps] = *(const f32x4*)(YR + o); yb[rr][ps] = *(const f32x4*)(YR + o + 4); wv_[rr][ps] = *(const u32x4*)(pr + c); wp_[rr][ps] = *(const u32x4*)(pp + c); wg_[rr][ps] = *(const u32x4*)(Gb + o);
                bsv[rr][ps] = BS[(size_t)row * 16 + 8 * ps + hl]; } }
#pragma unroll
        for (int ps = 0; ps < 2; ++ps) {
            const int c = (8 * ps + hl) * 64 + c8; float mv[8], lw[8], lb[8];
            ld8f(mu_v + c, mv); ld8f(ln_w + c, lw); ld8f(ln_b + c, lb);
#pragma unroll
            for (int rr = 0; rr < 2; ++rr) {
                float y[8] = {ya[rr][ps][0], ya[rr][ps][1], ya[rr][ps][2], ya[rr][ps][3], yb[rr][ps][0], yb[rr][ps][1], yb[rr][ps][2], yb[rr][ps][3]}, zv[8], qv[8], gg[8], out[8];
                unpack8(wv_[rr][ps], zv); unpack8(wp_[rr][ps], qv); unpack8(wg_[rr][ps], gg);
                const float bs = bsv[rr][ps];
                float s = 0.f;
#pragma unroll
                for (int i = 0; i < 8; ++i) s += y[i];
                const float mean = sum8(s) * (1.0f / 64.0f);
                float q = 0.f;
#pragma unroll
                for (int i = 0; i < 8; ++i) { y[i] -= mean; q += y[i] * y[i]; }
                const float rstd = rsqrtf(sum8(q) * (1.0f / 64.0f) + GN_EPS);
#pragma unroll
                for (int i = 0; i < 8; ++i) { const float vv = zv[i] + (qv[i] * hpf[rr] - zv[i]) * mv[i]; out[i] = (y[i] * rstd * lw[i] + lb[i] + bs * vv) * gg[i]; }
                if (live[rr]) *(u32x4*)(YA + (size_t)rows[rr] * 1024 + c) = pack8(out);
            }
        }
    }
}

#define MFMA_DRAIN(acc) asm volatile("s_nop 15\n\ts_nop 4" : "+v"(acc))
__device__ __forceinline__ void ph_rwkvpre(const Ctx& C, int l) {
    constexpr int WSC = 10240;
    LAS unsigned char* sc = C.lds + C.wave * WSC;
    LAS float* Gm = (LAS float*)sc;
    LAS float* TM = (LAS float*)(sc + 4608);
    LAS float* TMT = TM + 256; LAS float* FT = TM + 512; LAS float* W2 = TM + 768; LAS float* YBT = TM + 1024;
    unsigned char* rw = C.ws + WS_RW;
    const float* WD = (const float*)(rw + RW_WDEC); const bf16_t* Ag = (const bf16_t*)(rw + RW_A); const bf16_t* P = WSP(bf16_t, WS_P);
    float* BS = (float*)(rw + RW_A + 2 * RW_ARR);
    const float* mu = inp(C, IN_MU) + (size_t)l * RW_COLS; const float* k_k = inp(C, IN_K_K) + l * 1024; const float* k_a = inp(C, IN_K_A) + l * 1024; const float* r_k = inp(C, IN_R_K) + l * 1024;
    unsigned char* RCH = C.ws + WS_RCH;
    const int lane = C.lane, ql = lane & 31, hh = lane >> 5, t = lane & 15, q4 = (lane >> 4) * 4;
    for (int u = C.wg * 8 + C.wave; u < NB * 16 * NCHUNK; u += C.G * 8) {
        const int bh = u / NCHUNK, c = u - bh * NCHUNK;
        const int hd = bh & 15, chn = hd * 64 + lane; const size_t row0 = (size_t)(bh >> 4) * LSEQ + 16 * c;
        unsigned char* rec = RCH + (size_t)u * RC_STRIDE;
        float Kb[16], Rb[16], Kh[16], Bh[16]; unsigned vpk[8]; float gC;
        {
            unsigned short zr[17], zk[17], zv[17], za[16]; float wv[16];
#pragma unroll
            for (int i = 0; i < 17; ++i) { const size_t pr = (row0 + (size_t)((i == 0 && c == 0) ? 0 : i - 1)) * PN + chn; zr[i] = P[pr]; zk[i] = P[pr + 1024]; zv[i] = P[pr + 2048]; }
#pragma unroll
            for (int i = 0; i < 16; ++i) { const size_t o = (row0 + i) * 1024 + chn; za[i] = Ag[o]; wv[i] = WD[o]; }
            const float mur = mu[chn], muk = mu[1024 + chn], muv = mu[2048 + chn], kkc = k_k[chn], kac = k_a[chn], rkc = r_k[chn];
            float g = 1.0f; float vxs[16]; int bsv = 0;
#pragma unroll
            for (int i = 0; i < 16; ++i) {
                const float hp = (i == 0 && c == 0) ? 0.0f : 1.0f;
                const float cr = bf2f(zr[i + 1]), ck = bf2f(zk[i + 1]), cv = bf2f(zv[i + 1]);
                const float rr = cr + (bf2f(zr[i]) * hp - cr) * mur, kx = ck + (bf2f(zk[i]) * hp - ck) * muk, vx = cv + (bf2f(zv[i]) * hp - cv) * muv;
                const float av = bf2f(za[i]);
                float kkx = kx * kkc; const float n2 = wsum64_dpp(kkx * kkx); kkx *= __builtin_amdgcn_rsqf(fmaxf(n2, 1e-24f));
                const float kpx = kx * (1.0f + (av - 1.0f) * kac), bbx = kkx * av;
                const float bs = wsum64_dpp(rr * kpx * rkc); bsv = (lane == i) ? __float_as_int(bs) : bsv;
                const float gp = g; g *= wv[i]; const float ig = __builtin_amdgcn_rcpf(g);
                Kb[i] = kkx * gp; Rb[i] = rr * g; Kh[i] = kpx * ig; Bh[i] = bbx * ig;
                vxs[i] = vx;
                *(LAS bf16_t*)(sc + i * 144 + lane * 2) = f2bf(Kh[i]); *(LAS bf16_t*)(sc + (16 + i) * 144 + lane * 2) = f2bf(Bh[i]);
                *(LAS bf16_t*)(sc + 4608 + i * 144 + lane * 2) = f2bf(Kb[i]); *(LAS bf16_t*)(sc + 4608 + (16 + i) * 144 + lane * 2) = f2bf(Rb[i]); }
#pragma unroll
            for (int i = 0; i < 16; ++i) { Kh[i] *= g; Bh[i] *= g; }
            gC = g;
#pragma unroll
            for (int i = 0; i < 8; ++i) vpk[i] = cvt_pk_bf16(vxs[2 * i], vxs[2 * i + 1]);
            if (lane < 16) BS[(row0 + lane) * 16 + hd] = __int_as_float(bsv);
        }
        __builtin_amdgcn_wave_barrier();
        {
            f32x16 acc;
#pragma unroll
            for (int r = 0; r < 16; ++r) acc[r] = 0.f;
#pragma unroll
            for (int s = 0; s < 4; ++s) { const bf16x8 a = *(const LAS bf16x8*)(sc + ql * 144 + 32 * s + 16 * hh); const bf16x8 bq = *(const LAS bf16x8*)(sc + 4608 + ql * 144 + 32 * s + 16 * hh);
                acc = __builtin_amdgcn_mfma_f32_32x32x16_bf16(a, bq, acc, 0, 0, 0); }
            __builtin_amdgcn_wave_barrier();
#pragma unroll
            for (int r = 0; r < 16; ++r) { const int row = (r & 3) + 8 * (r >> 2) + 4 * hh, i = row & 15; const bool keep = (ql >= 16) ? (i <= (ql & 15)) : (i < ql); Gm[row * 36 + ql] = keep ? acc[r] : 0.f; }
        }
        __builtin_amdgcn_wave_barrier();
        {
            float X[16];
#pragma unroll
            for (int i = 15; i >= 0; --i) { float x = (t == i) ? 1.0f : 0.0f; const LAS float* er = Gm + (16 + i) * 36;
#pragma unroll
                for (int j = i + 1; j < 16; ++j) x -= er[j] * X[j];
                X[i] = x; }
#pragma unroll
            for (int i = 0; i < 16; ++i) TM[i * 16 + t] = X[i];
#pragma unroll
            for (int i = 0; i < 4; ++i) *(LAS f32x4*)(TMT + t * 16 + 4 * i) = (f32x4){X[4 * i], X[4 * i + 1], X[4 * i + 2], X[4 * i + 3]};
            float E2c[16];
#pragma unroll
            for (int j = 0; j < 16; ++j) E2c[j] = Gm[(16 + j) * 36 + 16 + t];
#pragma unroll
            for (int e = 0; e < 4; ++e) { const LAS float* ar = Gm + (q4 + e) * 36; float s = 0.f;
#pragma unroll
                for (int i = 0; i < 16; ++i) s += ar[i] * X[i];
                W2[(q4 + e) * 16 + t] = s; }
            __builtin_amdgcn_wave_barrier();
            f32x4 fv, yv;
#pragma unroll
            for (int e = 0; e < 4; ++e) { const LAS float* tr = TM + (q4 + e) * 16; const LAS float* wr = W2 + (q4 + e) * 16; float s = 0.f, y = Gm[(q4 + e) * 36 + 16 + t];
#pragma unroll
                for (int j = 0; j < 16; ++j) { s += tr[j] * E2c[j]; y -= wr[j] * E2c[j]; }
                fv[e] = s; yv[e] = y; }
            *(LAS f32x4*)(FT + t * 16 + q4) = fv; *(LAS f32x4*)(YBT + t * 16 + q4) = yv;
        }
        __builtin_amdgcn_wave_barrier();
        {
            { unsigned char* b2 = rec + RC_B2 + lane * 80;
              *(u32x4*)(b2) = (u32x4){cvt_pk_bf16(-Bh[0], -Bh[1]), cvt_pk_bf16(-Bh[2], -Bh[3]), cvt_pk_bf16(-Bh[4], -Bh[5]), cvt_pk_bf16(-Bh[6], -Bh[7])};
              *(u32x4*)(b2 + 16) = (u32x4){cvt_pk_bf16(-Bh[8], -Bh[9]), cvt_pk_bf16(-Bh[10], -Bh[11]), cvt_pk_bf16(-Bh[12], -Bh[13]), cvt_pk_bf16(-Bh[14], -Bh[15])}; }
            u32x4 kb0, kb1, rb0, rb1, bh0, bh1, kh0, kh1;
#define RC_BOP(src_, t0_, t1_) do { _Pragma("unroll") for (int e = 0; e < 4; ++e) { const unsigned x_ = cvt_pk_bf16(src_[2 * e], src_[2 * e + 1]), y_ = cvt_pk_bf16(src_[8 + 2 * e], src_[9 + 2 * e]); \
                const auto sw_ = __builtin_amdgcn_permlane32_swap(x_, y_, false, false); t0_[e] = sw_[0]; t1_[e] = sw_[1]; } } while (0)
            RC_BOP(Kb, kb0, kb1); RC_BOP(Rb, rb0, rb1); RC_BOP(Bh, bh0, bh1); RC_BOP(Kh, kh0, kh1);
#undef RC_BOP
            const bool lo16 = ql < 16; const int m16 = ql & 15;
            u32x4 aPA, aPB, aIlo, aIhi;
            { const LAS float* ap = (lo16 ? TMT : FT) + m16 * 16 + 8 * hh; const f32x4 a0 = *(const LAS f32x4*)ap, a1 = *(const LAS f32x4*)(ap + 4); const float sg = lo16 ? 1.0f : -1.0f;
              aPA = (u32x4){cvt_pk_bf16(a0[0] * sg, a0[1] * sg), cvt_pk_bf16(a0[2] * sg, a0[3] * sg), cvt_pk_bf16(a1[0] * sg, a1[1] * sg), cvt_pk_bf16(a1[2] * sg, a1[3] * sg)};
              const LAS float* wp = W2 + m16 * 16 + 8 * hh; const f32x4 w0 = *(const LAS f32x4*)wp, w1 = *(const LAS f32x4*)(wp + 4); const float sw = lo16 ? -1.0f : 0.0f;
              aPB = (u32x4){cvt_pk_bf16(w0[0] * sw, w0[1] * sw), cvt_pk_bf16(w0[2] * sw, w0[3] * sw), cvt_pk_bf16(w1[0] * sw, w1[1] * sw), cvt_pk_bf16(w1[2] * sw, w1[3] * sw)};
#pragma unroll
              for (int e = 0; e < 4; ++e) { const unsigned idv = (m16 == 8 * hh + 2 * e ? 0x3F80u : 0u) | (m16 == 8 * hh + 2 * e + 1 ? 0x3F800000u : 0u); aIlo[e] = lo16 ? idv : 0u; aIhi[e] = lo16 ? 0u : idv; } }
            bf16x8 fa, fb, fc, fi;
            bf16_t* b1 = (bf16_t*)rec + ql + (4 * hh) * 88;
            unsigned char* q0 = rec + RC_B2 + ql * 80 + 32 + 8 * hh;
            __builtin_memcpy(&fa, &aPA, 16); __builtin_memcpy(&fi, &aIhi, 16);
#pragma unroll
            for (int T = 0; T < 2; ++T) {
                f32x16 pa;
#pragma unroll
                for (int r = 0; r < 16; ++r) pa[r] = 0.f;
                __builtin_memcpy(&fb, T ? &kb1 : &kb0, 16); __builtin_memcpy(&fc, T ? &rb1 : &rb0, 16);
                pa = __builtin_amdgcn_mfma_f32_32x32x16_bf16(fa, fb, pa, 0, 0, 0); pa = __builtin_amdgcn_mfma_f32_32x32x16_bf16(fi, fc, pa, 0, 0, 0);
                MFMA_DRAIN(pa);
#pragma unroll
                for (int r = 0; r < 16; ++r) b1[((r & 3) + 8 * (r >> 2)) * 88 + 32 * T] = f2bf(pa[r]);
            }
            __builtin_memcpy(&fa, &aPB, 16); __builtin_memcpy(&fi, &aIlo, 16);
#pragma unroll
            for (int T = 0; T < 2; ++T) {
                f32x16 pb;
#pragma unroll
                for (int r = 0; r < 16; ++r) pb[r] = 0.f;
                __builtin_memcpy(&fb, T ? &bh1 : &bh0, 16); __builtin_memcpy(&fc, T ? &kh1 : &kh0, 16);
                pb = __builtin_amdgcn_mfma_f32_32x32x16_bf16(fa, fb, pb, 0, 0, 0); pb = __builtin_amdgcn_mfma_f32_32x32x16_bf16(fi, fc, pb, 0, 0, 0);
                MFMA_DRAIN(pb);
                *(u32x2*)(q0 + T * 32 * 80) = (u32x2){cvt_pk_bf16(pb[0], pb[1]), cvt_pk_bf16(pb[2], pb[3])}; *(u32x2*)(q0 + T * 32 * 80 + 16) = (u32x2){cvt_pk_bf16(pb[4], pb[5]), cvt_pk_bf16(pb[6], pb[7])};
            }
            { const int tr_ = lane >> 2, part = lane & 3; const f32x4 y4 = *(const LAS f32x4*)(YBT + tr_ * 16 + 4 * part);
              unsigned zz; asm volatile("v_mov_b32 %0, 0" : "=v"(zz));
              *(u32x2*)(rec + tr_ * 176 + 128 + 8 * part) = (u32x2){zz, zz};
              *(u32x2*)(rec + (16 + tr_) * 176 + 128 + 8 * part) = (u32x2){cvt_pk_bf16(y4[0], y4[1]), cvt_pk_bf16(y4[2], y4[3])}; }
            unsigned char* vt = rec + RC_VT + lane * 48;
            *(u32x4*)(vt) = (u32x4){vpk[0], vpk[1], vpk[2], vpk[3]}; *(u32x4*)(vt + 16) = (u32x4){vpk[4], vpk[5], vpk[6], vpk[7]};
            *(float*)(rec + RC_G + 4 * lane) = gC;
        }
        __builtin_amdgcn_wave_barrier();
    }
    __syncthreads();
}

#define SEQ_BAR() asm volatile("s_waitcnt lgkmcnt(0)\n\ts_barrier" ::: "memory")
__device__ __forceinline__ void rwkv_seq_unit(const Ctx& C, int b, int hd) {
    constexpr int NR = 8, PF = 6;
    LAS unsigned char* ring = C.lds; LAS unsigned char* Zi = C.lds + NR * RC_STRIDE; LAS unsigned char* Ui = Zi + 64 * 144;
    const unsigned char* recs = C.ws + WS_RCH + (size_t)(b * 16 + hd) * NCHUNK * RC_STRIDE;
    float* YR = (float*)(C.ws + WS_RW + RW_YRAW) + (size_t)b * LSEQ * 1024 + hd * 64;
    const int tid = C.tid, w = C.wave, lane = C.lane, ql = lane & 31, hh = lane >> 5;
    const int lw = w - 4;
    for (int i = tid; i < 576; i += 512) *(LAS u32x4*)(Zi + 16 * i) = zero4u();
    auto issue = [&](int c) {
        const unsigned char* src = recs + (size_t)c * RC_STRIDE + lane * 16; LAS unsigned char* dst = ring + (c & (NR - 1)) * RC_STRIDE;
#pragma unroll
        for (int k = 0; k < 4; ++k) { const int q = lw + 4 * k; if (q < 14) __builtin_amdgcn_global_load_lds((const unsigned*)(src + q * 1024), (LAS unsigned*)(dst + q * 1024), 16, 0, 0); }
    };
    if (w >= 4) {
#pragma unroll
        for (int c = 0; c < PF; ++c) issue(c);
        if (lw < 2) asm volatile("s_waitcnt vmcnt(20)" ::: "memory"); else asm volatile("s_waitcnt vmcnt(15)" ::: "memory");
    }
    f32x16 Zt;
    { float zf; asm volatile("v_mov_b32 %0, 0" : "=v"(zf));
#pragma unroll
      for (int r = 0; r < 16; ++r) Zt[r] = zf; }
    __syncthreads();
    for (int c = 0; c < NCHUNK; ++c) {
        const LAS unsigned char* rec = ring + (c & (NR - 1)) * RC_STRIDE;
        if (w < 2) {
            f32x16 p;
#pragma unroll
            for (int r = 0; r < 16; ++r) p[r] = 0.f;
            const LAS unsigned char* ap = rec + RC_B1 + ql * 176 + hh * 16; const LAS unsigned char* bp = Zi + (32 * w + ql) * 144 + hh * 16;
#pragma unroll
            for (int s = 0; s < 4; ++s) { const bf16x8 a = *(const LAS bf16x8*)(ap + 32 * s); const bf16x8 bq = *(const LAS bf16x8*)(bp + 32 * s); p = __builtin_amdgcn_mfma_f32_32x32x16_bf16(a, bq, p, 0, 0, 0); }
            { const bf16x8 a = *(const LAS bf16x8*)(ap + 128); const bf16x8 bq = *(const LAS bf16x8*)(rec + RC_VT + (32 * w + ql) * 48 + hh * 16); p = __builtin_amdgcn_mfma_f32_32x32x16_bf16(a, bq, p, 0, 0, 0); }
            MFMA_DRAIN(p);
            LAS unsigned char* up = Ui + (32 * w + ql) * 48 + hh * 8;
            *(LAS u32x2*)up = (u32x2){cvt_pk_bf16(p[0], p[1]), cvt_pk_bf16(p[2], p[3])}; *(LAS u32x2*)(up + 16) = (u32x2){cvt_pk_bf16(p[4], p[5]), cvt_pk_bf16(p[6], p[7])};
            float* yp = YR + (size_t)(16 * c + 4 * hh) * 1024 + 32 * w + ql;
#pragma unroll
            for (int r = 8; r < 16; ++r) yp[((r & 3) + 8 * ((r - 8) >> 2)) * 1024] = p[r];
        } else if (w >= 4) {
            if (c + PF < NCHUNK) issue(c + PF);
        }
        SEQ_BAR();
        if (w < 4) {
            const int ti = w >> 1, tj = w & 1;
            const LAS float* gp = (const LAS float*)(rec + RC_G) + 32 * ti + 4 * hh;
#pragma unroll
            for (int q = 0; q < 4; ++q) { const f32x4 g4 = *(const LAS f32x4*)(gp + 8 * q); Zt[4 * q] *= g4[0]; Zt[4 * q + 1] *= g4[1]; Zt[4 * q + 2] *= g4[2]; Zt[4 * q + 3] *= g4[3]; }
            const LAS unsigned char* ap = rec + RC_B2 + (32 * ti + ql) * 80 + hh * 16;
            const bf16x8 a0 = *(const LAS bf16x8*)ap, a1 = *(const LAS bf16x8*)(ap + 32);
            const bf16x8 b0 = *(const LAS bf16x8*)(Ui + (32 * tj + ql) * 48 + hh * 16), b1 = *(const LAS bf16x8*)(rec + RC_VT + (32 * tj + ql) * 48 + hh * 16);
            Zt = __builtin_amdgcn_mfma_f32_32x32x16_bf16(a0, b0, Zt, 0, 0, 0);
            Zt = __builtin_amdgcn_mfma_f32_32x32x16_bf16(a1, b1, Zt, 0, 0, 0);
            MFMA_DRAIN(Zt);
            LAS unsigned char* zp = Zi + (32 * tj + ql) * 144 + (32 * ti + 4 * hh) * 2;
#pragma unroll
            for (int q = 0; q < 4; ++q) *(LAS u32x2*)(zp + 16 * q) = (u32x2){cvt_pk_bf16(Zt[4 * q], Zt[4 * q + 1]), cvt_pk_bf16(Zt[4 * q + 2], Zt[4 * q + 3])};
        } else {
            if (c + PF < NCHUNK) { if (lw < 2) asm volatile("s_waitcnt vmcnt(20)" ::: "memory"); else asm volatile("s_waitcnt vmcnt(15)" ::: "memory"); }
            else asm volatile("s_waitcnt vmcnt(0)" ::: "memory");
        }
        SEQ_BAR();
    }
}

template <int MODE>
__device__ __forceinline__ void attn_unit(const Ctx& C, int b, int hd, int qblk) {
    constexpr int DQ = MODE == 0 ? 192 : 128, NS = DQ / 16, KP = DQ * 2 + 16, VP = 136;
    constexpr int KB_BYTES = 64 * KP, VB_BYTES = 128 * VP, NKPC = 64 * (DQ / 8) / 512;
    LAS unsigned char* Kb = C.lds; LAS unsigned char* Vbuf = C.lds + 2 * KB_BYTES;
    const bf16_t* P = WSP(bf16_t, WS_P); const bf16_t* Qm = WSP(bf16_t, WS_Q); const bf16_t* KN = WSP(bf16_t, WS_KNOPE); const bf16_t* KRp = WSP(bf16_t, WS_KR);
    const bf16_t* VT = MODE == 0 ? WSP(bf16_t, WS_VTMLA) : WSP(bf16_t, WS_VTRET);
    bf16_t* Y = WSP(bf16_t, WS_YBR) + (MODE == 0 ? 2 : 1) * (size_t)MP * 1024;
    const int tid = C.tid, w = C.wave, lane = C.lane, ql = lane & 31, hh = lane >> 5;
    const size_t rb = (size_t)b * LSEQ;
    const int qpos = 256 * qblk + 32 * w + ql; const bool qvalid = qpos < LSEQ; const int qposc = qvalid ? qpos : LSEQ - 1;
    const int wqmin = 256 * qblk + 32 * w; const bool wactive = wqmin < LSEQ; const int wqmax = (wqmin + 31 < LSEQ - 1) ? wqmin + 31 : LSEQ - 1;
    const int nkt = (4 * qblk + 4 < 65) ? 4 * qblk + 4 : 65;
    const int j0 = MODE == 1 ? 4 * qblk : 0;
    bf16x8 Qf[NS];
    { const bf16_t* qrow = MODE == 0 ? Qm + (rb + qposc) * 1536 + hd * 192 : P + (rb + qposc) * PN + P_QRET + hd * 128;
#pragma unroll
      for (int s = 0; s < NS; ++s) Qf[s] = *(const bf16x8*)(qrow + 16 * s + 8 * hh); }
    if (MODE == 1) {
        const float* rt = WSP(float, WS_ROPE);
        constexpr int NP = MODE == 0 ? 2 : 4, S0 = MODE == 0 ? 8 : 0, DS = MODE == 0 ? 2 : 4;
        const float* cp = MODE == 0 ? rt + (size_t)qposc * 32 + 8 * hh : rt + (size_t)LSEQ * 64 + (size_t)qposc * 64 + 8 * hh;
        const float* sp = MODE == 0 ? rt + (size_t)LSEQ * 32 + (size_t)qposc * 32 + 8 * hh : rt + (size_t)LSEQ * 128 + (size_t)qposc * 64 + 8 * hh;
#pragma unroll
        for (int s = 0; s < NP; ++s) { u32x4 w1, w2; __builtin_memcpy(&w1, &Qf[S0 + s], 16); __builtin_memcpy(&w2, &Qf[S0 + s + DS], 16);
            float x1[8], x2[8], cc[8], ss[8], o1[8], o2[8]; unpack8(w1, x1); unpack8(w2, x2); ld8f(cp + 16 * s, cc); ld8f(sp + 16 * s, ss);
#pragma unroll
            for (int e = 0; e < 8; ++e) { o1[e] = x1[e] * cc[e] - x2[e] * ss[e]; o2[e] = x2[e] * cc[e] + x1[e] * ss[e]; }
            w1 = pack8(o1); w2 = pack8(o2); __builtin_memcpy(&Qf[S0 + s], &w1, 16); __builtin_memcpy(&Qf[S0 + s + DS], &w2, 16); }
    }
    f32x16 O[4];
#pragma unroll
    for (int d = 0; d < 4; ++d)
#pragma unroll
        for (int r = 0; r < 16; ++r) O[d][r] = 0.f;
    float m_run = -INFINITY, lsum = 0.f;
    const float csm = 0.07216878364870322f * 1.4426950408889634f;
    const float lg2g = MODE == 1 ? log1pf(-exp2f(-5.0f - (float)hd)) * 1.4426950408889634f : 0.f;
    u32x4 kreg[NKPC], vreg[2];
    auto gload = [&](int j) {
#pragma unroll
        for (int i = 0; i < NKPC; ++i) { const int pi = tid + i * 512, r = pi / (DQ / 8), c = pi % (DQ / 8); const size_t krow = rb + 64 * j + r;
            const bf16_t* sp;
            if (MODE == 0) sp = (c < 16) ? KN + krow * 1024 + hd * 128 + 8 * c : KRp + krow * 64 + 8 * (c - 16);
            else sp = P + krow * PN + P_KRET + hd * 128 + 8 * c;
            kreg[i] = *(const u32x4*)sp; }
#pragma unroll
        for (int i = 0; i < 2; ++i) { const int pi = tid + i * 512, dv = pi >> 3, c = pi & 7; vreg[i] = *(const u32x4*)(VT + (size_t)(hd * 128 + dv) * MP + rb + 64 * j + 8 * c); }
    };
    auto lstore = [&](int buf) {
#pragma unroll
        for (int i = 0; i < NKPC; ++i) { const int pi = tid + i * 512, r = pi / (DQ / 8), c = pi % (DQ / 8); *(LAS u32x4*)(Kb + buf * KB_BYTES + r * KP + 16 * c) = kreg[i]; }
#pragma unroll
        for (int i = 0; i < 2; ++i) { const int pi = tid + i * 512, dv = pi >> 3, c = pi & 7; LAS unsigned char* dp = Vbuf + buf * VB_BYTES + dv * VP + 16 * c;
            *(LAS u32x2*)dp = (u32x2){vreg[i].x, vreg[i].y}; *(LAS u32x2*)(dp + 8) = (u32x2){vreg[i].z, vreg[i].w}; }
    };
    gload(j0);
    if (MODE == 1 && qblk > 0) {
        constexpr int RP = 272; LAS unsigned char* RT = C.lds + 2 * KB_BYTES + 2 * VB_BYTES;
        const float* KVT = WSP(float, WS_KVT) + (size_t)((b * 8 + hd) * 16) * 16384;
        const int dvr = tid >> 2, d0 = (tid & 3) * 32;
        f32x4 acc8[8];
#pragma unroll
        for (int i = 0; i < 8; ++i) acc8[i] = (f32x4){0.f, 0.f, 0.f, 0.f};
#pragma unroll 2
        for (int kp = 0; kp < qblk; ++kp) { const float f = __builtin_amdgcn_exp2f(lg2g * 256.0f * (float)(qblk - 1 - kp)); const float* sp = KVT + (size_t)kp * 16384 + dvr * 128 + d0;
#pragma unroll
            for (int i = 0; i < 8; ++i) acc8[i] = acc8[i] + *(const f32x4*)(sp + 4 * i) * f; }
#pragma unroll
        for (int i = 0; i < 4; ++i) { u32x4 wv; wv.x = cvt_pk_bf16(acc8[2 * i][0], acc8[2 * i][1]); wv.y = cvt_pk_bf16(acc8[2 * i][2], acc8[2 * i][3]); wv.z = cvt_pk_bf16(acc8[2 * i + 1][0], acc8[2 * i + 1][1]); wv.w = cvt_pk_bf16(acc8[2 * i + 1][2], acc8[2 * i + 1][3]);
            *(LAS u32x4*)(RT + dvr * RP + (d0 + 8 * i) * 2) = wv; }
        __syncthreads();
        if (wactive) {
#pragma unroll
            for (int d = 0; d < 4; ++d)
#pragma unroll
                for (int s = 0; s < NS; ++s) { const bf16x8 a = *(const LAS bf16x8*)(RT + (32 * d + ql) * RP + (16 * s + 8 * hh) * 2); O[d] = __builtin_amdgcn_mfma_f32_32x32x16_bf16(a, Qf[s], O[d], 0, 0, 0); }
            const float fq = __builtin_amdgcn_exp2f(lg2g * (float)(qposc - 256 * qblk + 1));
#pragma unroll
            for (int d = 0; d < 4; ++d)
#pragma unroll
                for (int r = 0; r < 16; ++r) O[d][r] *= fq;
        }
    }
    lstore(0);
    __syncthreads();
    for (int j = j0; j < nkt; ++j) {
        if (j + 1 < nkt) gload(j + 1);
        if (wactive && 64 * j <= wqmax) {
            const LAS unsigned char* kb = Kb + ((j - j0) & 1) * KB_BYTES; const LAS unsigned char* vb = Vbuf + ((j - j0) & 1) * VB_BYTES;
            f32x16 st[2];
#pragma unroll
            for (int kt = 0; kt < 2; ++kt) {
#pragma unroll
                for (int r = 0; r < 16; ++r) st[kt][r] = 0.f;
#pragma unroll
                for (int s = 0; s < NS; ++s) { const bf16x8 a = *(const LAS bf16x8*)(kb + (32 * kt + ql) * KP + (16 * s + 8 * hh) * 2); st[kt] = __builtin_amdgcn_mfma_f32_32x32x16_bf16(a, Qf[s], st[kt], 0, 0, 0); }
            }
            const int kbase = 64 * j + 4 * hh;
            if (MODE == 0) {
                if (64 * j + 63 > wqmin) {
#pragma unroll
                    for (int kt = 0; kt < 2; ++kt)
#pragma unroll
                        for (int r = 0; r < 16; ++r) { const int kpos = kbase + 32 * kt + (r & 3) + 8 * (r >> 2); if (kpos > qposc) st[kt][r] = -INFINITY; }
                }
                float tm0 = fmaxf(st[0][0], st[1][0]), tm1 = fmaxf(st[0][1], st[1][1]);
#pragma unroll
                for (int r = 2; r < 16; r += 2) { tm0 = fmaxf(tm0, fmaxf(st[0][r], st[1][r])); tm1 = fmaxf(tm1, fmaxf(st[0][r + 1], st[1][r + 1])); }
                const float tmax = hmax32(fmaxf(tm0, tm1));
                if (__builtin_amdgcn_ballot_w64(tmax > m_run) != 0ull) {
                    const float m_new = fmaxf(m_run, tmax);
                    const float alpha = __builtin_amdgcn_exp2f((m_run - m_new) * csm);
                    m_run = m_new; lsum *= alpha;
#pragma unroll
                    for (int d = 0; d < 4; ++d)
#pragma unroll
                        for (int r = 0; r < 16; ++r) O[d][r] *= alpha;
                }
                const float mb = m_run * csm;
                float ps = 0.f;
#pragma unroll
                for (int kt = 0; kt < 2; ++kt)
#pragma unroll
                    for (int r = 0; r < 16; ++r) { const float p = __builtin_amdgcn_exp2f(st[kt][r] * csm - mb); st[kt][r] = p; ps += p; }
                lsum += ps;
            } else {
#pragma unroll
                for (int kt = 0; kt < 2; ++kt)
#pragma unroll
                    for (int r = 0; r < 16; ++r) { const int kpos = kbase + 32 * kt + (r & 3) + 8 * (r >> 2); const int dd = qposc - kpos;
                        st[kt][r] = dd >= 0 ? st[kt][r] * __builtin_amdgcn_exp2f(lg2g * (float)dd) : 0.f; }
            }
#pragma unroll
            for (int kt = 0; kt < 2; ++kt)
#pragma unroll
                for (int s2 = 0; s2 < 2; ++s2) {
                    u32x4 pw; pw.x = cvt_pk_bf16(st[kt][8 * s2 + 0], st[kt][8 * s2 + 1]); pw.y = cvt_pk_bf16(st[kt][8 * s2 + 2], st[kt][8 * s2 + 3]);
                    pw.z = cvt_pk_bf16(st[kt][8 * s2 + 4], st[kt][8 * s2 + 5]); pw.w = cvt_pk_bf16(st[kt][8 * s2 + 6], st[kt][8 * s2 + 7]);
                    bf16x8 pf; __builtin_memcpy(&pf, &pw, 16);
#pragma unroll
                    for (int d = 0; d < 4; ++d) { const LAS unsigned char* ap = vb + (32 * d + ql) * VP + (32 * kt + 16 * s2 + 4 * hh) * 2;
                        const u32x2 lo = *(const LAS u32x2*)ap, hi = *(const LAS u32x2*)(ap + 16); u32x4 aw = (u32x4){lo.x, lo.y, hi.x, hi.y}; bf16x8 af; __builtin_memcpy(&af, &aw, 16);
                        O[d] = __builtin_amdgcn_mfma_f32_32x32x16_bf16(af, pf, O[d], 0, 0, 0); }
                }
        }
        if (j + 1 < nkt) lstore((j + 1 - j0) & 1);
        __syncthreads();
    }
    if (MODE == 0) {
        const float lt = hsum32(lsum); const float inv = 1.0f / lt;
        if (qvalid) { bf16_t* yp = Y + (rb + qpos) * 1024 + hd * 128;
#pragma unroll
            for (int d = 0; d < 4; ++d)
#pragma unroll
                for (int rg = 0; rg < 4; ++rg) { const int dv0 = 32 * d + 8 * rg + 4 * hh;
                    *(u32x2*)(yp + dv0) = (u32x2){cvt_pk_bf16(O[d][4 * rg] * inv, O[d][4 * rg + 1] * inv), cvt_pk_bf16(O[d][4 * rg + 2] * inv, O[d][4 * rg + 3] * inv)}; } }
    } else {
        u32x2 gws[4][4];
        { const bf16_t* gp = P + (rb + qposc) * PN + P_GRET + hd * 128 + 4 * hh;
#pragma unroll
          for (int d = 0; d < 4; ++d)
#pragma unroll
              for (int rg = 0; rg < 4; ++rg) gws[d][rg] = *(const u32x2*)(gp + 32 * d + 8 * rg); }
        float ss = 0.f;
#pragma unroll
        for (int d = 0; d < 4; ++d)
#pragma unroll
            for (int r = 0; r < 16; ++r) ss += O[d][r] * O[d][r];
        ss = hsum32(ss); const float rstd = rsqrtf(ss * (1.0f / 128.0f) + NORM_EPS);
        if (qvalid) { bf16_t* yp = Y + (rb + qpos) * 1024 + hd * 128;
#pragma unroll
            for (int d = 0; d < 4; ++d)
#pragma unroll
                for (int rg = 0; rg < 4; ++rg) { const int dv0 = 32 * d + 8 * rg + 4 * hh; const u32x2 gw = gws[d][rg];
                    const float g0 = bflo(gw.x), g1 = bfhi(gw.x), g2 = bflo(gw.y), g3 = bfhi(gw.y);
                    const float o0 = O[d][4 * rg] * rstd * g0 * sigmoidf_(g0), o1 = O[d][4 * rg + 1] * rstd * g1 * sigmoidf_(g1), o2 = O[d][4 * rg + 2] * rstd * g2 * sigmoidf_(g2), o3 = O[d][4 * rg + 3] * rstd * g3 * sigmoidf_(g3);
                    *(u32x2*)(yp + dv0) = (u32x2){cvt_pk_bf16(o0, o1), cvt_pk_bf16(o2, o3)}; } }
    }
}

__device__ __forceinline__ void ph_retkv(const Ctx& C) {
    constexpr int VP = 136, TB = 128 * VP;
    LAS unsigned char* Vb = C.lds; LAS unsigned char* Kt = C.lds + TB;
    const bf16_t* P = WSP(bf16_t, WS_P); const bf16_t* VT = WSP(bf16_t, WS_VTRET); float* KVT = WSP(float, WS_KVT);
    const int tid = C.tid, w = C.wave, lane = C.lane, ql = lane & 31, hh = lane >> 5;
    for (int u = C.wg; u < NB * 8 * 16; u += C.G) {
        const int b = u >> 7, hd = (u >> 4) & 7, kb = u & 15; const size_t rb = (size_t)b * LSEQ + 256 * kb;
        const float lg2g = log1pf(-exp2f(-5.0f - (float)hd)) * 1.4426950408889634f;
        f32x16 acc[2];
#pragma unroll
        for (int r = 0; r < 16; ++r) { acc[0][r] = 0.f; acc[1][r] = 0.f; }
        for (int j = 0; j < 4; ++j) {
            __syncthreads();
#pragma unroll
            for (int i = 0; i < 2; ++i) { const int pi = tid + i * 512;
                { const int dv = pi >> 3, c = pi & 7; const u32x4 v = *(const u32x4*)(VT + (size_t)(hd * 128 + dv) * MP + rb + 64 * j + 8 * c); LAS unsigned char* dp = Vb + dv * VP + 16 * c;
                  *(LAS u32x2*)dp = (u32x2){v.x, v.y}; *(LAS u32x2*)(dp + 8) = (u32x2){v.z, v.w}; }
                { const int key = pi >> 4, c = pi & 15; float x[8]; unpack8(*(const u32x4*)(P + (rb + 64 * j + key) * PN + P_KRET + hd * 128 + 8 * c), x);
                  const float f = __builtin_amdgcn_exp2f(lg2g * (float)(255 - 64 * j - key));
#pragma unroll
                  for (int e = 0; e < 8; ++e) *(LAS bf16_t*)(Kt + (8 * c + e) * VP + key * 2) = f2bf(x[e] * f); } }
            __syncthreads();
#pragma unroll
            for (int s = 0; s < 4; ++s) {
                const LAS unsigned char* ap = Vb + (32 * (w >> 1) + ql) * VP + (16 * s + 8 * hh) * 2; const u32x2 alo = *(const LAS u32x2*)ap, ahi = *(const LAS u32x2*)(ap + 8);
                u32x4 aw = (u32x4){alo.x, alo.y, ahi.x, ahi.y}; bf16x8 af; __builtin_memcpy(&af, &aw, 16);
#pragma unroll
                for (int t = 0; t < 2; ++t) { const LAS unsigned char* bp = Kt + (32 * (2 * (w & 1) + t) + ql) * VP + (16 * s + 8 * hh) * 2; const u32x2 blo = *(const LAS u32x2*)bp, bhi = *(const LAS u32x2*)(bp + 8);
                    u32x4 bw = (u32x4){blo.x, blo.y, bhi.x, bhi.y}; bf16x8 bf; __builtin_memcpy(&bf, &bw, 16);
                    acc[t] = __builtin_amdgcn_mfma_f32_32x32x16_bf16(af, bf, acc[t], 0, 0, 0); }
            }
        }
        float* op = KVT + (size_t)u * 16384;
#pragma unroll
        for (int t = 0; t < 2; ++t)
#pragma unroll
            for (int r = 0; r < 16; ++r) { const int dv = 32 * (w >> 1) + (r & 3) + 8 * (r >> 2) + 4 * hh; op[dv * 128 + 32 * (2 * (w & 1) + t) + ql] = acc[t][r]; }
    }
    __syncthreads();
}

__device__ __forceinline__ int q_pop(const Ctx& C, unsigned* head) {
    volatile LAS int* item = (volatile LAS int*)(C.lds + LDS_MISC + 64);
    __syncthreads();
    if (C.tid == 0) *item = (int)__hip_atomic_fetch_add(head, 1u, __ATOMIC_RELAXED, __HIP_MEMORY_SCOPE_AGENT);
    __syncthreads();
    return *item;
}
__device__ __forceinline__ void ph_mix(const Ctx& C, int l) {
    unsigned* head = C.ctl + CW_QUEUE + 256 * l;
    for (;;) { const int it = q_pop(C, head); if (it >= 64) break; rwkv_seq_unit(C, it >> 4, it & 15); }
    for (;;) { const int it = q_pop(C, head + 128); if (it >= 17 * 32) break; attn_unit<1>(C, (it & 31) >> 3, it & 7, 16 - (it >> 5)); }
    for (;;) { const int it = q_pop(C, head + 64); if (it >= 17 * 32) break; attn_unit<0>(C, (it & 31) >> 3, it & 7, 16 - (it >> 5)); }
}

constexpr int MMAIN = 16384;
template <int KIND>
__device__ __forceinline__ void tail_units(const Ctx& C, const bf16_t* A, const bf16_t* Bt, const int K, const int nunits, bf16_t* Hb, bf16_t* Ob, const bf16_t* P) {
    constexpr int NB = KIND == 1 ? 2 : 1, NBR = KIND == 2 ? 3 : 1;
    const int ql = C.lane & 31, hh = C.lane >> 5, w = C.wave; const int KS = K / 8;
    LAS float* red = (LAS float*)C.lds;
    for (int t = C.wg; t < nunits; t += C.G) {
        float tot[4] = {0.f, 0.f, 0.f, 0.f};
        for (int br = 0; br < NBR; ++br) {
        f32x16 acc[NB][2];
#pragma unroll
        for (int q = 0; q < NB; ++q)
#pragma unroll
            for (int r = 0; r < 16; ++r) { acc[q][0][r] = 0.f; acc[q][1][r] = 0.f; }
        const bf16_t* Au = (KIND == 2) ? A + (size_t)br * MP * 1024 : A;
        const bf16_t* a0 = Au + (size_t)(MMAIN + ql) * K + w * KS + 8 * hh;
        const bf16_t* bp[NB];
        if (KIND == 1) { const int j = 32 * t + ql; const int grow = 8 * (j >> 2) + (j & 3); bp[0] = Bt + (size_t)grow * K + w * KS + 8 * hh; bp[NB - 1] = Bt + (size_t)(grow + 4) * K + w * KS + 8 * hh; }
        else bp[0] = Bt + (size_t)(br * 2048 + 32 * t + ql) * K + w * KS + 8 * hh;
        for (int k = 0; k < KS; k += 64) { bf16x8 af0[4], af1[4], bfr[NB][4];
#pragma unroll
            for (int u = 0; u < 4; ++u) { af0[u] = *(const bf16x8*)(a0 + k + 16 * u); af1[u] = *(const bf16x8*)(a0 + (size_t)32 * K + k + 16 * u);
#pragma unroll
                for (int q = 0; q < NB; ++q) bfr[q][u] = *(const bf16x8*)(bp[q] + k + 16 * u); }
#pragma unroll
            for (int u = 0; u < 4; ++u)
#pragma unroll
                for (int q = 0; q < NB; ++q) { acc[q][0] = __builtin_amdgcn_mfma_f32_32x32x16_bf16(af0[u], bfr[q][u], acc[q][0], 0, 0, 0); acc[q][1] = __builtin_amdgcn_mfma_f32_32x32x16_bf16(af1[u], bfr[q][u], acc[q][1], 0, 0, 0); } }
        __syncthreads();
#pragma unroll
        for (int q = 0; q < NB; ++q)
#pragma unroll
            for (int hf = 0; hf < 2; ++hf)
#pragma unroll
                for (int r = 0; r < 16; ++r) red[((q * 8 + w) * 32 + hf * 16 + r) * 64 + C.lane] = acc[q][hf][r];
        __syncthreads();
#pragma unroll
        for (int i = 0; i < 4; ++i) { const int hr = 4 * w + i, hf = hr >> 4, r = hr & 15; float s0 = 0.f, s1 = 0.f;
#pragma unroll
            for (int ww = 0; ww < 8; ++ww) { s0 += red[(ww * 32 + hr) * 64 + C.lane]; if (NB == 2) s1 += red[((8 + ww) * 32 + hr) * 64 + C.lane]; }
            const int row = MMAIN + 32 * hf + (r & 3) + 8 * (r >> 2) + 4 * hh; const int c = 32 * t + ql;
            if (KIND == 0) { bf16_t* p = Hb + (size_t)row * DM + c; *p = f2bf(bf2f(*p) + s0); }
            else if (KIND == 1) Ob[(size_t)row * FFN + c] = f2bf(s0 * sigmoidf_(s0) * s1);
            else { tot[i] += s0 * sigmoidf_(bf2f(P[(size_t)row * PN + P_GATES + br * 2048 + c])); if (br == NBR - 1) Ob[(size_t)row * DM + c] = f2bf(tot[i]); } }
        }
    }
    __syncthreads();
}
#define T16_STEP(NS, k) do { bf16x8 a_[NS], b0_[NS], b1_[NS]; \
        _Pragma("unroll") for (int s_ = 0; s_ < NS; ++s_) { a_[s_] = *(const bf16x8*)(ap + (k) + 32 * s_); b0_[s_] = *(const bf16x8*)(bp + (k) + 32 * s_); b1_[s_] = *(const bf16x8*)(bp + (size_t)16 * K + (k) + 32 * s_); } \
        _Pragma("unroll") for (int s_ = 0; s_ < NS; ++s_) { acc0 = __builtin_amdgcn_mfma_f32_16x16x32_bf16(a_[s_], b0_[s_], acc0, 0, 0, 0); acc1 = __builtin_amdgcn_mfma_f32_16x16x32_bf16(a_[s_], b1_[s_], acc1, 0, 0, 0); } } while (0)
template <int KIND>
__device__ __forceinline__ void tail16(const Ctx& C, const bf16_t* A, const bf16_t* Bt, const int K, bf16_t* Hb, bf16_t* Ob, const bf16_t* P) {
    const int r = C.lane & 15, kq = C.lane >> 4, w = C.wave; const int KS = K / 8;
    LAS float* red = (LAS float*)C.lds;
    for (int un = C.wg; un < 256; un += C.G) {
        const int rg = (un >> 3) & 3, t = (un & 7) + 8 * (un >> 5);
        const int row = MMAIN + 16 * rg + 4 * kq + (w & 3), c = 32 * t + 16 * (w >> 2) + r;
        if (KIND == 0) {
            bf16_t* p = Hb + (size_t)row * DM + c; const bf16_t hv = *p;
            f32x4 acc0 = {0.f, 0.f, 0.f, 0.f}, acc1 = {0.f, 0.f, 0.f, 0.f};
            const bf16_t* ap = A + (size_t)(MMAIN + 16 * rg + r) * K + w * KS + 8 * kq;
            const bf16_t* bp = Bt + (size_t)(32 * t + r) * K + w * KS + 8 * kq;
            int k = 0;
            for (; k + 256 <= KS; k += 256) T16_STEP(8, k);
            for (; k + 128 <= KS; k += 128) T16_STEP(4, k);
            for (; k < KS; k += 64) T16_STEP(2, k);
            __syncthreads();
#pragma unroll
            for (int j = 0; j < 4; ++j) { red[(w * 8 + j) * 64 + C.lane] = acc0[j]; red[(w * 8 + 4 + j) * 64 + C.lane] = acc1[j]; }
            __syncthreads();
            float s = 0.f;
#pragma unroll
            for (int ww = 0; ww < 8; ++ww) s += red[(ww * 8 + w) * 64 + C.lane];
            *p = f2bf(bf2f(hv) + s);
        } else {
            bf16_t gt[3];
#pragma unroll
            for (int br = 0; br < 3; ++br) gt[br] = P[(size_t)row * PN + P_GATES + br * 2048 + c];
            bf16x8 a_[3][4], b0_[3][4], b1_[3][4];
#pragma unroll
            for (int br = 0; br < 3; ++br) {
                const bf16_t* ap = A + (size_t)br * MP * 1024 + (size_t)(MMAIN + 16 * rg + r) * K + w * KS + 8 * kq;
                const bf16_t* bp = Bt + (size_t)(br * 2048 + 32 * t + r) * K + w * KS + 8 * kq;
#pragma unroll
                for (int s_ = 0; s_ < 4; ++s_) { a_[br][s_] = *(const bf16x8*)(ap + 32 * s_); b0_[br][s_] = *(const bf16x8*)(bp + 32 * s_); b1_[br][s_] = *(const bf16x8*)(bp + (size_t)16 * K + 32 * s_); }
            }
            f32x4 acc[3][2];
#pragma unroll
            for (int br = 0; br < 3; ++br) { acc[br][0] = (f32x4){0.f, 0.f, 0.f, 0.f}; acc[br][1] = (f32x4){0.f, 0.f, 0.f, 0.f};
#pragma unroll
                for (int s_ = 0; s_ < 4; ++s_) { acc[br][0] = __builtin_amdgcn_mfma_f32_16x16x32_bf16(a_[br][s_], b0_[br][s_], acc[br][0], 0, 0, 0); acc[br][1] = __builtin_amdgcn_mfma_f32_16x16x32_bf16(a_[br][s_], b1_[br][s_], acc[br][1], 0, 0, 0); } }
            __syncthreads();
#pragma unroll
            for (int br = 0; br < 3; ++br)
#pragma unroll
                for (int j = 0; j < 4; ++j) { red[(w * 24 + br * 8 + j) * 64 + C.lane] = acc[br][0][j]; red[(w * 24 + br * 8 + 4 + j) * 64 + C.lane] = acc[br][1][j]; }
            __syncthreads();
            float tot = 0.f;
#pragma unroll
            for (int br = 0; br < 3; ++br) { float s = 0.f;
#pragma unroll
                for (int ww = 0; ww < 8; ++ww) s += red[(ww * 24 + br * 8 + w) * 64 + C.lane];
                tot += s * sigmoidf_(bf2f(gt[br])); }
            Ob[(size_t)row * DM + c] = f2bf(tot);
        }
    }
    __syncthreads();
}
#undef T16_STEP
__device__ __forceinline__ void ph_sum3(const Ctx& C) {
    const bf16_t* GT = WSP(bf16_t, WS_RW); bf16_t* MG = WSP(bf16_t, WS_U);
    for (int row = C.wg * 8 + C.wave; row < M; row += C.G * 8) {
        const bf16_t* gp = GT + (size_t)row * 6144;
#pragma unroll
        for (int i = 0; i < 4; ++i) { const int c = (i * 64 + C.lane) * 8; float a[8], b[8], d[8];
            unpack8(*(const u32x4*)(gp + c), a); unpack8(*(const u32x4*)(gp + 2048 + c), b); unpack8(*(const u32x4*)(gp + 4096 + c), d);
#pragma unroll
            for (int e = 0; e < 8; ++e) a[e] = a[e] + b[e] + d[e];
            *(u32x4*)(MG + (size_t)row * DM + c) = pack8(a); }
    }
}

constexpr int NSTEP_LAYER = 13, STEP_FINAL = 1 + DEPTH * NSTEP_LAYER, NSTEPS = STEP_FINAL + 1;
__device__ __forceinline__ Ctx mkctx(const Args& args, LAS unsigned char* lds, int wave_s) {
    Ctx C; GAS unsigned char* wsg = (GAS unsigned char*)args.ws; asm volatile("" : "+s"(wsg)); unsigned char* ws = (unsigned char*)wsg; int wv = wave_s; asm volatile("" : "+s"(wv));
    int lane; asm volatile("v_mbcnt_lo_u32_b32 %0, -1, 0\n\tv_mbcnt_hi_u32_b32 %0, -1, %0" : "=v"(lane));
    C.out = (float*)(GAS float*)args.out; C.ws = ws; C.lds = lds; C.ctl = (unsigned*)(ws + WS_CTL);
    C.tid = wv * 64 + lane; C.lane = lane; C.wave = wv; C.G = gridDim.x; C.wg = blockIdx.x;
    return C;
}
__global__ void __launch_bounds__(512, 2) trunk_fwd(Args args) {
    extern __shared__ __attribute__((aligned(16))) unsigned char lds_raw[];
    LAS unsigned char* lds = (LAS unsigned char*)lds_raw;
    volatile LAS unsigned* misc = (volatile LAS unsigned*)(lds + LDS_MISC);
    if (threadIdx.x < 32) misc[threadIdx.x] = 0u;
    if (threadIdx.x == 0) { volatile LAS unsigned long long* tb = (volatile LAS unsigned long long*)(lds + LDS_INTBL);
#pragma unroll
        for (int i = 0; i < 27; ++i) tb[i] = (unsigned long long)args.in[i]; }
    __syncthreads();
    const int s_lo = args.s_lo, s_hi = args.s_hi;
    const int wave_s = __builtin_amdgcn_readfirstlane(threadIdx.x >> 6);
    unsigned* const barw = (unsigned*)(args.ws + WS_CTL) + CW_BAR + args.bar_idx * XCD_BAR_WORDS;
    XcdBarrier bar; bar.bar = barw; bar.x = 0; bar.st = misc;
    if (s_hi - s_lo > 1) bar = xcd_barrier_post(barw, misc);
#ifndef PMASK
#define PMASK 0xFFFFF
#endif
#define RUN(k, s) (((PMASK >> (k)) & 1) && (s) >= s_lo && (s) < s_hi)
#define SEAM(s) do { if ((s) >= s_lo && (s) + 1 < s_hi) { GAS unsigned* bw_ = (GAS unsigned*)barw; asm volatile("" : "+s"(bw_)); bar.bar = (unsigned*)bw_; int ln_; asm volatile("v_mbcnt_lo_u32_b32 %0, -1, 0\n\tv_mbcnt_hi_u32_b32 %0, -1, %0" : "=v"(ln_)); xcd_barrier(bar, wave_s == 0 && ln_ == 0); } } while (0)
    using namespace pg8;
    if (RUN(14, 0)) { const Ctx C = mkctx(args, lds, wave_s); ph_rope_tables(C); } SEAM(0);
    for (int l = 0; l < DEPTH; ++l) {
        const int sb = 1 + l * NSTEP_LAYER;
        if (RUN(0, sb + 0)) { const Ctx C = mkctx(args, lds, wave_s); ph_conv(C, l); if (l == 0) ph_norm<true>(C); else ph_norm<false>(C); } SEAM(sb + 0);
        if (RUN(1, sb + 1)) { const Ctx C = mkctx(args, lds, wave_s); Gemm g{WSP(bf16_t, WS_U), WSP(bf16_t, WS_WIN), MP, PN, DM, 0, 0}; StaticOrder S; S.init(MP, PN, C.G, C.wg);
            EpiBf16Plain E{WSP(bf16_t, WS_P), PN}; gemm_phase<EpiBf16Plain, StaticOrder, true, true>(lds, g, S, E, C.tid); }
        if (RUN(1, sb + 1)) { const Ctx C = mkctx(args, lds, wave_s); Gemm g{WSP(bf16_t, WS_WVRET), WSP(bf16_t, WS_U), 1024, MP, DM, 0, 0}; StaticOrder S; S.init(1024, MP, C.G, (C.wg + 121) % C.G);
            EpiBf16Plain E{WSP(bf16_t, WS_VTRET), MP}; gemm_phase<EpiBf16Plain, StaticOrder, true, true>(lds, g, S, E, C.tid); }
        if (RUN(1, sb + 1)) { Ctx C = mkctx(args, lds, wave_s);
            int idx = C.wg, cnt = C.G;
            if (C.G == 256) { const bool idle = C.wg >= 117 && !(C.wg >= 135 && C.wg <= 138); idx = idle ? C.wg - 117 - (C.wg > 138 ? 4 : 0) : -1; cnt = 135; }
            if (idx >= 0) { C.wg = idx; C.G = cnt; __syncthreads(); ph_convB(C, l); } }
        SEAM(sb + 1);
        if (RUN(2, sb + 2)) { const Ctx C = mkctx(args, lds, wave_s); ph_prepA(C, l); } SEAM(sb + 2);
        if (RUN(3, sb + 3)) { const Ctx C = mkctx(args, lds, wave_s);
            unsigned char* rw = C.ws + WS_RW;
            { Gemm g{WSP(bf16_t, WS_XL), WSP(bf16_t, WS_WLORA), MP, LORA_N, LORA_K, 0, 0}; StaticOrder S; S.init(MP, LORA_N, C.G, C.wg);
              EpiLora E{(float*)(rw + RW_WDEC), (bf16_t*)(rw + RW_A), (bf16_t*)(rw + RW_A + RW_ARR), inp(C, IN_W0) + l * 1024, inp(C, IN_A0) + l * 1024}; gemm_phase<EpiLora, StaticOrder, true, true>(lds, g, S, E, C.tid); }
        }
        if (RUN(3, sb + 3)) { const Ctx C = mkctx(args, lds, wave_s); Gemm g{WSP(bf16_t, WS_QN), WSP(bf16_t, WS_WUQ), MP, 1536, 512, 0, 0}; StaticOrder S; S.init(MP, 1536, C.G, (C.wg + 140) % C.G);
            EpiBf16Plain E{WSP(bf16_t, WS_Q), 1536}; gemm_phase<EpiBf16Plain, StaticOrder, true, true>(lds, g, S, E, C.tid); }
        if (RUN(3, sb + 3)) { const Ctx C = mkctx(args, lds, wave_s); Gemm g{WSP(bf16_t, WS_KVN), WSP(bf16_t, WS_WUK), MP, 1024, 256, 0, 0}; StaticOrder S; S.init(MP, 1024, C.G, (C.wg + 236) % C.G);
            EpiBf16Plain E{WSP(bf16_t, WS_KNOPE), 1024}; gemm_phase<EpiBf16Plain, StaticOrder, true, true>(lds, g, S, E, C.tid); }
        if (RUN(3, sb + 3)) { const Ctx C = mkctx(args, lds, wave_s); Gemm g{WSP(bf16_t, WS_WUV), WSP(bf16_t, WS_KVN), 1024, MP, 256, 0, 0}; StaticOrder S; S.init(1024, MP, C.G, (C.wg + 232) % C.G);
            EpiBf16Plain E{WSP(bf16_t, WS_VTMLA), MP}; gemm_phase<EpiBf16Plain, StaticOrder, true, true>(lds, g, S, E, C.tid); }
        SEAM(sb + 3);
        if (RUN(5, sb + 5)) { const Ctx C = mkctx(args, lds, wave_s); ph_qrope(C); }
        if (RUN(5, sb + 5)) { const Ctx C = mkctx(args, lds, wave_s); ph_retkv(C); }
        if (RUN(5, sb + 5)) { const Ctx C = mkctx(args, lds, wave_s); ph_rwkvpre(C, l); } SEAM(sb + 5);
        if (RUN(6, sb + 6)) { const Ctx C = mkctx(args, lds, wave_s); ph_mix(C, l); } SEAM(sb + 6);
        if (RUN(7, sb + 7)) { const Ctx C = mkctx(args, lds, wave_s); ph_post(C, l); } SEAM(sb + 7);
        if (RUN(8, sb + 8)) { const Ctx C = mkctx(args, lds, wave_s); Gemm g{WSP(bf16_t, WS_YBR), WSP(bf16_t, WS_WBR), MMAIN, 6144, 1024, 8, (size_t)MP * 1024 * 2}; BranchOrder S; S.base.init(MMAIN, DM, C.G, C.wg);
            EpiGate E{WSP(bf16_t, WS_U), WSP(bf16_t, WS_P)}; gemm_phase<EpiGate, BranchOrder, true, true>(lds, g, S, E, C.tid); }
        if (RUN(8, sb + 8)) { const Ctx C = mkctx(args, lds, wave_s); tail16<2>(C, WSP(bf16_t, WS_YBR), WSP(bf16_t, WS_WBR), 1024, nullptr, WSP(bf16_t, WS_U), WSP(bf16_t, WS_P)); }
        SEAM(sb + 8);
        if (RUN(9, sb + 9)) { const Ctx C = mkctx(args, lds, wave_s); Gemm g{WSP(bf16_t, WS_U), WSP(bf16_t, WS_WOUT), MMAIN, DM, DM, 0, 0}; StaticOrder S; S.init(MMAIN, DM, C.G, C.wg);
            EpiResid E{WSP(bf16_t, WS_H)}; gemm_phase<EpiResid, StaticOrder, true, true>(lds, g, S, E, C.tid); }
        if (RUN(9, sb + 9)) { const Ctx C = mkctx(args, lds, wave_s); tail16<0>(C, WSP(bf16_t, WS_U), WSP(bf16_t, WS_WOUT), DM, WSP(bf16_t, WS_H), nullptr, nullptr); }
        SEAM(sb + 9);
        if (RUN(10, sb + 10)) { const Ctx C = mkctx(args, lds, wave_s); ph_norm<false>(C); } SEAM(sb + 10);
        if (RUN(11, sb + 11)) { const Ctx C = mkctx(args, lds, wave_s); Gemm g{WSP(bf16_t, WS_U), WSP(bf16_t, WS_WGU), MMAIN, 2 * FFN, DM, 0, 0}; StaticOrder S; S.init(MMAIN, 2 * FFN, C.G, C.wg);
            EpiSwiglu E{WSP(bf16_t, WS_P)}; gemm_phase<EpiSwiglu, StaticOrder, true, true>(lds, g, S, E, C.tid); }
        if (RUN(11, sb + 11)) { const Ctx C = mkctx(args, lds, wave_s); tail_units<1>(C, WSP(bf16_t, WS_U), WSP(bf16_t, WS_WGU), DM, FFN / 32, nullptr, WSP(bf16_t, WS_P), nullptr); }
        SEAM(sb + 11);
        if (RUN(12, sb + 12)) { const Ctx C = mkctx(args, lds, wave_s); Gemm g{WSP(bf16_t, WS_P), WSP(bf16_t, WS_WD), MMAIN, DM, FFN, 0, 0}; StaticOrder S; S.init(MMAIN, DM, C.G, C.wg);
            EpiResid E{WSP(bf16_t, WS_H)}; gemm_phase<EpiResid, StaticOrder, true, true>(lds, g, S, E, C.tid); }
        if (RUN(12, sb + 12)) { const Ctx C = mkctx(args, lds, wave_s); tail16<0>(C, WSP(bf16_t, WS_P), WSP(bf16_t, WS_WD), FFN, WSP(bf16_t, WS_H), nullptr, nullptr); }
        SEAM(sb + 12);
    }
    if (RUN(15, STEP_FINAL)) { const Ctx C = mkctx(args, lds, wave_s); ph_final(C); }
#undef RUN
#undef SEAM
}

extern "C" void kernel_launch(void* const* d_in, const int* in_sizes, int n_in, void* d_out, int out_size, void* d_ws, size_t ws_size, hipStream_t stream) {
    static int grid = 0;
    if (grid == 0) {
        if (n_in != 27 || ws_size < WS_END) { fprintf(stderr, "kernel_launch: unexpected n_in %d or ws_size %zu (< %zu)\n", n_in, ws_size, (size_t)WS_END); grid = -1; return; }
        int dev = 0, cus = 0, per_cu = 0;
        if (hipGetDevice(&dev) != hipSuccess || hipDeviceGetAttribute(&cus, hipDeviceAttributeMultiprocessorCount, dev) != hipSuccess) { grid = -1; return; }
        if (hipFuncSetAttribute((const void*)trunk_fwd, hipFuncAttributeMaxDynamicSharedMemorySize, LDS_BYTES) != hipSuccess) { fprintf(stderr, "kernel_launch: hipFuncSetAttribute failed\n"); grid = -1; return; }
        if (hipOccupancyMaxActiveBlocksPerMultiprocessor(&per_cu, (const void*)trunk_fwd, 512, LDS_BYTES) != hipSuccess || per_cu < 1) { fprintf(stderr, "kernel_launch: occupancy query says %d\n", per_cu); }
        (void)hipGetLastError();
        grid = cus;
    }
    if (grid < 0) return;
    (void)hipMemsetAsync((char*)d_ws + WS_CTL, 0, CTL_ZERO_BYTES, stream);
    Args a{};
    for (int i = 0; i < 27; ++i) a.in[i] = (const float*)d_in[i];
    a.out = (float*)d_out; a.ws = (unsigned char*)d_ws; a.pad = 0;
#if N_LAUNCH_MODE == 1
    a.s_lo = 0; a.s_hi = NSTEPS; a.bar_idx = 0;
    hipLaunchKernelGGL(trunk_fwd, dim3(grid), dim3(512), LDS_BYTES, stream, a);
#else
    for (int s = 0; s < NSTEPS; ++s) { a.s_lo = s; a.s_hi = s + 1; a.bar_idx = 0; hipLaunchKernelGGL(trunk_fwd, dim3(grid), dim3(512), LDS_BYTES, stream, a); }
#endif
}
```

```cpp
#include <hip/hip_runtime.h>
#include <cstdio>
#include <cstdint>

#define LAS __attribute__((address_space(3)))
#define GAS __attribute__((address_space(1)))
typedef unsigned short bf16_t;
typedef short bf16x8 __attribute__((ext_vector_type(8)));
typedef float f32x4 __attribute__((ext_vector_type(4)));
typedef float f32x2 __attribute__((ext_vector_type(2)));
typedef float f32x16 __attribute__((ext_vector_type(16)));
typedef unsigned u32x4 __attribute__((ext_vector_type(4)));
typedef unsigned u32x2 __attribute__((ext_vector_type(2)));

constexpr int DM = 2048, NB = 4, SEQ = 4096, NMETA = 16, LSEQ = 4112, M = NB * LSEQ  , MP = 16640  , DEPTH = 4;
constexpr int RWW = 1024, RW_COLS = 3520, IN_COLS = 14592, PN = 13568  ;
constexpr int P_QRET = 3520, P_KRET = 4544, P_GRET = 5568, P_QD = 6592, P_KVD = 7104, P_KRD = 7360, P_GATES = 7424;
constexpr int FFN = 5632, LORA_K = 512, LORA_N = 3072;
constexpr float NORM_EPS = 1e-6f, GN_EPS = 64.0f * 1e-5f;

constexpr size_t MiB = 1u << 20;
constexpr size_t al(size_t x) { return (x + MiB - 1) / MiB * MiB; }
constexpr size_t WS_CTL = 0, CTL_BYTES = 2 * MiB;
constexpr size_t WS_WIN = WS_CTL + CTL_BYTES;
constexpr size_t WS_WVRET = WS_WIN + al((size_t)PN * DM * 2);
constexpr size_t WS_WLORA = WS_WVRET + al((size_t)1024 * DM * 2);
constexpr size_t WS_WUQ = WS_WLORA + al((size_t)LORA_N * LORA_K * 2);
constexpr size_t WS_WUK = WS_WUQ + al((size_t)1536 * 512 * 2);
constexpr size_t WS_WUV = WS_WUK + al((size_t)1024 * 256 * 2);
constexpr size_t WS_WBR = WS_WUV + al((size_t)1024 * 256 * 2);
constexpr size_t WS_WOUT = WS_WBR + al((size_t)6144 * 1024 * 2);
constexpr size_t WS_WGU = WS_WOUT + al((size_t)2048 * 6144 * 2);
constexpr size_t WS_WD = WS_WGU + al((size_t)11264 * 2048 * 2);
constexpr size_t WS_ROPE = WS_WD + al((size_t)2048 * FFN * 2);
constexpr size_t WS_H = WS_ROPE + al((size_t)LSEQ * 192 * 4);
constexpr size_t WS_U = WS_H + al((size_t)MP * DM * 4);
constexpr size_t WS_P = WS_U + al((size_t)MP * DM * 2);
constexpr size_t WS_VTRET = WS_P + al((size_t)MP * PN * 2);
constexpr size_t WS_XL = WS_VTRET + al((size_t)1024 * MP * 2);
constexpr size_t WS_RW = WS_XL + al((size_t)MP * 512 * 2);
constexpr size_t RW_WDEC = 0;
constexpr size_t RW_A = RW_WDEC + (size_t)MP * 1024 * 4;
constexpr size_t RW_ARR = (size_t)MP * 1024 * 2;
constexpr size_t RW_YRAW = RW_A + 7 * RW_ARR;
constexpr size_t RW_BYTES = RW_YRAW + (size_t)MP * 1024 * 4;
static_assert(RW_BYTES >= (size_t)MP * 6144 * 2, "GT overlay");
constexpr size_t WS_YBR = WS_RW + al(RW_BYTES);
constexpr size_t WS_QN = WS_YBR + al(3 * RW_ARR);
constexpr size_t WS_KVN = WS_QN + al((size_t)MP * 512 * 2);
constexpr size_t WS_KR = WS_KVN + al((size_t)MP * 256 * 2);
constexpr size_t WS_Q = WS_KR + al((size_t)MP * 64 * 2);
constexpr size_t WS_KNOPE = WS_Q + al((size_t)MP * 1536 * 2);
constexpr size_t WS_VTMLA = WS_KNOPE + al((size_t)MP * 1024 * 2);
constexpr size_t WS_KVT = WS_VTMLA + al((size_t)1024 * MP * 2);
constexpr int NCHUNK = LSEQ / 16;
constexpr int RC_B1 = 0, RC_B2 = 5632, RC_VT = 10752, RC_G = 13824, RC_STRIDE = 14336;
constexpr size_t WS_RCH = WS_KVT + al((size_t)NB * 8 * 16 * 128 * 128 * 4);
constexpr size_t WS_END = WS_RCH + al((size_t)NB * 16 * NCHUNK * RC_STRIDE);
static_assert((size_t)MP * FFN * 2 <= (size_t)MP * PN * 2, "ACT overlay");

constexpr int CW_QUEUE = 1024;
constexpr int CW_BAR = 4096;
constexpr int XCD_BAR_WORDS_C = 3456;
constexpr int MAX_BAR_REGIONS = 64;
#ifndef N_LAUNCH_MODE
#define N_LAUNCH_MODE 1
#endif
constexpr size_t CTL_ZERO_BYTES = (N_LAUNCH_MODE == 1) ? (size_t)(CW_BAR + XCD_BAR_WORDS_C) * 4 : CTL_BYTES;

constexpr int LDS_BYTES = 147456;
constexpr int LDS_MISC = 131072;

__device__ __forceinline__ float bf2f(unsigned short v) { return __uint_as_float(((unsigned)v) << 16); }
__device__ __forceinline__ float bflo(unsigned v) { return __uint_as_float(v << 16); }
__device__ __forceinline__ float bfhi(unsigned v) { return __uint_as_float(v & 0xffff0000u); }
__device__ __forceinline__ unsigned cvt_pk_bf16(float lo, float hi) { unsigned r; asm volatile("v_cvt_pk_bf16_f32 %0, %1, %2" : "=v"(r) : "v"(lo), "v"(hi)); return r; }
__device__ __forceinline__ unsigned short f2bf(float x) { return (unsigned short)(cvt_pk_bf16(x, 0.f) & 0xffffu); }
template <int X> __device__ __forceinline__ float sw_xor(float x) { return __int_as_float(__builtin_amdgcn_ds_swizzle(__float_as_int(x), 0x1f | (X << 10))); }
__device__ __forceinline__ float hsum32(float x) { const int v = __float_as_int(x); auto r = __builtin_amdgcn_permlane32_swap(v, v, false, false); return __int_as_float(r[0]) + __int_as_float(r[1]); }
__device__ __forceinline__ float hmax32(float x) { const int v = __float_as_int(x); auto r = __builtin_amdgcn_permlane32_swap(v, v, false, false); return fmaxf(__int_as_float(r[0]), __int_as_float(r[1])); }
__device__ __forceinline__ float wsum32(float x) { x += sw_xor<16>(x); x += sw_xor<8>(x); x += sw_xor<4>(x); x += sw_xor<2>(x); x += sw_xor<1>(x); return x; }
__device__ __forceinline__ float wsum64(float x) { x = wsum32(x); return hsum32(x); }
__device__ __forceinline__ float dpp_xor1(float x) { return __int_as_float(__builtin_amdgcn_update_dpp(0, __float_as_int(x), 0xB1, 0xF, 0xF, true)); }
__device__ __forceinline__ float dpp_xor2(float x) { return __int_as_float(__builtin_amdgcn_update_dpp(0, __float_as_int(x), 0x4E, 0xF, 0xF, true)); }
__device__ __forceinline__ float dpp_mirror(float x) { return __int_as_float(__builtin_amdgcn_update_dpp(0, __float_as_int(x), 0x140, 0xF, 0xF, true)); }
__device__ __forceinline__ float dpp_hmirror(float x) { return __int_as_float(__builtin_amdgcn_update_dpp(0, __float_as_int(x), 0x141, 0xF, 0xF, true)); }
__device__ __forceinline__ float wsum64_dpp(float x) {
    x += dpp_xor1(x); x += dpp_xor2(x); x += dpp_hmirror(x); x += dpp_mirror(x);
    x += __int_as_float(__builtin_amdgcn_update_dpp(0, __float_as_int(x), 0x142, 0xA, 0xF, false));
    x += __int_as_float(__builtin_amdgcn_update_dpp(0, __float_as_int(x), 0x143, 0xC, 0xF, false));
    return __int_as_float(__builtin_amdgcn_readlane(__float_as_int(x), 63));
}
__device__ __forceinline__ float sigmoidf_(float x) { return 1.0f / (1.0f + __expf(-x)); }
__device__ __forceinline__ u32x4 zero4u() { unsigned z; asm volatile("v_mov_b32 %0, 0" : "=v"(z)); return (u32x4){z, z, z, z}; }

#define XB_TMO      128
#define XB_XCNT(j)  (256  + 64 * (j))
#define XB_XSUB(j)  (1280 + 64 * (j))
#define XB_XGEN(j)  (2304 + 64 * (j))
#define XB_TOP      3328
#define XB_TOPGEN   3392
#define XCD_BAR_WORDS 3456
#define XB_SPIN_CAP (1u << 18)

__device__ __forceinline__ unsigned xb_ld(unsigned* p)              { return __hip_atomic_load(p, __ATOMIC_RELAXED, __HIP_MEMORY_SCOPE_AGENT); }
__device__ __forceinline__ unsigned xb_add(unsigned* p, unsigned v) { return __hip_atomic_fetch_add(p, v, __ATOMIC_RELAXED, __HIP_MEMORY_SCOPE_AGENT); }
__device__ __forceinline__ unsigned xb_xcc_id() { return (unsigned)__builtin_amdgcn_s_getreg((3 << 11) | 20) & 0xFu; }
#define XB_SPIN(cond, bar) do { unsigned _sp = 0; while (cond) { __builtin_amdgcn_s_sleep(1); \
    if ((++_sp & 255u) == 0u) { if (xb_ld(&(bar)[XB_TMO])) break; if (_sp > XB_SPIN_CAP) { atomicAdd(&(bar)[XB_TMO], 1u); break; } } } } while (0)

struct XcdBarrier { unsigned* bar; unsigned x; volatile LAS unsigned* st; };

__device__ __forceinline__ XcdBarrier xcd_barrier_post(unsigned* bar, volatile LAS unsigned* st) {
    XcdBarrier b; b.bar = bar; b.x = xb_xcc_id(); b.st = st;
    if (threadIdx.x == 0) (void)xb_add(&bar[XB_XCNT(b.x)], 1u);
    return b;
}
__device__ __forceinline__ void xcd_barrier_complete(unsigned* bar, unsigned x, unsigned& nloc, unsigned& nx) {
    const unsigned G = gridDim.x * gridDim.y * gridDim.z;
    unsigned sum, cnt, mine, sp = 0u;
    for (;;) {
        sum = 0u; cnt = 0u; mine = 0u;
#pragma unroll
        for (unsigned j = 0; j < 16; ++j) { const unsigned c = xb_ld(&bar[XB_XCNT(j)]); sum += c; cnt += (c > 0u) ? 1u : 0u; mine = (j == x) ? c : mine; }
        if (sum == G) break;
        __builtin_amdgcn_s_sleep(1);
        if ((++sp & 255u) == 0u) { if (xb_ld(&bar[XB_TMO])) break; if (sp > XB_SPIN_CAP) { atomicAdd(&bar[XB_TMO], 1u); break; } }
    }
    nloc = mine > 0u ? mine : 1u; nx = cnt > 0u ? cnt : 1u;
}
__device__ __forceinline__ void xcd_barrier(const XcdBarrier& b, const bool leader) {
    asm volatile("s_waitcnt vmcnt(0)" ::: "memory");
    __syncthreads();
    if (leader) {
        unsigned* bar = b.bar;
        __builtin_amdgcn_s_waitcnt(0);
        unsigned nloc = b.st[0], nx = b.st[1];
        if (nloc == 0u) { xcd_barrier_complete(bar, b.x, nloc, nx); b.st[0] = nloc; b.st[1] = nx; }
        const unsigned old = xb_add(&bar[XB_XSUB(b.x)], 1u);
        const unsigned gen = old / nloc;
        if (old + 1u == (gen + 1u) * nloc) {
            __builtin_amdgcn_fence(__ATOMIC_RELEASE, "agent");
            asm volatile("s_waitcnt vmcnt(0)" ::: "memory");
            const unsigned og = xb_add(&bar[XB_TOP], 1u);
            const unsigned tg = og / nx;
            if (og + 1u == (tg + 1u) * nx) xb_add(&bar[XB_TOPGEN], 1u);
            else XB_SPIN(xb_ld(&bar[XB_TOPGEN]) == tg, bar);
            __builtin_amdgcn_fence(__ATOMIC_ACQUIRE, "agent");
            xb_add(&bar[XB_XGEN(b.x)], 1u);
            asm volatile("s_waitcnt vmcnt(0)" ::: "memory");
        } else {
            XB_SPIN(xb_ld(&bar[XB_XGEN(b.x)]) == gen, bar);
            __builtin_amdgcn_fence(__ATOMIC_ACQUIRE, "agent");
            asm volatile("s_waitcnt vmcnt(0)" ::: "memory");
        }
    }
    __syncthreads();
}

__device__ __forceinline__ void unpack8(const u32x4 w, float (&x)[8]);
__device__ __forceinline__ u32x4 pack8(const float (&x)[8]);
__device__ __forceinline__ void ld8f(const float* p, float (&x)[8]);
namespace pg8 {
constexpr int BM = 256, BK = 64, HALF = 128, HTB = HALF * BK * 2, STAGE_BYTES = 8 * HTB, NXCD = 8, WGM = 8;
__host__ __device__ __forceinline__ int lds_byte(int r, int c) { const int st = (r >> 4) * 2 + (c >> 5), rr = r & 15, cc = c & 31, ob = rr * 64 + cc * 2; return st * 1024 + (ob ^ (((ob >> 9) & 1) << 5)); }
__host__ __device__ __forceinline__ void stage_rc(int b, int& R, int& C) { const int st = b / 1024, sb = b % 1024, swz = sb ^ (((sb >> 9) & 1) << 5); R = (st >> 1) * 16 + swz / 64; C = (st & 1) * 32 + (swz % 64) / 2; }
__host__ __device__ __forceinline__ int perm32(int rho) { const int n = rho >> 4, i = rho & 15; return 8 * (i >> 2) + 4 * n + (i & 3); }

struct Unit { int pm, pn; };
struct Gemm { const bf16_t* A; const bf16_t* Bt; int M, N, K; int asel_tiles; size_t asel_stride; };

struct StaticOrder {
    int nM, nN, nwg, G, c;
    __host__ __device__ void init(int M_, int N_, int G_, int c_) { nM = M_ / BM; nN = N_ / BM; nwg = nM * nN; G = G_; c = c_; }
    __host__ __device__ bool next(int i, Unit& u) const {
        const long L = (long)i * G + c; if (L >= nwg) return false;
        int wgid = (int)L; { const int q = nwg / NXCD, r = nwg % NXCD, xcd = wgid % NXCD, off = wgid / NXCD; wgid = (xcd < r ? xcd * (q + 1) : r * (q + 1) + (xcd - r) * q) + off; }
        const int nig = WGM * nN, gid = wgid / nig, fm = gid * WGM, gsz = (nM - fm) < WGM ? (nM - fm) : WGM;
        u.pm = fm + ((wgid % nig) % gsz); u.pn = (wgid % nig) / gsz; return true;
    }
    __device__ __forceinline__ void a_ready(const Unit&) const {}
    __device__ __forceinline__ void done(const Unit&) const {}
};

template <class Epi, class Sched, bool ALIGN_EPI = false, bool SP2 = false>
__device__ __forceinline__ void gemm_phase(LAS unsigned char* lds, const Gemm g, const Sched& S, const Epi& E, const int tid) {
    const int wid = __builtin_amdgcn_readfirstlane(tid >> 6), lane = tid & 63, wr = wid >> 2, wc = wid & 3, fr = lane & 15, fq = lane >> 4;
    const int K = g.K, nt = K / BK;
    unsigned voffA[2], voffB[2];
#pragma unroll
    for (int i = 0; i < 2; ++i) { int R, C; stage_rc(tid * 16 + i * 8192, R, C); const int Rb = Epi::PERM ? ((R & ~31) + perm32(R & 31)) : R;
        voffA[i] = (unsigned)(R * K + C) * 2u; voffB[i] = (unsigned)(Rb * K + C) * 2u; }
    const size_t kstep = (size_t)(BK * 2);
    const size_t hstep = (size_t)HALF * K * 2;
    const size_t tstep = 2 * hstep;
    const unsigned ldsw = (unsigned)wid * 1024u;
    const int aoff = lds_byte(wr * 64 + fr, fq * 8), boff = lds_byte(wc * 32 + fr, fq * 8);
#define PG8_SA(b, h) (((b) * 2 + (h)) * HTB)
#define PG8_SB(b, h) ((4 + (b) * 2 + (h)) * HTB)
#define PG8_STAGE(bufoff, gbase, voff) do { _Pragma("unroll") for (int _i = 0; _i < 2; ++_i) \
        __builtin_amdgcn_global_load_lds((const unsigned*)((const char*)(gbase) + (voff)[_i]), (LAS unsigned*)(lds + (bufoff) + ldsw + _i * 8192), 16, 0, 0); } while (0)
#define PG8_LDA(dst, b, h) do { _Pragma("unroll") for (int m = 0; m < 4; ++m) _Pragma("unroll") for (int k = 0; k < 2; ++k) dst[m][k] = *(const LAS bf16x8*)(lds + PG8_SA(b, h) + aoff + m * 2048 + k * 1024); } while (0)
#define PG8_LDB(dst, b, h) do { _Pragma("unroll") for (int n = 0; n < 2; ++n) _Pragma("unroll") for (int k = 0; k < 2; ++k) dst[n][k] = *(const LAS bf16x8*)(lds + PG8_SB(b, h) + boff + n * 2048 + k * 1024); } while (0)
#define PG8_MMA(ai, bj, At, Bt) do { __builtin_amdgcn_s_setprio(1); _Pragma("unroll") for (int m = 0; m < 4; ++m) _Pragma("unroll") for (int n = 0; n < 2; ++n) _Pragma("unroll") for (int k = 0; k < 2; ++k) \
        acc[ai][bj][m][n] = __builtin_amdgcn_mfma_f32_16x16x32_bf16(Bt[n][k], At[m][k], acc[ai][bj][m][n], 0, 0, 0); __builtin_amdgcn_s_setprio(0); } while (0)
#define PG8_WAIT_V(n) asm volatile("s_waitcnt vmcnt(" #n ")" ::: "memory")
#define PG8_WAIT_L(n) asm volatile("s_waitcnt lgkmcnt(" #n ")" ::: "memory")
#define PG8_BAR __builtin_amdgcn_s_barrier()
#define PG8_SCHED __builtin_amdgcn_sched_barrier(0)
#define PG8_ABASE(u) ((const char*)g.A + (g.asel_tiles ? (size_t)((u).pn / g.asel_tiles) * g.asel_stride : (size_t)0) + (size_t)(u).pm * tstep)
    Unit cur, nxt; int ui = 0;
    if (!S.next(0, cur)) return;
    f32x4 acc[2][2][4][2];
    { float zf; asm volatile("v_mov_b32 %0, 0" : "=v"(zf)); const f32x4 Z = {zf, zf, zf, zf};
#pragma unroll
    for (int a = 0; a < 2; ++a)
#pragma unroll
        for (int b = 0; b < 2; ++b)
#pragma unroll
            for (int m = 0; m < 4; ++m)
#pragma unroll
                for (int n = 0; n < 2; ++n) acc[a][b][m][n] = Z; }
    bf16x8 At[4][2], B0[2][2], B1[2][2];
    const char* cA = PG8_ABASE(cur); const char* cB = (const char*)g.Bt + (size_t)cur.pn * tstep;
    S.a_ready(cur);
    if constexpr (SP2) {
        PG8_STAGE(PG8_SB(0, 0), cB, voffB); PG8_STAGE(PG8_SB(0, 1), cB + hstep, voffB); PG8_STAGE(PG8_SA(0, 0), cA, voffA); PG8_STAGE(PG8_SA(0, 1), cA + hstep, voffA);
        if (wr == 1) PG8_BAR;
        PG8_WAIT_V(2); PG8_BAR;
        PG8_STAGE(PG8_SB(1, 0), cB + kstep, voffB); PG8_STAGE(PG8_SA(1, 0), cA + kstep, voffA); PG8_STAGE(PG8_SB(1, 1), cB + hstep + kstep, voffB);
        PG8_WAIT_V(6); PG8_BAR;
    } else {
        PG8_STAGE(PG8_SB(0, 0), cB, voffB); PG8_STAGE(PG8_SA(0, 0), cA, voffA); PG8_STAGE(PG8_SB(0, 1), cB + hstep, voffB); PG8_STAGE(PG8_SA(0, 1), cA + hstep, voffA);
        if (wr == 1) PG8_BAR;
        PG8_WAIT_V(4); PG8_BAR;
        PG8_STAGE(PG8_SB(1, 0), cB + kstep, voffB); PG8_STAGE(PG8_SA(1, 0), cA + kstep, voffA); PG8_STAGE(PG8_SB(1, 1), cB + hstep + kstep, voffB);
        PG8_WAIT_V(6); PG8_BAR;
    }
    for (;;) {
        const bool has_next = S.next(ui + 1, nxt);
        const char* nA = has_next ? PG8_ABASE(nxt) : cA; const char* nB = has_next ? (const char*)g.Bt + (size_t)nxt.pn * tstep : cB;
        for (int t = 0; t < nt; t += 2) {
            const bool last = (t == nt - 2);
            const char* a1 = cA + (size_t)(t + 1) * kstep;
            const char* a2 = last ? nA : cA + (size_t)(t + 2) * kstep; const char* b2 = last ? nB : cB + (size_t)(t + 2) * kstep;
            const char* a3 = a2 + kstep; const char* b3 = b2 + kstep;
            if (last && has_next) S.a_ready(nxt);
            if constexpr (SP2) {
            PG8_LDB(B0, 0, 0); PG8_LDB(B1, 0, 1); PG8_SCHED; PG8_LDA(At, 0, 0); PG8_STAGE(PG8_SA(1, 1), a1 + hstep, voffA);
            PG8_WAIT_V(8); PG8_WAIT_L(0); PG8_BAR; PG8_MMA(0, 0, At, B0); PG8_MMA(0, 1, At, B1); PG8_BAR; PG8_SCHED;
            PG8_LDA(At, 0, 1); PG8_STAGE(PG8_SB(0, 0), b2, voffB); PG8_STAGE(PG8_SB(0, 1), b2 + hstep, voffB); PG8_STAGE(PG8_SA(0, 0), a2, voffA);
            PG8_WAIT_V(8); PG8_WAIT_L(0); PG8_BAR; PG8_MMA(1, 0, At, B0); PG8_MMA(1, 1, At, B1); PG8_BAR; PG8_SCHED;
            PG8_LDB(B0, 1, 0); PG8_LDB(B1, 1, 1); PG8_SCHED; PG8_LDA(At, 1, 0); PG8_STAGE(PG8_SA(0, 1), a2 + hstep, voffA);
            PG8_WAIT_V(8); PG8_WAIT_L(0); PG8_BAR; PG8_MMA(0, 0, At, B0); PG8_MMA(0, 1, At, B1); PG8_BAR; PG8_SCHED;
            PG8_LDA(At, 1, 1); PG8_STAGE(PG8_SB(1, 0), b3, voffB); PG8_STAGE(PG8_SB(1, 1), b3 + hstep, voffB); PG8_STAGE(PG8_SA(1, 0), a3, voffA);
            PG8_WAIT_V(8); PG8_WAIT_L(0); PG8_BAR; PG8_MMA(1, 0, At, B0); PG8_MMA(1, 1, At, B1); PG8_BAR; PG8_SCHED;
            } else {
            PG8_LDB(B0, 0, 0); PG8_SCHED; PG8_LDA(At, 0, 0); PG8_STAGE(PG8_SA(1, 1), a1 + hstep, voffA);
            PG8_WAIT_L(8); PG8_BAR; PG8_WAIT_L(0); PG8_MMA(0, 0, At, B0); PG8_BAR; PG8_SCHED;
            PG8_LDB(B1, 0, 1); PG8_STAGE(PG8_SB(0, 0), b2, voffB);
            PG8_BAR; PG8_WAIT_L(0); PG8_MMA(0, 1, At, B1); PG8_BAR;
            PG8_LDA(At, 0, 1); PG8_STAGE(PG8_SA(0, 0), a2, voffA);
            PG8_BAR; PG8_WAIT_L(0); PG8_MMA(1, 0, At, B0); PG8_BAR; PG8_SCHED;
            PG8_STAGE(PG8_SB(0, 1), b2 + hstep, voffB);
            PG8_WAIT_V(6); PG8_BAR; PG8_MMA(1, 1, At, B1); PG8_BAR;
            PG8_LDB(B0, 1, 0); PG8_SCHED; PG8_LDA(At, 1, 0); PG8_STAGE(PG8_SA(0, 1), a2 + hstep, voffA);
            PG8_WAIT_L(8); PG8_BAR; PG8_WAIT_L(0); PG8_MMA(0, 0, At, B0); PG8_BAR; PG8_SCHED;
            PG8_LDB(B1, 1, 1); PG8_STAGE(PG8_SB(1, 0), b3, voffB);
            PG8_BAR; PG8_WAIT_L(0); PG8_MMA(0, 1, At, B1); PG8_BAR;
            PG8_LDA(At, 1, 1); PG8_STAGE(PG8_SA(1, 0), a3, voffA);
            PG8_BAR; PG8_WAIT_L(0); PG8_MMA(1, 0, At, B0); PG8_BAR; PG8_SCHED;
            PG8_STAGE(PG8_SB(1, 1), b3 + hstep, voffB);
            PG8_WAIT_V(6); PG8_BAR; PG8_MMA(1, 1, At, B1); PG8_BAR;
            }
        }
        if constexpr (ALIGN_EPI) { if (wr == 0) PG8_BAR; }
        E(acc, cur, wr, wc, fr, fq); S.done(cur);
        if (!has_next) break;
        { float zf; asm volatile("v_mov_b32 %0, 0" : "=v"(zf)); const f32x4 Z = {zf, zf, zf, zf};
#pragma unroll
        for (int a = 0; a < 2; ++a)
#pragma unroll
            for (int b = 0; b < 2; ++b)
#pragma unroll
                for (int m = 0; m < 4; ++m)
#pragma unroll
                    for (int n = 0; n < 2; ++n) acc[a][b][m][n] = Z; }
        cur = nxt; cA = nA; cB = nB; ++ui;
        if constexpr (ALIGN_EPI) { if (wr == 1) PG8_BAR; }
    }
    PG8_WAIT_V(0);
    if constexpr (!ALIGN_EPI) { if (wr == 0) PG8_BAR; }
    PG8_BAR;
#undef PG8_SA
#undef PG8_SB
#undef PG8_STAGE
#undef PG8_LDA
#undef PG8_LDB
#undef PG8_MMA
#undef PG8_WAIT_V
#undef PG8_WAIT_L
#undef PG8_BAR
#undef PG8_SCHED
#undef PG8_ABASE
}

struct EpiBf16Plain {
    static constexpr bool PERM = true;
    bf16_t* O; int ldc;
    __device__ __forceinline__ void operator()(const f32x4 (&acc)[2][2][4][2], const Unit& u, int wr, int wc, int fr, int fq) const {
        const int row0 = u.pm * BM + wr * 64 + fr; const int col0 = u.pn * BM + wc * 32 + 8 * fq;
#pragma unroll
        for (int ai = 0; ai < 2; ++ai)
#pragma unroll
            for (int m = 0; m < 4; ++m) { bf16_t* rowp = O + (size_t)(row0 + ai * HALF + m * 16) * ldc + col0;
#pragma unroll
                for (int bj = 0; bj < 2; ++bj) { const f32x4 v0 = acc[ai][bj][m][0], v1 = acc[ai][bj][m][1];
                    u32x4 w; w.x = cvt_pk_bf16(v0[0], v0[1]); w.y = cvt_pk_bf16(v0[2], v0[3]); w.z = cvt_pk_bf16(v1[0], v1[1]); w.w = cvt_pk_bf16(v1[2], v1[3]);
                    *(u32x4*)(rowp + bj * HALF) = w; } }
    }
};
struct EpiResid {
    static constexpr bool PERM = true;
    bf16_t* Hb;
    __device__ __forceinline__ void operator()(const f32x4 (&acc)[2][2][4][2], const Unit& u, int wr, int wc, int fr, int fq) const {
        const int row0 = u.pm * BM + wr * 64 + fr, col0 = u.pn * BM + wc * 32 + 8 * fq;
        bf16_t* base = Hb + (size_t)row0 * DM + col0;
        u32x4 hv[2][4][2];
#pragma unroll
        for (int ai = 0; ai < 2; ++ai)
#pragma unroll
            for (int m = 0; m < 4; ++m)
#pragma unroll
                for (int bj = 0; bj < 2; ++bj) hv[ai][m][bj] = *(const u32x4*)(base + (size_t)(ai * HALF + m * 16) * DM + bj * HALF);
#pragma unroll
        for (int ai = 0; ai < 2; ++ai)
#pragma unroll
            for (int m = 0; m < 4; ++m)
#pragma unroll
                for (int bj = 0; bj < 2; ++bj) { const f32x4 v0 = acc[ai][bj][m][0], v1 = acc[ai][bj][m][1]; float p[8]; unpack8(hv[ai][m][bj], p);
                    const float o[8] = {p[0] + v0[0], p[1] + v0[1], p[2] + v0[2], p[3] + v0[3], p[4] + v1[0], p[5] + v1[1], p[6] + v1[2], p[7] + v1[3]};
                    *(u32x4*)(base + (size_t)(ai * HALF + m * 16) * DM + bj * HALF) = pack8(o); }
    }
};
struct EpiLora {
    static constexpr bool PERM = true;
    float* wdec; bf16_t* abuf; bf16_t* gbuf; const float* w0; const float* a0;
    __device__ __forceinline__ void operator()(const f32x4 (&acc)[2][2][4][2], const Unit& u, int wr, int wc, int fr, int fq) const {
        const int row0 = u.pm * BM + wr * 64 + fr; const int type = u.pn >> 2; const int col0 = (u.pn & 3) * BM + wc * 32 + 8 * fq;
        if (type == 0) {
            f32x4 bv[2][2];
#pragma unroll
            for (int bj = 0; bj < 2; ++bj) { bv[bj][0] = *(const f32x4*)(w0 + col0 + bj * HALF); bv[bj][1] = *(const f32x4*)(w0 + col0 + bj * HALF + 4); }
#pragma unroll
            for (int ai = 0; ai < 2; ++ai)
#pragma unroll
                for (int m = 0; m < 4; ++m) { float* rowp = wdec + (size_t)(row0 + ai * HALF + m * 16) * 1024 + col0;
#pragma unroll
                    for (int bj = 0; bj < 2; ++bj)
#pragma unroll
                        for (int n = 0; n < 2; ++n) { f32x4 x = acc[ai][bj][m][n] + bv[bj][n]; f32x4 o;
#pragma unroll
                            for (int i = 0; i < 4; ++i) { const float y = -x[i]; const float sp = fmaxf(y, 0.f) + __logf(1.0f + __expf(-fabsf(y))); o[i] = __expf(-__expf(-sp - 0.5f)); }
                            *(f32x4*)(rowp + bj * HALF + 4 * n) = o; } }
        } else {
            bf16_t* ob = (type == 1) ? abuf : gbuf;
            f32x4 bv[2][2];
#pragma unroll
            for (int bj = 0; bj < 2; ++bj) { bv[bj][0] = *(const f32x4*)(a0 + col0 + bj * HALF); bv[bj][1] = *(const f32x4*)(a0 + col0 + bj * HALF + 4); }
#pragma unroll
            for (int ai = 0; ai < 2; ++ai)
#pragma unroll
                for (int m = 0; m < 4; ++m) { bf16_t* rowp = ob + (size_t)(row0 + ai * HALF + m * 16) * 1024 + col0;
#pragma unroll
                    for (int bj = 0; bj < 2; ++bj) { f32x4 v0 = acc[ai][bj][m][0], v1 = acc[ai][bj][m][1];
                        if (type == 1) { v0 = v0 + bv[bj][0]; v1 = v1 + bv[bj][1];
#pragma unroll
                            for (int i = 0; i < 4; ++i) { v0[i] = sigmoidf_(v0[i]); v1[i] = sigmoidf_(v1[i]); } }
                        u32x4 w; w.x = cvt_pk_bf16(v0[0], v0[1]); w.y = cvt_pk_bf16(v0[2], v0[3]); w.z = cvt_pk_bf16(v1[0], v1[1]); w.w = cvt_pk_bf16(v1[2], v1[3]);
                        *(u32x4*)(rowp + bj * HALF) = w; } }
        }
    }
};
struct EpiGate {
    static constexpr bool PERM = true;
    bf16_t* MG; const bf16_t* P;
    __device__ __forceinline__ void operator()(const f32x4 (&acc)[2][2][4][2], const Unit& u, int wr, int wc, int fr, int fq) const {
        const int br = u.pn >> 3; const int row0 = u.pm * BM + wr * 64 + fr; const int col0 = (u.pn & 7) * BM + wc * 32 + 8 * fq;
        const bf16_t* gbase = P + (size_t)row0 * PN + P_GATES + br * 2048 + col0; bf16_t* mbase = MG + (size_t)row0 * DM + col0;
        u32x4 gv[2][4][2], mv[2][4][2];
#define EG_LOADG(ai) do { _Pragma("unroll") for (int m = 0; m < 4; ++m) _Pragma("unroll") for (int bj = 0; bj < 2; ++bj) gv[ai][m][bj] = *(const u32x4*)(gbase + (size_t)((ai) * HALF + m * 16) * PN + bj * HALF); } while (0)
#define EG_LOADM(ai) do { if (br > 0) { _Pragma("unroll") for (int m = 0; m < 4; ++m) _Pragma("unroll") for (int bj = 0; bj < 2; ++bj) mv[ai][m][bj] = *(const u32x4*)(mbase + (size_t)((ai) * HALF + m * 16) * DM + bj * HALF); } } while (0)
#define EG_ROWS(ai, m0) do { _Pragma("unroll") for (int m = (m0); m < (m0) + 2; ++m) _Pragma("unroll") for (int bj = 0; bj < 2; ++bj) { const f32x4 v0 = acc[ai][bj][m][0], v1 = acc[ai][bj][m][1]; const u32x4 gt = gv[ai][m][bj]; \
            float o[8] = { v0[0] * sigmoidf_(bflo(gt.x)), v0[1] * sigmoidf_(bfhi(gt.x)), v0[2] * sigmoidf_(bflo(gt.y)), v0[3] * sigmoidf_(bfhi(gt.y)), \
                           v1[0] * sigmoidf_(bflo(gt.z)), v1[1] * sigmoidf_(bfhi(gt.z)), v1[2] * sigmoidf_(bflo(gt.w)), v1[3] * sigmoidf_(bfhi(gt.w)) }; \
            if (br > 0) { float p[8]; unpack8(mv[ai][m][bj], p); _Pragma("unroll") for (int i = 0; i < 8; ++i) o[i] += p[i]; } \
            *(u32x4*)(mbase + (size_t)((ai) * HALF + m * 16) * DM + bj * HALF) = pack8(o); } } while (0)
        EG_LOADG(0); EG_LOADM(0); __builtin_amdgcn_sched_barrier(0);
        EG_ROWS(0, 0); __builtin_amdgcn_sched_barrier(0);
        EG_LOADG(1); __builtin_amdgcn_sched_barrier(0);
        EG_ROWS(0, 2); __builtin_amdgcn_sched_barrier(0);
        EG_LOADM(1); __builtin_amdgcn_sched_barrier(0);
        EG_ROWS(1, 0); EG_ROWS(1, 2);
#undef EG_LOADG
#undef EG_LOADM
#undef EG_ROWS
    }
};
struct BranchOrder {
    StaticOrder base;
    __device__ bool next(int i, Unit& u) const { Unit t; if (!base.next(i / 3, t)) return false; u.pm = t.pm; u.pn = (i % 3) * 8 + t.pn; return true; }
    __device__ __forceinline__ void a_ready(const Unit&) const {}
    __device__ __forceinline__ void done(const Unit&) const {}
};
struct EpiSwiglu {
    static constexpr bool PERM = true;
    bf16_t* ACT;
    __device__ __forceinline__ void operator()(const f32x4 (&acc)[2][2][4][2], const Unit& u, int wr, int wc, int fr, int fq) const {
        const int row0 = u.pm * BM + wr * 64 + fr; const int col0 = u.pn * BM + wc * 32 + 8 * fq;
#pragma unroll
        for (int ai = 0; ai < 2; ++ai)
#pragma unroll
            for (int m = 0; m < 4; ++m) { const size_t row = (size_t)(row0 + ai * HALF + m * 16);
#pragma unroll
                for (int bj = 0; bj < 2; ++bj) { const int hc = (col0 + bj * HALF) >> 1; const f32x4 g = acc[ai][bj][m][0], up = acc[ai][bj][m][1];
                    float o[4];
#pragma unroll
                    for (int i = 0; i < 4; ++i) o[i] = g[i] * sigmoidf_(g[i]) * up[i];
                    u32x2 w; w.x = cvt_pk_bf16(o[0], o[1]); w.y = cvt_pk_bf16(o[2], o[3]);
                    *(u32x2*)(ACT + row * FFN + hc) = w; } }
    }
};
}

struct Args {
    const float* in[27];
    float* out; unsigned char* ws;
    int s_lo, s_hi, bar_idx, pad;
};
struct Ctx {
    float* out; unsigned char* ws; LAS unsigned char* lds; unsigned* ctl;
    int tid, lane, wave, G, wg;
};
enum { IN_X = 0, IN_META, IN_NORM_MIX, IN_W_IN, IN_MU, IN_W0, IN_W_UP, IN_A0, IN_A_UP, IN_G_UP, IN_K_K, IN_K_A, IN_R_K, IN_LN_W, IN_LN_B, IN_NORM_Q, IN_NORM_KV, IN_W_UQ, IN_W_UKV,
       IN_BR_RWKV, IN_BR_RET, IN_BR_MLA, IN_W_OUT, IN_NORM_FFN, IN_W_GU, IN_W_DOWN, IN_FINAL_NORM };

#define WSP(T, off) ((T*)(C.ws + (off)))
constexpr int LDS_INTBL = LDS_MISC + 256;
__device__ __forceinline__ const float* inp(const Ctx& C, int i) {
    const unsigned long long v = ((volatile LAS unsigned long long*)(C.lds + LDS_INTBL))[i];
    const unsigned lo = __builtin_amdgcn_readfirstlane((unsigned)v), hi = __builtin_amdgcn_readfirstlane((unsigned)(v >> 32));
    return (const float*)(GAS const float*)(((unsigned long long)hi << 32) | lo);
}

__device__ __forceinline__ void ph_rope_tables(const Ctx& C) {
    float* rt = WSP(float, WS_ROPE);
    float* cm = rt; float* sm = rt + LSEQ * 32; float* cr = rt + LSEQ * 64; float* sr = rt + LSEQ * 128;
    for (int i = C.wg * 512 + C.tid; i < LSEQ * 96; i += C.G * 512) {
        const int pos = i / 96, j = i % 96;
        if (j < 32) { const float inv = powf(10000.0f, -((float)(2 * j) / 64.0f)); const float ang = (float)pos * inv; cm[pos * 32 + j] = cosf(ang); sm[pos * 32 + j] = sinf(ang); }
        else { const int jj = j - 32; const float inv = powf(10000.0f, -((float)(2 * jj) / 128.0f)); const float ang = (float)pos * inv; cr[pos * 64 + jj] = cosf(ang); sr[pos * 64 + jj] = sinf(ang); }
    }
}

template <class RowPtr>
__device__ __forceinline__ void conv_T(const Ctx& C, const float* __restrict__ src, int ld, int K, int c0, int ncols, const float* __restrict__ gain, const RowPtr& rowptr, int& tbase) {
    LAS float* tile = (LAS float*)C.lds;
    const int nkt = K / 64, ntile = nkt * (ncols / 64);
    const int t = C.tid, kk = t >> 3, n8 = (t & 7) * 8;
    int ti = (C.wg - (tbase % C.G) + C.G) % C.G;
    tbase += ntile;
    if (ti >= ntile) return;
    f32x4 a, b; float gn;
    { const int k0 = (ti % nkt) * 64, n0 = c0 + (ti / nkt) * 64; const float* sp = src + (size_t)(k0 + kk) * ld + n0 + n8; a = *(const f32x4*)sp; b = *(const f32x4*)(sp + 4); gn = gain ? gain[k0 + kk] : 1.0f; }
    for (; ti < ntile; ti += C.G) {
        const int k0 = (ti % nkt) * 64, n0 = c0 + (ti / nkt) * 64;
        { LAS float* tp = tile + kk * 65 + n8;
          tp[0] = a[0] * gn; tp[1] = a[1] * gn; tp[2] = a[2] * gn; tp[3] = a[3] * gn; tp[4] = b[0] * gn; tp[5] = b[1] * gn; tp[6] = b[2] * gn; tp[7] = b[3] * gn; }
        { const int tn = ti + C.G; if (tn < ntile) { const int k1 = (tn % nkt) * 64, n1 = c0 + (tn / nkt) * 64; const float* sp = src + (size_t)(k1 + kk) * ld + n1 + n8; a = *(const f32x4*)sp; b = *(const f32x4*)(sp + 4); gn = gain ? gain[k1 + kk] : 1.0f; } }
        __syncthreads();
        { const int n = t >> 3, k8 = (t & 7) * 8; bf16_t* dp = rowptr(n0 + n);
          if (dp) { float v[8];
#pragma unroll
              for (int i = 0; i < 8; ++i) v[i] = tile[(k8 + i) * 65 + n];
              u32x4 w; w.x = cvt_pk_bf16(v[0], v[1]); w.y = cvt_pk_bf16(v[2], v[3]); w.z = cvt_pk_bf16(v[4], v[5]); w.w = cvt_pk_bf16(v[6], v[7]);
              *(u32x4*)(dp + k0 + k8) = w; } }
        __syncthreads();
    }
}
struct RpLinear { bf16_t* base; int ldk; int coff; int roff; __device__ __forceinline__ bf16_t* operator()(int n) const { return base + (size_t)(n - coff + roff) * ldk; } };
struct RpWin { bf16_t* win; bf16_t* wvret; __device__ __forceinline__ bf16_t* operator()(int n) const {
    if (n < 5568) return win + (size_t)n * DM; if (n < 6592) return wvret + (size_t)(n - 5568) * DM; return win + (size_t)(n - 1024) * DM; } };
struct RpUkv { bf16_t* wuk; bf16_t* wuv; __device__ __forceinline__ bf16_t* operator()(int n) const { const int h = n >> 8, j = n & 255; return (j < 128 ? wuk + (size_t)(h * 128 + j) * 256 : wuv + (size_t)(h * 128 + j - 128) * 256); } };
struct RpOut3 { bf16_t* base; int seg; __device__ __forceinline__ bf16_t* operator()(int n) const { return base + (size_t)n * 6144 + seg * 2048; } };
struct RpGu { bf16_t* base; __device__ __forceinline__ bf16_t* operator()(int n) const { const int which = n >= FFN ? 1 : 0; const int j = n - which * FFN; return base + (size_t)(8 * (j >> 2) + 4 * which + (j & 3)) * DM; } };

__device__ __forceinline__ void ph_convB(const Ctx& C, int l) {
    int tb = 0;
    conv_T(C, inp(C, IN_W_DOWN) + (size_t)l * FFN * DM, DM, FFN, 0, DM, nullptr, RpLinear{WSP(bf16_t, WS_WD), FFN, 0, 0}, tb);
    conv_T(C, inp(C, IN_W_OUT) + (size_t)l * DM * DM, DM, DM, 0, DM, nullptr, RpLinear{WSP(bf16_t, WS_WOUT), DM, 0, 0}, tb);
    conv_T(C, inp(C, IN_BR_RWKV) + (size_t)l * 1024 * DM, DM, 1024, 0, DM, nullptr, RpLinear{WSP(bf16_t, WS_WBR), 1024, 0, 0}, tb);
    conv_T(C, inp(C, IN_BR_RET) + (size_t)l * 1024 * DM, DM, 1024, 0, DM, nullptr, RpLinear{WSP(bf16_t, WS_WBR), 1024, 0, 2048}, tb);
    conv_T(C, inp(C, IN_BR_MLA) + (size_t)l * 1024 * DM, DM, 1024, 0, DM, nullptr, RpLinear{WSP(bf16_t, WS_WBR), 1024, 0, 4096}, tb);
}

__device__ __forceinline__ void ph_conv(const Ctx& C, int l) {
    int tb = 0;
    conv_T(C, inp(C, IN_W_IN) + (size_t)l * DM * IN_COLS, IN_COLS, DM, 0, IN_COLS, inp(C, IN_NORM_MIX) + l * DM, RpWin{WSP(bf16_t, WS_WIN), WSP(bf16_t, WS_WVRET)}, tb);
    conv_T(C, inp(C, IN_W_GU) + (size_t)l * DM * 2 * FFN, 2 * FFN, DM, 0, 2 * FFN, inp(C, IN_NORM_FFN) + l * DM, RpGu{WSP(bf16_t, WS_WGU)}, tb);
    conv_T(C, inp(C, IN_W_UQ) + (size_t)l * 512 * 1536, 1536, 512, 0, 1536, inp(C, IN_NORM_Q) + l * 512, RpLinear{WSP(bf16_t, WS_WUQ), 512, 0, 0}, tb);
    conv_T(C, inp(C, IN_W_UKV) + (size_t)l * 256 * 2048, 2048, 256, 0, 2048, inp(C, IN_NORM_KV) + l * 256, RpUkv{WSP(bf16_t, WS_WUK), WSP(bf16_t, WS_WUV)}, tb);
    { bf16_t* wl = WSP(bf16_t, WS_WLORA); const float* wup = inp(C, IN_W_UP) + (size_t)l * 96 * 1024; const float* aup = inp(C, IN_A_UP) + (size_t)l * 96 * 1024; const float* gup = inp(C, IN_G_UP) + (size_t)l * 256 * 1024;
      static_assert((LORA_N * LORA_K) % 4 == 0, "lora conversion");
      for (int i0 = (C.wg * 512 + C.tid) * 4; i0 < LORA_N * LORA_K; i0 += C.G * 512 * 4) { float v[4];
#pragma unroll
          for (int e = 0; e < 4; ++e) { const int i = i0 + e, n = i / LORA_K, k = i % LORA_K; v[e] = 0.f;
              if (n < 1024) { if (k < 96) v[e] = wup[k * 1024 + n]; } else if (n < 2048) { if (k >= 96 && k < 192) v[e] = aup[(k - 96) * 1024 + (n - 1024)]; } else { if (k >= 192 && k < 448) v[e] = gup[(k - 192) * 1024 + (n - 2048)]; } }
          *(u32x2*)(wl + i0) = (u32x2){cvt_pk_bf16(v[0], v[1]), cvt_pk_bf16(v[2], v[3])}; } }
}

template <bool FIRST>
__device__ __forceinline__ void ph_norm(const Ctx& C) {
    bf16_t* H = WSP(bf16_t, WS_H); bf16_t* U = WSP(bf16_t, WS_U);
    for (int r0 = C.wg * 8 + C.wave; r0 < MP; r0 += C.G * 16) {
        int rows[2]; rows[0] = r0; rows[1] = r0 + C.G * 8;
        float v[2][4][8]; u32x4 raw[2][4];
#pragma unroll
        for (int rr = 0; rr < 2; ++rr)
#pragma unroll
            for (int i = 0; i < 4; ++i) raw[rr][i] = zero4u();
#pragma unroll
        for (int rr = 0; rr < 2; ++rr) { const int row = rows[rr]; if (row >= M) continue;
            if (FIRST) { const int b = row / LSEQ, pos = row % LSEQ; const float* sp = pos < NMETA ? inp(C, IN_META) + (size_t)pos * DM : inp(C, IN_X) + ((size_t)b * SEQ + (pos - NMETA)) * DM;
#pragma unroll
                for (int i = 0; i < 4; ++i) ld8f(sp + (i * 64 + C.lane) * 8, v[rr][i]); }
            else { const bf16_t* hp = H + (size_t)row * DM;
#pragma unroll
                for (int i = 0; i < 4; ++i) raw[rr][i] = *(const u32x4*)(hp + (i * 64 + C.lane) * 8); } }
        __builtin_amdgcn_sched_barrier(0);
        if (!FIRST) {
#pragma unroll
            for (int rr = 0; rr < 2; ++rr)
#pragma unroll
                for (int i = 0; i < 4; ++i) unpack8(raw[rr][i], v[rr][i]); }
#pragma unroll
        for (int rr = 0; rr < 2; ++rr) { const int row = rows[rr]; if (row >= MP) continue;
            bf16_t* up = U + (size_t)row * DM;
            if (row >= M) { const u32x4 z = zero4u(); for (int i = 0; i < 4; ++i) *(u32x4*)(up + (i * 64 + C.lane) * 8) = z; continue; }
            bf16_t* hp = H + (size_t)row * DM; float ss = 0.f;
#pragma unroll
            for (int i = 0; i < 4; ++i)
#pragma unroll
                for (int j = 0; j < 8; ++j) ss += v[rr][i][j] * v[rr][i][j];
            ss = wsum64(ss); const float rstd = rsqrtf(ss * (1.0f / DM) + NORM_EPS);
#pragma unroll
            for (int i = 0; i < 4; ++i) { if (FIRST) *(u32x4*)(hp + (i * 64 + C.lane) * 8) = pack8(v[rr][i]);
                float o[8];
#pragma unroll
                for (int j = 0; j < 8; ++j) o[j] = v[rr][i][j] * rstd;
                *(u32x4*)(up + (i * 64 + C.lane) * 8) = pack8(o); } }
    }
}
__device__ __forceinline__ void ph_final(const Ctx& C) {
    const bf16_t* H = WSP(bf16_t, WS_H); const float* fn = inp(C, IN_FINAL_NORM);
    f32x4 gn[4][2];
#pragma unroll
    for (int i = 0; i < 4; ++i) { gn[i][0] = *(const f32x4*)(fn + (i * 64 + C.lane) * 8); gn[i][1] = *(const f32x4*)(fn + (i * 64 + C.lane) * 8 + 4); }
    for (int r = C.wg * 8 + C.wave; r < NB * SEQ; r += C.G * 8) {
        const int b = r / SEQ, t = r % SEQ; const bf16_t* sp = H + ((size_t)b * LSEQ + NMETA + t) * DM; float* op = C.out + (size_t)r * DM;
        float v[4][8]; float ss = 0.f; u32x4 raw[4];
#pragma unroll
        for (int i = 0; i < 4; ++i) raw[i] = *(const u32x4*)(sp + (i * 64 + C.lane) * 8);
        __builtin_amdgcn_sched_barrier(0);
#pragma unroll
        for (int i = 0; i < 4; ++i) { unpack8(raw[i], v[i]);
#pragma unroll
            for (int j = 0; j < 8; ++j) ss += v[i][j] * v[i][j]; }
        ss = wsum64(ss); const float rstd = rsqrtf(ss * (1.0f / DM) + NORM_EPS);
#pragma unroll
        for (int i = 0; i < 4; ++i) { const int c = (i * 64 + C.lane) * 8; const f32x4 g0 = gn[i][0], g1 = gn[i][1];
            *(f32x4*)(op + c) = (f32x4){v[i][0] * rstd * g0[0], v[i][1] * rstd * g0[1], v[i][2] * rstd * g0[2], v[i][3] * rstd * g0[3]};
            *(f32x4*)(op + c + 4) = (f32x4){v[i][4] * rstd * g1[0], v[i][5] * rstd * g1[1], v[i][6] * rstd * g1[2], v[i][7] * rstd * g1[3]}; }
    }
}
__device__ __forceinline__ void unpack8(const u32x4 w, float (&x)[8]) { x[0] = bflo(w.x); x[1] = bfhi(w.x); x[2] = bflo(w.y); x[3] = bfhi(w.y); x[4] = bflo(w.z); x[5] = bfhi(w.z); x[6] = bflo(w.w); x[7] = bfhi(w.w); }
__device__ __forceinline__ u32x4 pack8(const float (&x)[8]) { u32x4 w; w.x = cvt_pk_bf16(x[0], x[1]); w.y = cvt_pk_bf16(x[2], x[3]); w.z = cvt_pk_bf16(x[4], x[5]); w.w = cvt_pk_bf16(x[6], x[7]); return w; }

__device__ __forceinline__ void ph_prepA(const Ctx& C, int l) {
    const bf16_t* P = WSP(bf16_t, WS_P); bf16_t* XL = WSP(bf16_t, WS_XL); bf16_t* QN = WSP(bf16_t, WS_QN); bf16_t* KVN = WSP(bf16_t, WS_KVN); bf16_t* KR = WSP(bf16_t, WS_KR);
    const float* mu = inp(C, IN_MU) + (size_t)l * RW_COLS; const float* rt = WSP(float, WS_ROPE); const float* cm = rt; const float* sm = rt + LSEQ * 32;
    const int lane = C.lane;
    for (int row = C.wg * 8 + C.wave; row < MP; row += C.G * 8) {
        if (row >= M) { const u32x4 z = zero4u(); *(u32x4*)(XL + (size_t)row * 512 + 8 * lane) = z; *(u32x4*)(QN + (size_t)row * 512 + 8 * lane) = z;
            if (lane < 32) *(u32x4*)(KVN + (size_t)row * 256 + 8 * lane) = z; KR[(size_t)row * 64 + lane] = (bf16_t)z.x; continue; }
        const int pos = row % LSEQ; const bf16_t* pr = P + (size_t)row * PN;
        const int khl = lane >> 3, kc8 = (lane & 7) * 8; bf16_t* kbase = WSP(bf16_t, WS_P) + (size_t)row * PN + P_KRET + khl * 128 + kc8;
        const u32x4 kx1 = *(const u32x4*)kbase, kx2 = *(const u32x4*)(kbase + 64);
        float kcc[8], kss[8]; ld8f(rt + LSEQ * 64 + pos * 64 + kc8, kcc); ld8f(rt + LSEQ * 128 + pos * 64 + kc8, kss);
        const bool lact = lane < 56; const int lc = 3072 + 8 * (lact ? lane : 0);
        const u32x4 lz = *(const u32x4*)(pr + lc), lpz = *(const u32x4*)((pos > 0 ? pr - PN : pr) + lc); const f32x4 lm0 = *(const f32x4*)(mu + lc), lm1 = *(const f32x4*)(mu + lc + 4);
        const u32x4 qdw = *(const u32x4*)(pr + P_QD + 8 * lane), kvw = *(const u32x4*)(pr + P_KVD + 8 * (lane & 31));
        const bf16_t kr1 = pr[P_KRD + (lane & 31)], kr2 = pr[P_KRD + 32 + (lane & 31)]; const float krc = cm[pos * 32 + (lane & 31)], krs = sm[pos * 32 + (lane & 31)];
        { u32x4 o = zero4u();
          if (lact) { float z[8], pz[8];
              unpack8(lz, z);
              if (pos > 0) unpack8(lpz, pz); else { for (int i = 0; i < 8; ++i) pz[i] = 0.f; }
              const float mm[8] = {lm0[0], lm0[1], lm0[2], lm0[3], lm1[0], lm1[1], lm1[2], lm1[3]};
              float x[8];
#pragma unroll
              for (int i = 0; i < 8; ++i) { const float zs = z[i] + (pz[i] - z[i]) * mm[i]; x[i] = (lane < 12) ? tanhf(zs) : (lane < 24 ? zs : sigmoidf_(zs)); }
              o = pack8(x); }
          *(u32x4*)(XL + (size_t)row * 512 + 8 * lane) = o; }
        { float x[8]; unpack8(qdw, x); float ss = 0.f;
#pragma unroll
          for (int i = 0; i < 8; ++i) ss += x[i] * x[i];
          ss = wsum64(ss); const float rstd = rsqrtf(ss * (1.0f / 512.0f) + NORM_EPS);
#pragma unroll
          for (int i = 0; i < 8; ++i) x[i] *= rstd;
          *(u32x4*)(QN + (size_t)row * 512 + 8 * lane) = pack8(x); }
        { float x[8]; if (lane < 32) unpack8(kvw, x); else { for (int i = 0; i < 8; ++i) x[i] = 0.f; }
          float ss = 0.f;
#pragma unroll
          for (int i = 0; i < 8; ++i) ss += x[i] * x[i];
          ss = wsum64(ss); const float rstd = rsqrtf(ss * (1.0f / 256.0f) + NORM_EPS);
#pragma unroll
          for (int i = 0; i < 8; ++i) x[i] *= rstd;
          if (lane < 32) *(u32x4*)(KVN + (size_t)row * 256 + 8 * lane) = pack8(x); }
        { float x1[8], x2[8], o1[8], o2[8]; unpack8(kx1, x1); unpack8(kx2, x2);
#pragma unroll
          for (int i = 0; i < 8; ++i) { o1[i] = (x1[i] * kcc[i] - x2[i] * kss[i]) * 0.08838834764831845f; o2[i] = (x2[i] * kcc[i] + x1[i] * kss[i]) * 0.08838834764831845f; }
          *(u32x4*)kbase = pack8(o1); *(u32x4*)(kbase + 64) = pack8(o2); }
        if (lane < 32) { const float x1 = bf2f(kr1), x2 = bf2f(kr2); const float c = krc, s = krs;
            KR[(size_t)row * 64 + lane] = f2bf(x1 * c - x2 * s); KR[(size_t)row * 64 + 32 + lane] = f2bf(x2 * c + x1 * s); }
    }
}
__device__ __forceinline__ float sum8(float x) { x += dpp_xor1(x); x += dpp_xor2(x); x += dpp_hmirror(x); return x; }
__device__ __forceinline__ void ld8f(const float* p, float (&x)[8]) { const f32x4 a = *(const f32x4*)p, b = *(const f32x4*)(p + 4); x[0] = a[0]; x[1] = a[1]; x[2] = a[2]; x[3] = a[3]; x[4] = b[0]; x[5] = b[1]; x[6] = b[2]; x[7] = b[3]; }
__device__ __forceinline__ void ph_qrope(const Ctx& C) {
    bf16_t* Q = WSP(bf16_t, WS_Q); const float* rt = WSP(float, WS_ROPE); const float* cm = rt; const float* sm = rt + LSEQ * 32;
    const int lane = C.lane, hl = lane >> 3;
    for (int r0 = C.wg * 8 + C.wave; r0 < M; r0 += C.G * 16) {
        int rows[2]; bool ok[2]; rows[0] = r0; ok[0] = true; rows[1] = r0 + C.G * 8; ok[1] = rows[1] < M; if (!ok[1]) rows[1] = r0;
        u32x2 m1w[2], m2w[2];
#pragma unroll
        for (int rr = 0; rr < 2; ++rr) { const bf16_t* mb = Q + (size_t)rows[rr] * 1536 + hl * 192 + 128 + (lane & 7) * 4; m1w[rr] = *(const u32x2*)mb; m2w[rr] = *(const u32x2*)(mb + 32); }
#pragma unroll
        for (int rr = 0; rr < 2; ++rr) { if (!ok[rr]) continue;
            const int pos = rows[rr] % LSEQ; bf16_t* base = Q + (size_t)rows[rr] * 1536 + hl * 192 + 128 + (lane & 7) * 4; const u32x2 w1 = m1w[rr], w2 = m2w[rr];
            const f32x4 c4 = *(const f32x4*)(cm + pos * 32 + (lane & 7) * 4), s4 = *(const f32x4*)(sm + pos * 32 + (lane & 7) * 4);
            const float x1[4] = {bflo(w1.x), bfhi(w1.x), bflo(w1.y), bfhi(w1.y)}, x2[4] = {bflo(w2.x), bfhi(w2.x), bflo(w2.y), bfhi(w2.y)};
            float o1[4], o2[4];
#pragma unroll
            for (int i = 0; i < 4; ++i) { o1[i] = x1[i] * c4[i] - x2[i] * s4[i]; o2[i] = x2[i] * c4[i] + x1[i] * s4[i]; }
            *(u32x2*)base = (u32x2){cvt_pk_bf16(o1[0], o1[1]), cvt_pk_bf16(o1[2], o1[3])}; *(u32x2*)(base + 32) = (u32x2){cvt_pk_bf16(o2[0], o2[1]), cvt_pk_bf16(o2[2], o2[3])}; }
    }
}
__device__ __forceinline__ void ph_post(const Ctx& C, int l) {
    unsigned char* rw = C.ws + WS_RW; const float* YR = (const float*)(rw + RW_YRAW);
    const bf16_t* Gb = (const bf16_t*)(rw + RW_A + 1 * RW_ARR); const float* BS = (const float*)(rw + RW_A + 2 * RW_ARR); const bf16_t* P = WSP(bf16_t, WS_P);
    bf16_t* YA = WSP(bf16_t, WS_YBR);
    const float* mu_v = inp(C, IN_MU) + (size_t)l * RW_COLS + 2048; const float* ln_w = inp(C, IN_LN_W) + l * 1024; const float* ln_b = inp(C, IN_LN_B) + l * 1024;
    const int lane = C.lane, hl = lane >> 3, c8 = (lane & 7) * 8;
    for (int r0 = C.wg * 8 + C.wave; r0 < MP; r0 += C.G * 16) {
        int rows[2]; bool live[2]; rows[0] = r0; rows[1] = r0 + C.G * 8; live[0] = rows[0] < M; live[1] = rows[1] < M;
#pragma unroll
        for (int rr = 0; rr < 2; ++rr) if (rows[rr] < MP && !live[rr]) { const u32x4 z = zero4u(); *(u32x4*)(YA + (size_t)rows[rr] * 1024 + 16 * lane) = z; *(u32x4*)(YA + (size_t)rows[rr] * 1024 + 16 * lane + 8) = z; }
        u32x4 wv_[2][2], wp_[2][2], wg_[2][2]; f32x4 ya[2][2], yb[2][2]; float bsv[2][2], hpf[2];
#pragma unroll
        for (int rr = 0; rr < 2; ++rr) { const int row = live[rr] ? rows[rr] : 0; const bool hp = (row % LSEQ) > 0; hpf[rr] = hp ? 1.0f : 0.0f;
            const bf16_t* pr = P + (size_t)row * PN + 2048; const bf16_t* pp = hp ? pr - PN : pr;
#pragma unroll
            for (int ps = 0; ps < 2; ++ps) { const int c = (8 * ps + hl) * 64 + c8; const size_t o = (size_t)row * 1024 + c;
                ya[rr][ps] = *(const f32x4*)(YR + o); yb[rr][ps] = *(const f32x4*)(YR + o + 4); wv_[rr][ps] = *(const u32x4*)(pr + c); wp_[rr][ps] = *(const u32x4*)(pp + c); wg_[rr][ps] = *(const u32x4*)(Gb + o);
                bsv[rr][ps] = BS[(size_t)row * 16 + 8 * ps + hl]; } }
#pragma unroll
        for (int ps = 0; ps < 2; ++ps) {
            const int c = (8 * ps + hl) * 64 + c8; float mv[8], lw[8], lb[8];
            ld8f(mu_v + c, mv); ld8f(ln_w + c, lw); ld8f(ln_b + c, lb);
#pragma unroll
            for (int rr = 0; rr < 2; ++rr) {
                float y[8] = {ya[rr][ps][0], ya[rr][ps][1], ya[rr][ps][2], ya[rr][ps][3], yb[rr][ps][0], yb[rr][ps][1], yb[rr][ps][2], yb[rr][ps][3]}, zv[8], qv[8], gg[8], out[8];
                unpack8(wv_[rr][ps], zv); unpack8(wp_[rr][ps], qv); unpack8(wg_[rr][ps], gg);
                const float bs = bsv[rr][ps];
                float s = 0.f;
#pragma unroll
                for (int i = 0; i < 8; ++i) s += y[i];
                const float mean = sum8(s) * (1.0f / 64.0f);
                float q = 0.f;
#pragma unroll
                for (int i = 0; i < 8; ++i) { y[i] -= mean; q += y[i] * y[i]; }
                const float rstd = rsqrtf(sum8(q) * (1.0f / 64.0f) + GN_EPS);
#pragma unroll
                for (int i = 0; i < 8; ++i) { const float vv = zv[i] + (qv[i] * hpf[rr] - zv[i]) * mv[i]; out[i] = (y[i] * rstd * lw[i] + lb[i] + bs * vv) * gg[i]; }
                if (live[rr]) *(u32x4*)(YA + (size_t)rows[rr] * 1024 + c) = pack8(out);
            }
        }
    }
}

#define MFMA_DRAIN(acc) asm volatile("s_nop 15\n\ts_nop 4" : "+v"(acc))
__device__ __forceinline__ void ph_rwkvpre(const Ctx& C, int l) {
    constexpr int WSC = 10240;
    LAS unsigned char* sc = C.lds + C.wave * WSC;
    LAS float* Gm = (LAS float*)sc;
    LAS float* TM = (LAS float*)(sc + 4608);
    LAS float* TMT = TM + 256; LAS float* FT = TM + 512; LAS float* W2 = TM + 768; LAS float* YBT = TM + 1024;
    unsigned char* rw = C.ws + WS_RW;
    const float* WD = (const float*)(rw + RW_WDEC); const bf16_t* Ag = (const bf16_t*)(rw + RW_A); const bf16_t* P = WSP(bf16_t, WS_P);
    float* BS = (float*)(rw + RW_A + 2 * RW_ARR);
    const float* mu = inp(C, IN_MU) + (size_t)l * RW_COLS; const float* k_k = inp(C, IN_K_K) + l * 1024; const float* k_a = inp(C, IN_K_A) + l * 1024; const float* r_k = inp(C, IN_R_K) + l * 1024;
    unsigned char* RCH = C.ws + WS_RCH;
    const int lane = C.lane, ql = lane & 31, hh = lane >> 5, t = lane & 15, q4 = (lane >> 4) * 4;
    for (int u = C.wg * 8 + C.wave; u < NB * 16 * NCHUNK; u += C.G * 8) {
        const int bh = u / NCHUNK, c = u - bh * NCHUNK;
        const int hd = bh & 15, chn = hd * 64 + lane; const size_t row0 = (size_t)(bh >> 4) * LSEQ + 16 * c;
        unsigned char* rec = RCH + (size_t)u * RC_STRIDE;
        float Kb[16], Rb[16], Kh[16], Bh[16]; unsigned vpk[8]; float gC;
        {
            unsigned short zr[17], zk[17], zv[17], za[16]; float wv[16];
#pragma unroll
            for (int i = 0; i < 17; ++i) { const size_t pr = (row0 + (size_t)((i == 0 && c == 0) ? 0 : i - 1)) * PN + chn; zr[i] = P[pr]; zk[i] = P[pr + 1024]; zv[i] = P[pr + 2048]; }
#pragma unroll
            for (int i = 0; i < 16; ++i) { const size_t o = (row0 + i) * 1024 + chn; za[i] = Ag[o]; wv[i] = WD[o]; }
            const float mur = mu[chn], muk = mu[1024 + chn], muv = mu[2048 + chn], kkc = k_k[chn], kac = k_a[chn], rkc = r_k[chn];
            float g = 1.0f; float vxs[16]; int bsv = 0;
#pragma unroll
            for (int i = 0; i < 16; ++i) {
                const float hp = (i == 0 && c == 0) ? 0.0f : 1.0f;
                const float cr = bf2f(zr[i + 1]), ck = bf2f(zk[i + 1]), cv = bf2f(zv[i + 1]);
                const float rr = cr + (bf2f(zr[i]) * hp - cr) * mur, kx = ck + (bf2f(zk[i]) * hp - ck) * muk, vx = cv + (bf2f(zv[i]) * hp - cv) * muv;
                const float av = bf2f(za[i]);
                float kkx = kx * kkc; const float n2 = wsum64_dpp(kkx * kkx); kkx *= __builtin_amdgcn_rsqf(fmaxf(n2, 1e-24f));
                const float kpx = kx * (1.0f + (av - 1.0f) * kac), bbx = kkx * av;
                const float bs = wsum64_dpp(rr * kpx * rkc); bsv = (lane == i) ? __float_as_int(bs) : bsv;
                const float gp = g; g *= wv[i]; const float ig = __builtin_amdgcn_rcpf(g);
                Kb[i] = kkx * gp; Rb[i] = rr * g; Kh[i] = kpx * ig; Bh[i] = bbx * ig;
                vxs[i] = vx;
                *(LAS bf16_t*)(sc + i * 144 + lane * 2) = f2bf(Kh[i]); *(LAS bf16_t*)(sc + (16 + i) * 144 + lane * 2) = f2bf(Bh[i]);
                *(LAS bf16_t*)(sc + 4608 + i * 144 + lane * 2) = f2bf(Kb[i]); *(LAS bf16_t*)(sc + 4608 + (16 + i) * 144 + lane * 2) = f2bf(Rb[i]); }
#pragma unroll
            for (int i = 0; i < 16; ++i) { Kh[i] *= g; Bh[i] *= g; }
            gC = g;
#pragma unroll
            for (int i = 0; i < 8; ++i) vpk[i] = cvt_pk_bf16(vxs[2 * i], vxs[2 * i + 1]);
            if (lane < 16) BS[(row0 + lane) * 16 + hd] = __int_as_float(bsv);
        }
        __builtin_amdgcn_wave_barrier();
        {
            f32x16 acc;
#pragma unroll
            for (int r = 0; r < 16; ++r) acc[r] = 0.f;
#pragma unroll
            for (int s = 0; s < 4; ++s) { const bf16x8 a = *(const LAS bf16x8*)(sc + ql * 144 + 32 * s + 16 * hh); const bf16x8 bq = *(const LAS bf16x8*)(sc + 4608 + ql * 144 + 32 * s + 16 * hh);
                acc = __builtin_amdgcn_mfma_f32_32x32x16_bf16(a, bq, acc, 0, 0, 0); }
            __builtin_amdgcn_wave_barrier();
#pragma unroll
            for (int r = 0; r < 16; ++r) { const int row = (r & 3) + 8 * (r >> 2) + 4 * hh, i = row & 15; const bool keep = (ql >= 16) ? (i <= (ql & 15)) : (i < ql); Gm[row * 36 + ql] = keep ? acc[r] : 0.f; }
        }
        __builtin_amdgcn_wave_barrier();
        {
            float X[16];
#pragma unroll
            for (int i = 15; i >= 0; --i) { float x = (t == i) ? 1.0f : 0.0f; const LAS float* er = Gm + (16 + i) * 36;
#pragma unroll
                for (int j = i + 1; j < 16; ++j) x -= er[j] * X[j];
                X[i] = x; }
#pragma unroll
            for (int i = 0; i < 16; ++i) TM[i * 16 + t] = X[i];
#pragma unroll
            for (int i = 0; i < 4; ++i) *(LAS f32x4*)(TMT + t * 16 + 4 * i) = (f32x4){X[4 * i], X[4 * i + 1], X[4 * i + 2], X[4 * i + 3]};
            float E2c[16];
#pragma unroll
            for (int j = 0; j < 16; ++j) E2c[j] = Gm[(16 + j) * 36 + 16 + t];
#pragma unroll
            for (int e = 0; e < 4; ++e) { const LAS float* ar = Gm + (q4 + e) * 36; float s = 0.f;
#pragma unroll
                for (int i = 0; i < 16; ++i) s += ar[i] * X[i];
                W2[(q4 + e) * 16 + t] = s; }
            __builtin_amdgcn_wave_barrier();
            f32x4 fv, yv;
#pragma unroll
            for (int e = 0; e < 4; ++e) { const LAS float* tr = TM + (q4 + e) * 16; const LAS float* wr = W2 + (q4 + e) * 16; float s = 0.f, y = Gm[(q4 + e) * 36 + 16 + t];
#pragma unroll
                for (int j = 0; j < 16; ++j) { s += tr[j] * E2c[j]; y -= wr[j] * E2c[j]; }
                fv[e] = s; yv[e] = y; }
            *(LAS f32x4*)(FT + t * 16 + q4) = fv; *(LAS f32x4*)(YBT + t * 16 + q4) = yv;
        }
        __builtin_amdgcn_wave_barrier();
        {
            { unsigned char* b2 = rec + RC_B2 + lane * 80;
              *(u32x4*)(b2) = (u32x4){cvt_pk_bf16(-Bh[0], -Bh[1]), cvt_pk_bf16(-Bh[2], -Bh[3]), cvt_pk_bf16(-Bh[4], -Bh[5]), cvt_pk_bf16(-Bh[6], -Bh[7])};
              *(u32x4*)(b2 + 16) = (u32x4){cvt_pk_bf16(-Bh[8], -Bh[9]), cvt_pk_bf16(-Bh[10], -Bh[11]), cvt_pk_bf16(-Bh[12], -Bh[13]), cvt_pk_bf16(-Bh[14], -Bh[15])}; }
            u32x4 kb0, kb1, rb0, rb1, bh0, bh1, kh0, kh1;
#define RC_BOP(src_, t0_, t1_) do { _Pragma("unroll") for (int e = 0; e < 4; ++e) { const unsigned x_ = cvt_pk_bf16(src_[2 * e], src_[2 * e + 1]), y_ = cvt_pk_bf16(src_[8 + 2 * e], src_[9 + 2 * e]); \
                const auto sw_ = __builtin_amdgcn_permlane32_swap(x_, y_, false, false); t0_[e] = sw_[0]; t1_[e] = sw_[1]; } } while (0)
            RC_BOP(Kb, kb0, kb1); RC_BOP(Rb, rb0, rb1); RC_BOP(Bh, bh0, bh1); RC_BOP(Kh, kh0, kh1);
#undef RC_BOP
            const bool lo16 = ql < 16; const int m16 = ql & 15;
            u32x4 aPA, aPB, aIlo, aIhi;
            { const LAS float* ap = (lo16 ? TMT : FT) + m16 * 16 + 8 * hh; const f32x4 a0 = *(const LAS f32x4*)ap, a1 = *(const LAS f32x4*)(ap + 4); const float sg = lo16 ? 1.0f : -1.0f;
              aPA = (u32x4){cvt_pk_bf16(a0[0] * sg, a0[1] * sg), cvt_pk_bf16(a0[2] * sg, a0[3] * sg), cvt_pk_bf16(a1[0] * sg, a1[1] * sg), cvt_pk_bf16(a1[2] * sg, a1[3] * sg)};
              const LAS float* wp = W2 + m16 * 16 + 8 * hh; const f32x4 w0 = *(const LAS f32x4*)wp, w1 = *(const LAS f32x4*)(wp + 4); const float sw = lo16 ? -1.0f : 0.0f;
              aPB = (u32x4){cvt_pk_bf16(w0[0] * sw, w0[1] * sw), cvt_pk_bf16(w0[2] * sw, w0[3] * sw), cvt_pk_bf16(w1[0] * sw, w1[1] * sw), cvt_pk_bf16(w1[2] * sw, w1[3] * sw)};
#pragma unroll
              for (int e = 0; e < 4; ++e) { const unsigned idv = (m16 == 8 * hh + 2 * e ? 0x3F80u : 0u) | (m16 == 8 * hh + 2 * e + 1 ? 0x3F800000u : 0u); aIlo[e] = lo16 ? idv : 0u; aIhi[e] = lo16 ? 0u : idv; } }
            bf16x8 fa, fb, fc, fi;
            bf16_t* b1 = (bf16_t*)rec + ql + (4 * hh) * 88;
            unsigned char* q0 = rec + RC_B2 + ql * 80 + 32 + 8 * hh;
            __builtin_memcpy(&fa, &aPA, 16); __builtin_memcpy(&fi, &aIhi, 16);
#pragma unroll
            for (int T = 0; T < 2; ++T) {
                f32x16 pa;
#pragma unroll
                for (int r = 0; r < 16; ++r) pa[r] = 0.f;
                __builtin_memcpy(&fb, T ? &kb1 : &kb0, 16); __builtin_memcpy(&fc, T ? &rb1 : &rb0, 16);
                pa = __builtin_amdgcn_mfma_f32_32x32x16_bf16(fa, fb, pa, 0, 0, 0); pa = __builtin_amdgcn_mfma_f32_32x32x16_bf16(fi, fc, pa, 0, 0, 0);
                MFMA_DRAIN(pa);
#pragma unroll
                for (int r = 0; r < 16; ++r) b1[((r & 3) + 8 * (r >> 2)) * 88 + 32 * T] = f2bf(pa[r]);
            }
            __builtin_memcpy(&fa, &aPB, 16); __builtin_memcpy(&fi, &aIlo, 16);
#pragma unroll
            for (int T = 0; T < 2; ++T) {
                f32x16 pb;
#pragma unroll
                for (int r = 0; r < 16; ++r) pb[r] = 0.f;
                __builtin_memcpy(&fb, T ? &bh1 : &bh0, 16); __builtin_memcpy(&fc, T ? &kh1 : &kh0, 16);
                pb = __builtin_amdgcn_mfma_f32_32x32x16_bf16(fa, fb, pb, 0, 0, 0); pb = __builtin_amdgcn_mfma_f32_32x32x16_bf16(fi, fc, pb, 0, 0, 0);
                MFMA_DRAIN(pb);
                *(u32x2*)(q0 + T * 32 * 80) = (u32x2){cvt_pk_bf16(pb[0], pb[1]), cvt_pk_bf16(pb[2], pb[3])}; *(u32x2*)(q0 + T * 32 * 80 + 16) = (u32x2){cvt_pk_bf16(pb[4], pb[5]), cvt_pk_bf16(pb[6], pb[7])};
            }
            { const int tr_ = lane >> 2, part = lane & 3; const f32x4 y4 = *(const LAS f32x4*)(YBT + tr_ * 16 + 4 * part);
              unsigned zz; asm volatile("v_mov_b32 %0, 0" : "=v"(zz));
              *(u32x2*)(rec + tr_ * 176 + 128 + 8 * part) = (u32x2){zz, zz};
              *(u32x2*)(rec + (16 + tr_) * 176 + 128 + 8 * part) = (u32x2){cvt_pk_bf16(y4[0], y4[1]), cvt_pk_bf16(y4[2], y4[3])}; }
            unsigned char* vt = rec + RC_VT + lane * 48;
            *(u32x4*)(vt) = (u32x4){vpk[0], vpk[1], vpk[2], vpk[3]}; *(u32x4*)(vt + 16) = (u32x4){vpk[4], vpk[5], vpk[6], vpk[7]};
            *(float*)(rec + RC_G + 4 * lane) = gC;
        }
        __builtin_amdgcn_wave_barrier();
    }
    __syncthreads();
}

#define SEQ_BAR() asm volatile("s_waitcnt lgkmcnt(0)\n\ts_barrier" ::: "memory")
__device__ __forceinline__ void rwkv_seq_unit(const Ctx& C, int b, int hd) {
    constexpr int NR = 8, PF = 6;
    LAS unsigned char* ring = C.lds; LAS unsigned char* Zi = C.lds + NR * RC_STRIDE; LAS unsigned char* Ui = Zi + 64 * 144;
    const unsigned char* recs = C.ws + WS_RCH + (size_t)(b * 16 + hd) * NCHUNK * RC_STRIDE;
    float* YR = (float*)(C.ws + WS_RW + RW_YRAW) + (size_t)b * LSEQ * 1024 + hd * 64;
    const int tid = C.tid, w = C.wave, lane = C.lane, ql = lane & 31, hh = lane >> 5;
    const int lw = w - 4;
    for (int i = tid; i < 576; i += 512) *(LAS u32x4*)(Zi + 16 * i) = zero4u();
    auto issue = [&](int c) {
        const unsigned char* src = recs + (size_t)c * RC_STRIDE + lane * 16; LAS unsigned char* dst = ring + (c & (NR - 1)) * RC_STRIDE;
#pragma unroll
        for (int k = 0; k < 4; ++k) { const int q = lw + 4 * k; if (q < 14) __builtin_amdgcn_global_load_lds((const unsigned*)(src + q * 1024), (LAS unsigned*)(dst + q * 1024), 16, 0, 0); }
    };
    if (w >= 4) {
#pragma unroll
        for (int c = 0; c < PF; ++c) issue(c);
        if (lw < 2) asm volatile("s_waitcnt vmcnt(20)" ::: "memory"); else asm volatile("s_waitcnt vmcnt(15)" ::: "memory");
    }
    f32x16 Zt;
    { float zf; asm volatile("v_mov_b32 %0, 0" : "=v"(zf));
#pragma unroll
      for (int r = 0; r < 16; ++r) Zt[r] = zf; }
    __syncthreads();
    for (int c = 0; c < NCHUNK; ++c) {
        const LAS unsigned char* rec = ring + (c & (NR - 1)) * RC_STRIDE;
        if (w < 2) {
            f32x16 p;
#pragma unroll
            for (int r = 0; r < 16; ++r) p[r] = 0.f;
            const LAS unsigned char* ap = rec + RC_B1 + ql * 176 + hh * 16; const LAS unsigned char* bp = Zi + (32 * w + ql) * 144 + hh * 16;
#pragma unroll
            for (int s = 0; s < 4; ++s) { const bf16x8 a = *(const LAS bf16x8*)(ap + 32 * s); const bf16x8 bq = *(const LAS bf16x8*)(bp + 32 * s); p = __builtin_amdgcn_mfma_f32_32x32x16_bf16(a, bq, p, 0, 0, 0); }
            { const bf16x8 a = *(const LAS bf16x8*)(ap + 128); const bf16x8 bq = *(const LAS bf16x8*)(rec + RC_VT + (32 * w + ql) * 48 + hh * 16); p = __builtin_amdgcn_mfma_f32_32x32x16_bf16(a, bq, p, 0, 0, 0); }
            MFMA_DRAIN(p);
            LAS unsigned char* up = Ui + (32 * w + ql) * 48 + hh * 8;
            *(LAS u32x2*)up = (u32x2){cvt_pk_bf16(p[0], p[1]), cvt_pk_bf16(p[2], p[3])}; *(LAS u32x2*)(up + 16) = (u32x2){cvt_pk_bf16(p[4], p[5]), cvt_pk_bf16(p[6], p[7])};
            float* yp = YR + (size_t)(16 * c + 4 * hh) * 1024 + 32 * w + ql;
#pragma unroll
            for (int r = 8; r < 16; ++r) yp[((r & 3) + 8 * ((r - 8) >> 2)) * 1024] = p[r];
        } else if (w >= 4) {
            if (c + PF < NCHUNK) issue(c + PF);
        }
        SEQ_BAR();
        if (w < 4) {
            const int ti = w >> 1, tj = w & 1;
            const LAS float* gp = (const LAS float*)(rec + RC_G) + 32 * ti + 4 * hh;
#pragma unroll
            for (int q = 0; q < 4; ++q) { const f32x4 g4 = *(const LAS f32x4*)(gp + 8 * q); Zt[4 * q] *= g4[0]; Zt[4 * q + 1] *= g4[1]; Zt[4 * q + 2] *= g4[2]; Zt[4 * q + 3] *= g4[3]; }
            const LAS unsigned char* ap = rec + RC_B2 + (32 * ti + ql) * 80 + hh * 16;
            const bf16x8 a0 = *(const LAS bf16x8*)ap, a1 = *(const LAS bf16x8*)(ap + 32);
            const bf16x8 b0 = *(const LAS bf16x8*)(Ui + (32 * tj + ql) * 48 + hh * 16), b1 = *(const LAS bf16x8*)(rec + RC_VT + (32 * tj + ql) * 48 + hh * 16);
            Zt = __builtin_amdgcn_mfma_f32_32x32x16_bf16(a0, b0, Zt, 0, 0, 0);
            Zt = __builtin_amdgcn_mfma_f32_32x32x16_bf16(a1, b1, Zt, 0, 0, 0);
            MFMA_DRAIN(Zt);
            LAS unsigned char* zp = Zi + (32 * tj + ql) * 144 + (32 * ti + 4 * hh) * 2;
#pragma unroll
            for (int q = 0; q < 4; ++q) *(LAS u32x2*)(zp + 16 * q) = (u32x2){cvt_pk_bf16(Zt[4 * q], Zt[4 * q + 1]), cvt_pk_bf16(Zt[4 * q + 2], Zt[4 * q + 3])};
        } else {
            if (c + PF < NCHUNK) { if (lw < 2) asm volatile("s_waitcnt vmcnt(20)" ::: "memory"); else asm volatile("s_waitcnt vmcnt(15)" ::: "memory"); }
            else asm volatile("s_waitcnt vmcnt(0)" ::: "memory");
        }
        SEQ_BAR();
    }
}

template <int MODE>
__device__ __forceinline__ void attn_unit(const Ctx& C, int b, int hd, int qblk) {
    constexpr int DQ = MODE == 0 ? 192 : 128, NS = DQ / 16, KP = DQ * 2 + 16, VP = 136;
    constexpr int KB_BYTES = 64 * KP, VB_BYTES = 128 * VP, NKPC = 64 * (DQ / 8) / 512;
    LAS unsigned char* Kb = C.lds; LAS unsigned char* Vbuf = C.lds + 2 * KB_BYTES;
    const bf16_t* P = WSP(bf16_t, WS_P); const bf16_t* Qm = WSP(bf16_t, WS_Q); const bf16_t* KN = WSP(bf16_t, WS_KNOPE); const bf16_t* KRp = WSP(bf16_t, WS_KR);
    const bf16_t* VT = MODE == 0 ? WSP(bf16_t, WS_VTMLA) : WSP(bf16_t, WS_VTRET);
    bf16_t* Y = WSP(bf16_t, WS_YBR) + (MODE == 0 ? 2 : 1) * (size_t)MP * 1024;
    const int tid = C.tid, w = C.wave, lane = C.lane, ql = lane & 31, hh = lane >> 5;
    const size_t rb = (size_t)b * LSEQ;
    const int qpos = 256 * qblk + 32 * w + ql; const bool qvalid = qpos < LSEQ; const int qposc = qvalid ? qpos : LSEQ - 1;
    const int wqmin = 256 * qblk + 32 * w; const bool wactive = wqmin < LSEQ; const int wqmax = (wqmin + 31 < LSEQ - 1) ? wqmin + 31 : LSEQ - 1;
    const int nkt = (4 * qblk + 4 < 65) ? 4 * qblk + 4 : 65;
    const int j0 = MODE == 1 ? 4 * qblk : 0;
    bf16x8 Qf[NS];
    { const bf16_t* qrow = MODE == 0 ? Qm + (rb + qposc) * 1536 + hd * 192 : P + (rb + qposc) * PN + P_QRET + hd * 128;
#pragma unroll
      for (int s = 0; s < NS; ++s) Qf[s] = *(const bf16x8*)(qrow + 16 * s + 8 * hh); }
    if (MODE == 1) {
        const float* rt = WSP(float, WS_ROPE);
        constexpr int NP = MODE == 0 ? 2 : 4, S0 = MODE == 0 ? 8 : 0, DS = MODE == 0 ? 2 : 4;
        const float* cp = MODE == 0 ? rt + (size_t)qposc * 32 + 8 * hh : rt + (size_t)LSEQ * 64 + (size_t)qposc * 64 + 8 * hh;
        const float* sp = MODE == 0 ? rt + (size_t)LSEQ * 32 + (size_t)qposc * 32 + 8 * hh : rt + (size_t)LSEQ * 128 + (size_t)qposc * 64 + 8 * hh;
#pragma unroll
        for (int s = 0; s < NP; ++s) { u32x4 w1, w2; __builtin_memcpy(&w1, &Qf[S0 + s], 16); __builtin_memcpy(&w2, &Qf[S0 + s + DS], 16);
            float x1[8], x2[8], cc[8], ss[8], o1[8], o2[8]; unpack8(w1, x1); unpack8(w2, x2); ld8f(cp + 16 * s, cc); ld8f(sp + 16 * s, ss);
#pragma unroll
            for (int e = 0; e < 8; ++e) { o1[e] = x1[e] * cc[e] - x2[e] * ss[e]; o2[e] = x2[e] * cc[e] + x1[e] * ss[e]; }
            w1 = pack8(o1); w2 = pack8(o2); __builtin_memcpy(&Qf[S0 + s], &w1, 16); __builtin_memcpy(&Qf[S0 + s + DS], &w2, 16); }
    }
    f32x16 O[4];
#pragma unroll
    for (int d = 0; d < 4; ++d)
#pragma unroll
        for (int r = 0; r < 16; ++r) O[d][r] = 0.f;
    float m_run = -INFINITY, lsum = 0.f;
    const float csm = 0.07216878364870322f * 1.4426950408889634f;
    const float lg2g = MODE == 1 ? log1pf(-exp2f(-5.0f - (float)hd)) * 1.4426950408889634f : 0.f;
    u32x4 kreg[NKPC], vreg[2];
    auto gload = [&](int j) {
#pragma unroll
        for (int i = 0; i < NKPC; ++i) { const int pi = tid + i * 512, r = pi / (DQ / 8), c = pi % (DQ / 8); const size_t krow = rb + 64 * j + r;
            const bf16_t* sp;
            if (MODE == 0) sp = (c < 16) ? KN + krow * 1024 + hd * 128 + 8 * c : KRp + krow * 64 + 8 * (c - 16);
            else sp = P + krow * PN + P_KRET + hd * 128 + 8 * c;
            kreg[i] = *(const u32x4*)sp; }
#pragma unroll
        for (int i = 0; i < 2; ++i) { const int pi = tid + i * 512, dv = pi >> 3, c = pi & 7; vreg[i] = *(const u32x4*)(VT + (size_t)(hd * 128 + dv) * MP + rb + 64 * j + 8 * c); }
    };
    auto lstore = [&](int buf) {
#pragma unroll
        for (int i = 0; i < NKPC; ++i) { const int pi = tid + i * 512, r = pi / (DQ / 8), c = pi % (DQ / 8); *(LAS u32x4*)(Kb + buf * KB_BYTES + r * KP + 16 * c) = kreg[i]; }
#pragma unroll
        for (int i = 0; i < 2; ++i) { const int pi = tid + i * 512, dv = pi >> 3, c = pi & 7; LAS unsigned char* dp = Vbuf + buf * VB_BYTES + dv * VP + 16 * c;
            *(LAS u32x2*)dp = (u32x2){vreg[i].x, vreg[i].y}; *(LAS u32x2*)(dp + 8) = (u32x2){vreg[i].z, vreg[i].w}; }
    };
    gload(j0);
    if (MODE == 1 && qblk > 0) {
        constexpr int RP = 272; LAS unsigned char* RT = C.lds + 2 * KB_BYTES + 2 * VB_BYTES;
        const float* KVT = WSP(float, WS_KVT) + (size_t)((b * 8 + hd) * 16) * 16384;
        const int dvr = tid >> 2, d0 = (tid & 3) * 32;
        f32x4 acc8[8];
#pragma unroll
        for (int i = 0; i < 8; ++i) acc8[i] = (f32x4){0.f, 0.f, 0.f, 0.f};
#pragma unroll 2
        for (int kp = 0; kp < qblk; ++kp) { const float f = __builtin_amdgcn_exp2f(lg2g * 256.0f * (float)(qblk - 1 - kp)); const float* sp = KVT + (size_t)kp * 16384 + dvr * 128 + d0;
#pragma unroll
            for (int i = 0; i < 8; ++i) acc8[i] = acc8[i] + *(const f32x4*)(sp + 4 * i) * f; }
#pragma unroll
        for (int i = 0; i < 4; ++i) { u32x4 wv; wv.x = cvt_pk_bf16(acc8[2 * i][0], acc8[2 * i][1]); wv.y = cvt_pk_bf16(acc8[2 * i][2], acc8[2 * i][3]); wv.z = cvt_pk_bf16(acc8[2 * i + 1][0], acc8[2 * i + 1][1]); wv.w = cvt_pk_bf16(acc8[2 * i + 1][2], acc8[2 * i + 1][3]);
            *(LAS u32x4*)(RT + dvr * RP + (d0 + 8 * i) * 2) = wv; }
        __syncthreads();
        if (wactive) {
#pragma unroll
            for (int d = 0; d < 4; ++d)
#pragma unroll
                for (int s = 0; s < NS; ++s) { const bf16x8 a = *(const LAS bf16x8*)(RT + (32 * d + ql) * RP + (16 * s + 8 * hh) * 2); O[d] = __builtin_amdgcn_mfma_f32_32x32x16_bf16(a, Qf[s], O[d], 0, 0, 0); }
            const float fq = __builtin_amdgcn_exp2f(lg2g * (float)(qposc - 256 * qblk + 1));
#pragma unroll
            for (int d = 0; d < 4; ++d)
#pragma unroll
                for (int r = 0; r < 16; ++r) O[d][r] *= fq;
        }
    }
    lstore(0);
    __syncthreads();
    for (int j = j0; j < nkt; ++j) {
        if (j + 1 < nkt) gload(j + 1);
        if (wactive && 64 * j <= wqmax) {
            const LAS unsigned char* kb = Kb + ((j - j0) & 1) * KB_BYTES; const LAS unsigned char* vb = Vbuf + ((j - j0) & 1) * VB_BYTES;
            f32x16 st[2];
#pragma unroll
            for (int kt = 0; kt < 2; ++kt) {
#pragma unroll
                for (int r = 0; r < 16; ++r) st[kt][r] = 0.f;
#pragma unroll
                for (int s = 0; s < NS; ++s) { const bf16x8 a = *(const LAS bf16x8*)(kb + (32 * kt + ql) * KP + (16 * s + 8 * hh) * 2); st[kt] = __builtin_amdgcn_mfma_f32_32x32x16_bf16(a, Qf[s], st[kt], 0, 0, 0); }
            }
            const int kbase = 64 * j + 4 * hh;
            if (MODE == 0) {
                if (64 * j + 63 > wqmin) {
#pragma unroll
                    for (int kt = 0; kt < 2; ++kt)
#pragma unroll
                        for (int r = 0; r < 16; ++r) { const int kpos = kbase + 32 * kt + (r & 3) + 8 * (r >> 2); if (kpos > qposc) st[kt][r] = -INFINITY; }
                }
                float tm0 = fmaxf(st[0][0], st[1][0]), tm1 = fmaxf(st[0][1], st[1][1]);
#pragma unroll
                for (int r = 2; r < 16; r += 2) { tm0 = fmaxf(tm0, fmaxf(st[0][r], st[1][r])); tm1 = fmaxf(tm1, fmaxf(st[0][r + 1], st[1][r + 1])); }
                const float tmax = hmax32(fmaxf(tm0, tm1));
                if (__builtin_amdgcn_ballot_w64(tmax > m_run) != 0ull) {
                    const float m_new = fmaxf(m_run, tmax);
                    const float alpha = __builtin_amdgcn_exp2f((m_run - m_new) * csm);
                    m_run = m_new; lsum *= alpha;
#pragma unroll
                    for (int d = 0; d < 4; ++d)
#pragma unroll
                        for (int r = 0; r < 16; ++r) O[d][r] *= alpha;
                }
                const float mb = m_run * csm;
                float ps = 0.f;
#pragma unroll
                for (int kt = 0; kt < 2; ++kt)
#pragma unroll
                    for (int r = 0; r < 16; ++r) { const float p = __builtin_amdgcn_exp2f(st[kt][r] * csm - mb); st[kt][r] = p; ps += p; }
                lsum += ps;
            } else {
#pragma unroll
                for (int kt = 0; kt < 2; ++kt)
#pragma unroll
                    for (int r = 0; r < 16; ++r) { const int kpos = kbase + 32 * kt + (r & 3) + 8 * (r >> 2); const int dd = qposc - kpos;
                        st[kt][r] = dd >= 0 ? st[kt][r] * __builtin_amdgcn_exp2f(lg2g * (float)dd) : 0.f; }
            }
#pragma unroll
            for (int kt = 0; kt < 2; ++kt)
#pragma unroll
                for (int s2 = 0; s2 < 2; ++s2) {
                    u32x4 pw; pw.x = cvt_pk_bf16(st[kt][8 * s2 + 0], st[kt][8 * s2 + 1]); pw.y = cvt_pk_bf16(st[kt][8 * s2 + 2], st[kt][8 * s2 + 3]);
                    pw.z = cvt_pk_bf16(st[kt][8 * s2 + 4], st[kt][8 * s2 + 5]); pw.w = cvt_pk_bf16(st[kt][8 * s2 + 6], st[kt][8 * s2 + 7]);
                    bf16x8 pf; __builtin_memcpy(&pf, &pw, 16);
#pragma unroll
                    for (int d = 0; d < 4; ++d) { const LAS unsigned char* ap = vb + (32 * d + ql) * VP + (32 * kt + 16 * s2 + 4 * hh) * 2;
                        const u32x2 lo = *(const LAS u32x2*)ap, hi = *(const LAS u32x2*)(ap + 16); u32x4 aw = (u32x4){lo.x, lo.y, hi.x, hi.y}; bf16x8 af; __builtin_memcpy(&af, &aw, 16);
                        O[d] = __builtin_amdgcn_mfma_f32_32x32x16_bf16(af, pf, O[d], 0, 0, 0); }
                }
        }
        if (j + 1 < nkt) lstore((j + 1 - j0) & 1);
        __syncthreads();
    }
    if (MODE == 0) {
        const float lt = hsum32(lsum); const float inv = 1.0f / lt;
        if (qvalid) { bf16_t* yp = Y + (rb + qpos) * 1024 + hd * 128;
#pragma unroll
            for (int d = 0; d < 4; ++d)
#pragma unroll
                for (int rg = 0; rg < 4; ++rg) { const int dv0 = 32 * d + 8 * rg + 4 * hh;
                    *(u32x2*)(yp + dv0) = (u32x2){cvt_pk_bf16(O[d][4 * rg] * inv, O[d][4 * rg + 1] * inv), cvt_pk_bf16(O[d][4 * rg + 2] * inv, O[d][4 * rg + 3] * inv)}; } }
    } else {
        u32x2 gws[4][4];
        { const bf16_t* gp = P + (rb + qposc) * PN + P_GRET + hd * 128 + 4 * hh;
#pragma unroll
          for (int d = 0; d < 4; ++d)
#pragma unroll
              for (int rg = 0; rg < 4; ++rg) gws[d][rg] = *(const u32x2*)(gp + 32 * d + 8 * rg); }
        float ss = 0.f;
#pragma unroll
        for (int d = 0; d < 4; ++d)
#pragma unroll
            for (int r = 0; r < 16; ++r) ss += O[d][r] * O[d][r];
        ss = hsum32(ss); const float rstd = rsqrtf(ss * (1.0f / 128.0f) + NORM_EPS);
        if (qvalid) { bf16_t* yp = Y + (rb + qpos) * 1024 + hd * 128;
#pragma unroll
            for (int d = 0; d < 4; ++d)
#pragma unroll
                for (int rg = 0; rg < 4; ++rg) { const int dv0 = 32 * d + 8 * rg + 4 * hh; const u32x2 gw = gws[d][rg];
                    const float g0 = bflo(gw.x), g1 = bfhi(gw.x), g2 = bflo(gw.y), g3 = bfhi(gw.y);
                    const float o0 = O[d][4 * rg] * rstd * g0 * sigmoidf_(g0), o1 = O[d][4 * rg + 1] * rstd * g1 * sigmoidf_(g1), o2 = O[d][4 * rg + 2] * rstd * g2 * sigmoidf_(g2), o3 = O[d][4 * rg + 3] * rstd * g3 * sigmoidf_(g3);
                    *(u32x2*)(yp + dv0) = (u32x2){cvt_pk_bf16(o0, o1), cvt_pk_bf16(o2, o3)}; } }
    }
}

__device__ __forceinline__ void ph_retkv(const Ctx& C) {
    constexpr int VP = 136, TB = 128 * VP;
    LAS unsigned char* Vb = C.lds; LAS unsigned char* Kt = C.lds + TB;
    const bf16_t* P = WSP(bf16_t, WS_P); const bf16_t* VT = WSP(bf16_t, WS_VTRET); float* KVT = WSP(float, WS_KVT);
    const int tid = C.tid, w = C.wave, lane = C.lane, ql = lane & 31, hh = lane >> 5;
    for (int u = C.wg; u < NB * 8 * 16; u += C.G) {
        const int b = u >> 7, hd = (u >> 4) & 7, kb = u & 15; const size_t rb = (size_t)b * LSEQ + 256 * kb;
        const float lg2g = log1pf(-exp2f(-5.0f - (float)hd)) * 1.4426950408889634f;
        f32x16 acc[2];
#pragma unroll
        for (int r = 0; r < 16; ++r) { acc[0][r] = 0.f; acc[1][r] = 0.f; }
        for (int j = 0; j < 4; ++j) {
            __syncthreads();
#pragma unroll
            for (int i = 0; i < 2; ++i) { const int pi = tid + i * 512;
                { const int dv = pi >> 3, c = pi & 7; const u32x4 v = *(const u32x4*)(VT + (size_t)(hd * 128 + dv) * MP + rb + 64 * j + 8 * c); LAS unsigned char* dp = Vb + dv * VP + 16 * c;
                  *(LAS u32x2*)dp = (u32x2){v.x, v.y}; *(LAS u32x2*)(dp + 8) = (u32x2){v.z, v.w}; }
                { const int key = pi >> 4, c = pi & 15; float x[8]; unpack8(*(const u32x4*)(P + (rb + 64 * j + key) * PN + P_KRET + hd * 128 + 8 * c), x);
                  const float f = __builtin_amdgcn_exp2f(lg2g * (float)(255 - 64 * j - key));
#pragma unroll
                  for (int e = 0; e < 8; ++e) *(LAS bf16_t*)(Kt + (8 * c + e) * VP + key * 2) = f2bf(x[e] * f); } }
            __syncthreads();
#pragma unroll
            for (int s = 0; s < 4; ++s) {
                const LAS unsigned char* ap = Vb + (32 * (w >> 1) + ql) * VP + (16 * s + 8 * hh) * 2; const u32x2 alo = *(const LAS u32x2*)ap, ahi = *(const LAS u32x2*)(ap + 8);
                u32x4 aw = (u32x4){alo.x, alo.y, ahi.x, ahi.y}; bf16x8 af; __builtin_memcpy(&af, &aw, 16);
#pragma unroll
                for (int t = 0; t < 2; ++t) { const LAS unsigned char* bp = Kt + (32 * (2 * (w & 1) + t) + ql) * VP + (16 * s + 8 * hh) * 2; const u32x2 blo = *(const LAS u32x2*)bp, bhi = *(const LAS u32x2*)(bp + 8);
                    u32x4 bw = (u32x4){blo.x, blo.y, bhi.x, bhi.y}; bf16x8 bf; __builtin_memcpy(&bf, &bw, 16);
                    acc[t] = __builtin_amdgcn_mfma_f32_32x32x16_bf16(af, bf, acc[t], 0, 0, 0); }
            }
        }
        float* op = KVT + (size_t)u * 16384;
#pragma unroll
        for (int t = 0; t < 2; ++t)
#pragma unroll
            for (int r = 0; r < 16; ++r) { const int dv = 32 * (w >> 1) + (r & 3) + 8 * (r >> 2) + 4 * hh; op[dv * 128 + 32 * (2 * (w & 1) + t) + ql] = acc[t][r]; }
    }
    __syncthreads();
}

__device__ __forceinline__ int q_pop(const Ctx& C, unsigned* head) {
    volatile LAS int* item = (volatile LAS int*)(C.lds + LDS_MISC + 64);
    __syncthreads();
    if (C.tid == 0) *item = (int)__hip_atomic_fetch_add(head, 1u, __ATOMIC_RELAXED, __HIP_MEMORY_SCOPE_AGENT);
    __syncthreads();
    return *item;
}
__device__ __forceinline__ void ph_mix(const Ctx& C, int l) {
    unsigned* head = C.ctl + CW_QUEUE + 256 * l;
    for (;;) { const int it = q_pop(C, head); if (it >= 64) break; rwkv_seq_unit(C, it >> 4, it & 15); }
    for (;;) { const int it = q_pop(C, head + 128); if (it >= 17 * 32) break; attn_unit<1>(C, (it & 31) >> 3, it & 7, 16 - (it >> 5)); }
    for (;;) { const int it = q_pop(C, head + 64); if (it >= 17 * 32) break; attn_unit<0>(C, (it & 31) >> 3, it & 7, 16 - (it >> 5)); }
}

constexpr int MMAIN = 16384;
template <int KIND>
__device__ __forceinline__ void tail_units(const Ctx& C, const bf16_t* A, const bf16_t* Bt, const int K, const int nunits, bf16_t* Hb, bf16_t* Ob, const bf16_t* P) {
    constexpr int NB = KIND == 1 ? 2 : 1, NBR = KIND == 2 ? 3 : 1;
    const int ql = C.lane & 31, hh = C.lane >> 5, w = C.wave; const int KS = K / 8;
    LAS float* red = (LAS float*)C.lds;
    for (int t = C.wg; t < nunits; t += C.G) {
        float tot[4] = {0.f, 0.f, 0.f, 0.f};
        for (int br = 0; br < NBR; ++br) {
        f32x16 acc[NB][2];
#pragma unroll
        for (int q = 0; q < NB; ++q)
#pragma unroll
            for (int r = 0; r < 16; ++r) { acc[q][0][r] = 0.f; acc[q][1][r] = 0.f; }
        const bf16_t* Au = (KIND == 2) ? A + (size_t)br * MP * 1024 : A;
        const bf16_t* a0 = Au + (size_t)(MMAIN + ql) * K + w * KS + 8 * hh;
        const bf16_t* bp[NB];
        if (KIND == 1) { const int j = 32 * t + ql; const int grow = 8 * (j >> 2) + (j & 3); bp[0] = Bt + (size_t)grow * K + w * KS + 8 * hh; bp[NB - 1] = Bt + (size_t)(grow + 4) * K + w * KS + 8 * hh; }
        else bp[0] = Bt + (size_t)(br * 2048 + 32 * t + ql) * K + w * KS + 8 * hh;
        for (int k = 0; k < KS; k += 64) { bf16x8 af0[4], af1[4], bfr[NB][4];
#pragma unroll
            for (int u = 0; u < 4; ++u) { af0[u] = *(const bf16x8*)(a0 + k + 16 * u); af1[u] = *(const bf16x8*)(a0 + (size_t)32 * K + k + 16 * u);
#pragma unroll
                for (int q = 0; q < NB; ++q) bfr[q][u] = *(const bf16x8*)(bp[q] + k + 16 * u); }
#pragma unroll
            for (int u = 0; u < 4; ++u)
#pragma unroll
                for (int q = 0; q < NB; ++q) { acc[q][0] = __builtin_amdgcn_mfma_f32_32x32x16_bf16(af0[u], bfr[q][u], acc[q][0], 0, 0, 0); acc[q][1] = __builtin_amdgcn_mfma_f32_32x32x16_bf16(af1[u], bfr[q][u], acc[q][1], 0, 0, 0); } }
        __syncthreads();
#pragma unroll
        for (int q = 0; q < NB; ++q)
#pragma unroll
            for (int hf = 0; hf < 2; ++hf)
#pragma unroll
                for (int r = 0; r < 16; ++r) red[((q * 8 + w) * 32 + hf * 16 + r) * 64 + C.lane] = acc[q][hf][r];
        __syncthreads();
#pragma unroll
        for (int i = 0; i < 4; ++i) { const int hr = 4 * w + i, hf = hr >> 4, r = hr & 15; float s0 = 0.f, s1 = 0.f;
#pragma unroll
            for (int ww = 0; ww < 8; ++ww) { s0 += red[(ww * 32 + hr) * 64 + C.lane]; if (NB == 2) s1 += red[((8 + ww) * 32 + hr) * 64 + C.lane]; }
            const int row = MMAIN + 32 * hf + (r & 3) + 8 * (r >> 2) + 4 * hh; const int c = 32 * t + ql;
            if (KIND == 0) { bf16_t* p = Hb + (size_t)row * DM + c; *p = f2bf(bf2f(*p) + s0); }
            else if (KIND == 1) Ob[(size_t)row * FFN + c] = f2bf(s0 * sigmoidf_(s0) * s1);
            else { tot[i] += s0 * sigmoidf_(bf2f(P[(size_t)row * PN + P_GATES + br * 2048 + c])); if (br == NBR - 1) Ob[(size_t)row * DM + c] = f2bf(tot[i]); } }
        }
    }
    __syncthreads();
}
#define T16_STEP(NS, k) do { bf16x8 a_[NS], b0_[NS], b1_[NS]; \
        _Pragma("unroll") for (int s_ = 0; s_ < NS; ++s_) { a_[s_] = *(const bf16x8*)(ap + (k) + 32 * s_); b0_[s_] = *(const bf16x8*)(bp + (k) + 32 * s_); b1_[s_] = *(const bf16x8*)(bp + (size_t)16 * K + (k) + 32 * s_); } \
        _Pragma("unroll") for (int s_ = 0; s_ < NS; ++s_) { acc0 = __builtin_amdgcn_mfma_f32_16x16x32_bf16(a_[s_], b0_[s_], acc0, 0, 0, 0); acc1 = __builtin_amdgcn_mfma_f32_16x16x32_bf16(a_[s_], b1_[s_], acc1, 0, 0, 0); } } while (0)
template <int KIND>
__device__ __forceinline__ void tail16(const Ctx& C, const bf16_t* A, const bf16_t* Bt, const int K, bf16_t* Hb, bf16_t* Ob, const bf16_t* P) {
    constexpr int NBR = KIND == 2 ? 3 : 1;
    const int r = C.lane & 15, kq = C.lane >> 4, w = C.wave; const int KS = K / 8;
    LAS float* red = (LAS float*)C.lds;
    for (int un = C.wg; un < 256; un += C.G) {
        const int rg = (un >> 3) & 3, t = (un & 7) + 8 * (un >> 5);
        float tot = 0.f;
        for (int br = 0; br < NBR; ++br) {
            f32x4 acc0 = {0.f, 0.f, 0.f, 0.f}, acc1 = {0.f, 0.f, 0.f, 0.f};
            const bf16_t* Au = (KIND == 2) ? A + (size_t)br * MP * 1024 : A;
            const bf16_t* ap = Au + (size_t)(MMAIN + 16 * rg + r) * K + w * KS + 8 * kq;
            const bf16_t* bp = Bt + (size_t)(br * 2048 + 32 * t + r) * K + w * KS + 8 * kq;
            int k = 0;
            for (; k + 128 <= KS; k += 128) T16_STEP(4, k);
            for (; k < KS; k += 64) T16_STEP(2, k);
            __syncthreads();
#pragma unroll
            for (int j = 0; j < 4; ++j) { red[(w * 8 + j) * 64 + C.lane] = acc0[j]; red[(w * 8 + 4 + j) * 64 + C.lane] = acc1[j]; }
            __syncthreads();
            float s = 0.f;
#pragma unroll
            for (int ww = 0; ww < 8; ++ww) s += red[(ww * 8 + w) * 64 + C.lane];
            const int row = MMAIN + 16 * rg + 4 * kq + (w & 3), c = 32 * t + 16 * (w >> 2) + r;
            if (KIND == 0) { bf16_t* p = Hb + (size_t)row * DM + c; *p = f2bf(bf2f(*p) + s); }
            else { tot += s * sigmoidf_(bf2f(P[(size_t)row * PN + P_GATES + br * 2048 + c])); if (br == NBR - 1) Ob[(size_t)row * DM + c] = f2bf(tot); }
        }
    }
    __syncthreads();
}
#undef T16_STEP
__device__ __forceinline__ void ph_sum3(const Ctx& C) {
    const bf16_t* GT = WSP(bf16_t, WS_RW); bf16_t* MG = WSP(bf16_t, WS_U);
    for (int row = C.wg * 8 + C.wave; row < M; row += C.G * 8) {
        const bf16_t* gp = GT + (size_t)row * 6144;
#pragma unroll
        for (int i = 0; i < 4; ++i) { const int c = (i * 64 + C.lane) * 8; float a[8], b[8], d[8];
            unpack8(*(const u32x4*)(gp + c), a); unpack8(*(const u32x4*)(gp + 2048 + c), b); unpack8(*(const u32x4*)(gp + 4096 + c), d);
#pragma unroll
            for (int e = 0; e < 8; ++e) a[e] = a[e] + b[e] + d[e];
            *(u32x4*)(MG + (size_t)row * DM + c) = pack8(a); }
    }
}

constexpr int NSTEP_LAYER = 13, STEP_FINAL = 1 + DEPTH * NSTEP_LAYER, NSTEPS = STEP_FINAL + 1;
__device__ __forceinline__ Ctx mkctx(const Args& args, LAS unsigned char* lds, int wave_s) {
    Ctx C; GAS unsigned char* wsg = (GAS unsigned char*)args.ws; asm volatile("" : "+s"(wsg)); unsigned char* ws = (unsigned char*)wsg; int wv = wave_s; asm volatile("" : "+s"(wv));
    int lane; asm volatile("v_mbcnt_lo_u32_b32 %0, -1, 0\n\tv_mbcnt_hi_u32_b32 %0, -1, %0" : "=v"(lane));
    C.out = (float*)(GAS float*)args.out; C.ws = ws; C.lds = lds; C.ctl = (unsigned*)(ws + WS_CTL);
    C.tid = wv * 64 + lane; C.lane = lane; C.wave = wv; C.G = gridDim.x; C.wg = blockIdx.x;
    return C;
}
__global__ void __launch_bounds__(512, 2) trunk_fwd(Args args) {
    extern __shared__ __attribute__((aligned(16))) unsigned char lds_raw[];
    LAS unsigned char* lds = (LAS unsigned char*)lds_raw;
    volatile LAS unsigned* misc = (volatile LAS unsigned*)(lds + LDS_MISC);
    if (threadIdx.x < 32) misc[threadIdx.x] = 0u;
    if (threadIdx.x == 0) { volatile LAS unsigned long long* tb = (volatile LAS unsigned long long*)(lds + LDS_INTBL);
#pragma unroll
        for (int i = 0; i < 27; ++i) tb[i] = (unsigned long long)args.in[i]; }
    __syncthreads();
    const int s_lo = args.s_lo, s_hi = args.s_hi;
    const int wave_s = __builtin_amdgcn_readfirstlane(threadIdx.x >> 6);
    unsigned* const barw = (unsigned*)(args.ws + WS_CTL) + CW_BAR + args.bar_idx * XCD_BAR_WORDS;
    XcdBarrier bar; bar.bar = barw; bar.x = 0; bar.st = misc;
    if (s_hi - s_lo > 1) bar = xcd_barrier_post(barw, misc);
#ifndef PMASK
#define PMASK 0xFFFFF
#endif
#define RUN(k, s) (((PMASK >> (k)) & 1) && (s) >= s_lo && (s) < s_hi)
#define SEAM(s) do { if ((s) >= s_lo && (s) + 1 < s_hi) { GAS unsigned* bw_ = (GAS unsigned*)barw; asm volatile("" : "+s"(bw_)); bar.bar = (unsigned*)bw_; int ln_; asm volatile("v_mbcnt_lo_u32_b32 %0, -1, 0\n\tv_mbcnt_hi_u32_b32 %0, -1, %0" : "=v"(ln_)); xcd_barrier(bar, wave_s == 0 && ln_ == 0); } } while (0)
    using namespace pg8;
    if (RUN(14, 0)) { const Ctx C = mkctx(args, lds, wave_s); ph_rope_tables(C); } SEAM(0);
    for (int l = 0; l < DEPTH; ++l) {
        const int sb = 1 + l * NSTEP_LAYER;
        if (RUN(0, sb + 0)) { const Ctx C = mkctx(args, lds, wave_s); ph_conv(C, l); if (l == 0) ph_norm<true>(C); else ph_norm<false>(C); } SEAM(sb + 0);
        if (RUN(1, sb + 1)) { const Ctx C = mkctx(args, lds, wave_s); Gemm g{WSP(bf16_t, WS_U), WSP(bf16_t, WS_WIN), MP, PN, DM, 0, 0}; StaticOrder S; S.init(MP, PN, C.G, C.wg);
            EpiBf16Plain E{WSP(bf16_t, WS_P), PN}; gemm_phase<EpiBf16Plain, StaticOrder, true, true>(lds, g, S, E, C.tid); }
        if (RUN(1, sb + 1)) { const Ctx C = mkctx(args, lds, wave_s); Gemm g{WSP(bf16_t, WS_WVRET), WSP(bf16_t, WS_U), 1024, MP, DM, 0, 0}; StaticOrder S; S.init(1024, MP, C.G, (C.wg + 121) % C.G);
            EpiBf16Plain E{WSP(bf16_t, WS_VTRET), MP}; gemm_phase<EpiBf16Plain, StaticOrder, true, true>(lds, g, S, E, C.tid); }
        if (RUN(1, sb + 1)) { Ctx C = mkctx(args, lds, wave_s);
            int idx = C.wg, cnt = C.G;
            if (C.G == 256) { const bool idle = C.wg >= 117 && !(C.wg >= 135 && C.wg <= 138); idx = idle ? C.wg - 117 - (C.wg > 138 ? 4 : 0) : -1; cnt = 135; }
            if (idx >= 0) { C.wg = idx; C.G = cnt; __syncthreads(); ph_convB(C, l); } }
        SEAM(sb + 1);
        if (RUN(2, sb + 2)) { const Ctx C = mkctx(args, lds, wave_s); ph_prepA(C, l); } SEAM(sb + 2);
        if (RUN(3, sb + 3)) { const Ctx C = mkctx(args, lds, wave_s);
            unsigned char* rw = C.ws + WS_RW;
            { Gemm g{WSP(bf16_t, WS_XL), WSP(bf16_t, WS_WLORA), MP, LORA_N, LORA_K, 0, 0}; StaticOrder S; S.init(MP, LORA_N, C.G, C.wg);
              EpiLora E{(float*)(rw + RW_WDEC), (bf16_t*)(rw + RW_A), (bf16_t*)(rw + RW_A + RW_ARR), inp(C, IN_W0) + l * 1024, inp(C, IN_A0) + l * 1024}; gemm_phase<EpiLora, StaticOrder, true, true>(lds, g, S, E, C.tid); }
        }
        if (RUN(3, sb + 3)) { const Ctx C = mkctx(args, lds, wave_s); Gemm g{WSP(bf16_t, WS_QN), WSP(bf16_t, WS_WUQ), MP, 1536, 512, 0, 0}; StaticOrder S; S.init(MP, 1536, C.G, (C.wg + 140) % C.G);
            EpiBf16Plain E{WSP(bf16_t, WS_Q), 1536}; gemm_phase<EpiBf16Plain, StaticOrder, true, true>(lds, g, S, E, C.tid); }
        if (RUN(3, sb + 3)) { const Ctx C = mkctx(args, lds, wave_s); Gemm g{WSP(bf16_t, WS_KVN), WSP(bf16_t, WS_WUK), MP, 1024, 256, 0, 0}; StaticOrder S; S.init(MP, 1024, C.G, (C.wg + 236) % C.G);
            EpiBf16Plain E{WSP(bf16_t, WS_KNOPE), 1024}; gemm_phase<EpiBf16Plain, StaticOrder, true, true>(lds, g, S, E, C.tid); }
        if (RUN(3, sb + 3)) { const Ctx C = mkctx(args, lds, wave_s); Gemm g{WSP(bf16_t, WS_WUV), WSP(bf16_t, WS_KVN), 1024, MP, 256, 0, 0}; StaticOrder S; S.init(1024, MP, C.G, (C.wg + 232) % C.G);
            EpiBf16Plain E{WSP(bf16_t, WS_VTMLA), MP}; gemm_phase<EpiBf16Plain, StaticOrder, true, true>(lds, g, S, E, C.tid); }
        SEAM(sb + 3);
        if (RUN(5, sb + 5)) { const Ctx C = mkctx(args, lds, wave_s); ph_qrope(C); }
        if (RUN(5, sb + 5)) { const Ctx C = mkctx(args, lds, wave_s); ph_retkv(C); }
        if (RUN(5, sb + 5)) { const Ctx C = mkctx(args, lds, wave_s); ph_rwkvpre(C, l); } SEAM(sb + 5);
        if (RUN(6, sb + 6)) { const Ctx C = mkctx(args, lds, wave_s); ph_mix(C, l); } SEAM(sb + 6);
        if (RUN(7, sb + 7)) { const Ctx C = mkctx(args, lds, wave_s); ph_post(C, l); } SEAM(sb + 7);
        if (RUN(8, sb + 8)) { const Ctx C = mkctx(args, lds, wave_s); Gemm g{WSP(bf16_t, WS_YBR), WSP(bf16_t, WS_WBR), MMAIN, 6144, 1024, 8, (size_t)MP * 1024 * 2}; BranchOrder S; S.base.init(MMAIN, DM, C.G, C.wg);
            EpiGate E{WSP(bf16_t, WS_U), WSP(bf16_t, WS_P)}; gemm_phase<EpiGate, BranchOrder, true, true>(lds, g, S, E, C.tid); }
        if (RUN(8, sb + 8)) { const Ctx C = mkctx(args, lds, wave_s); tail16<2>(C, WSP(bf16_t, WS_YBR), WSP(bf16_t, WS_WBR), 1024, nullptr, WSP(bf16_t, WS_U), WSP(bf16_t, WS_P)); }
        SEAM(sb + 8);
        if (RUN(9, sb + 9)) { const Ctx C = mkctx(args, lds, wave_s); Gemm g{WSP(bf16_t, WS_U), WSP(bf16_t, WS_WOUT), MMAIN, DM, DM, 0, 0}; StaticOrder S; S.init(MMAIN, DM, C.G, C.wg);
            EpiResid E{WSP(bf16_t, WS_H)}; gemm_phase<EpiResid, StaticOrder, true, true>(lds, g, S, E, C.tid); }
        if (RUN(9, sb + 9)) { const Ctx C = mkctx(args, lds, wave_s); tail16<0>(C, WSP(bf16_t, WS_U), WSP(bf16_t, WS_WOUT), DM, WSP(bf16_t, WS_H), nullptr, nullptr); }
        SEAM(sb + 9);
        if (RUN(10, sb + 10)) { const Ctx C = mkctx(args, lds, wave_s); ph_norm<false>(C); } SEAM(sb + 10);
        if (RUN(11, sb + 11)) { const Ctx C = mkctx(args, lds, wave_s); Gemm g{WSP(bf16_t, WS_U), WSP(bf16_t, WS_WGU), MMAIN, 2 * FFN, DM, 0, 0}; StaticOrder S; S.init(MMAIN, 2 * FFN, C.G, C.wg);
            EpiSwiglu E{WSP(bf16_t, WS_P)}; gemm_phase<EpiSwiglu, StaticOrder, true, true>(lds, g, S, E, C.tid); }
        if (RUN(11, sb + 11)) { const Ctx C = mkctx(args, lds, wave_s); tail_units<1>(C, WSP(bf16_t, WS_U), WSP(bf16_t, WS_WGU), DM, FFN / 32, nullptr, WSP(bf16_t, WS_P), nullptr); }
        SEAM(sb + 11);
        if (RUN(12, sb + 12)) { const Ctx C = mkctx(args, lds, wave_s); Gemm g{WSP(bf16_t, WS_P), WSP(bf16_t, WS_WD), MMAIN, DM, FFN, 0, 0}; StaticOrder S; S.init(MMAIN, DM, C.G, C.wg);
            EpiResid E{WSP(bf16_t, WS_H)}; gemm_phase<EpiResid, StaticOrder, true, true>(lds, g, S, E, C.tid); }
        if (RUN(12, sb + 12)) { const Ctx C = mkctx(args, lds, wave_s); tail16<0>(C, WSP(bf16_t, WS_P), WSP(bf16_t, WS_WD), FFN, WSP(bf16_t, WS_H), nullptr, nullptr); }
        SEAM(sb + 12);
    }
    if (RUN(15, STEP_FINAL)) { const Ctx C = mkctx(args, lds, wave_s); ph_final(C); }
#undef RUN
#undef SEAM
}

extern "C" void kernel_launch(void* const* d_in, const int* in_sizes, int n_in, void* d_out, int out_size, void* d_ws, size_t ws_size, hipStream_t stream) {
    static int grid = 0;
    if (grid == 0) {
        if (n_in != 27 || ws_size < WS_END) { fprintf(stderr, "kernel_launch: unexpected n_in %d or ws_size %zu (< %zu)\n", n_in, ws_size, (size_t)WS_END); grid = -1; return; }
        int dev = 0, cus = 0, per_cu = 0;
        if (hipGetDevice(&dev) != hipSuccess || hipDeviceGetAttribute(&cus, hipDeviceAttributeMultiprocessorCount, dev) != hipSuccess) { grid = -1; return; }
        if (hipFuncSetAttribute((const void*)trunk_fwd, hipFuncAttributeMaxDynamicSharedMemorySize, LDS_BYTES) != hipSuccess) { fprintf(stderr, "kernel_launch: hipFuncSetAttribute failed\n"); grid = -1; return; }
        if (hipOccupancyMaxActiveBlocksPerMultiprocessor(&per_cu, (const void*)trunk_fwd, 512, LDS_BYTES) != hipSuccess || per_cu < 1) { fprintf(stderr, "kernel_launch: occupancy query says %d\n", per_cu); }
        (void)hipGetLastError();
        grid = cus;
    }
    if (grid < 0) return;
    (void)hipMemsetAsync((char*)d_ws + WS_CTL, 0, CTL_ZERO_BYTES, stream);
    Args a{};
    for (int i = 0; i < 27; ++i) a.in[i] = (const float*)d_in[i];
    a.out = (float*)d_out; a.ws = (unsigned char*)d_ws; a.pad = 0;
#if N_LAUNCH_MODE == 1
    a.s_lo = 0; a.s_hi = NSTEPS; a.bar_idx = 0;
    hipLaunchKernelGGL(trunk_fwd, dim3(grid), dim3(512), LDS_BYTES, stream, a);
#else
    for (int s = 0; s < NSTEPS; ++s) { a.s_lo = s; a.s_hi = s + 1; a.bar_idx = 0; hipLaunchKernelGGL(trunk_fwd, dim3(grid), dim3(512), LDS_BYTES, stream, a); }
#endif
}
```

```cpp
#include <hip/hip_runtime.h>
#include <cstdio>
#include <cstdint>

#define LAS __attribute__((address_space(3)))
#define GAS __attribute__((address_space(1)))
typedef unsigned short bf16_t;
typedef short bf16x8 __attribute__((ext_vector_type(8)));
typedef float f32x4 __attribute__((ext_vector_type(4)));
typedef float f32x2 __attribute__((ext_vector_type(2)));
typedef float f32x16 __attribute__((ext_vector_type(16)));
typedef unsigned u32x4 __attribute__((ext_vector_type(4)));
typedef unsigned u32x2 __attribute__((ext_vector_type(2)));

constexpr int DM = 2048, NB = 4, SEQ = 4096, NMETA = 16, LSEQ = 4112, M = NB * LSEQ  , MP = 16640  , DEPTH = 4;
constexpr int RWW = 1024, RW_COLS = 3520, IN_COLS = 14592, PN = 13568  ;
constexpr int P_QRET = 3520, P_KRET = 4544, P_GRET = 5568, P_QD = 6592, P_KVD = 7104, P_KRD = 7360, P_GATES = 7424;
constexpr int FFN = 5632, LORA_K = 512, LORA_N = 3072;
constexpr float NORM_EPS = 1e-6f, GN_EPS = 64.0f * 1e-5f;

constexpr size_t MiB = 1u << 20;
constexpr size_t al(size_t x) { return (x + MiB - 1) / MiB * MiB; }
constexpr size_t WS_CTL = 0, CTL_BYTES = 2 * MiB;
constexpr size_t WS_WIN = WS_CTL + CTL_BYTES;
constexpr size_t WS_WVRET = WS_WIN + al((size_t)PN * DM * 2);
constexpr size_t WS_WLORA = WS_WVRET + al((size_t)1024 * DM * 2);
constexpr size_t WS_WUQ = WS_WLORA + al((size_t)LORA_N * LORA_K * 2);
constexpr size_t WS_WUK = WS_WUQ + al((size_t)1536 * 512 * 2);
constexpr size_t WS_WUV = WS_WUK + al((size_t)1024 * 256 * 2);
constexpr size_t WS_WBR = WS_WUV + al((size_t)1024 * 256 * 2);
constexpr size_t WS_WOUT = WS_WBR + al((size_t)6144 * 1024 * 2);
constexpr size_t WS_WGU = WS_WOUT + al((size_t)2048 * 6144 * 2);
constexpr size_t WS_WD = WS_WGU + al((size_t)11264 * 2048 * 2);
constexpr size_t WS_ROPE = WS_WD + al((size_t)2048 * FFN * 2);
constexpr size_t WS_H = WS_ROPE + al((size_t)LSEQ * 192 * 4);
constexpr size_t WS_U = WS_H + al((size_t)MP * DM * 4);
constexpr size_t WS_P = WS_U + al((size_t)MP * DM * 2);
constexpr size_t WS_VTRET = WS_P + al((size_t)MP * PN * 2);
constexpr size_t WS_XL = WS_VTRET + al((size_t)1024 * MP * 2);
constexpr size_t WS_RW = WS_XL + al((size_t)MP * 512 * 2);
constexpr size_t RW_WDEC = 0;
constexpr size_t RW_A = RW_WDEC + (size_t)MP * 1024 * 4;
constexpr size_t RW_ARR = (size_t)MP * 1024 * 2;
constexpr size_t RW_YRAW = RW_A + 7 * RW_ARR;
constexpr size_t RW_BYTES = RW_YRAW + (size_t)MP * 1024 * 4;
static_assert(RW_BYTES >= (size_t)MP * 6144 * 2, "GT overlay");
constexpr size_t WS_YBR = WS_RW + al(RW_BYTES);
constexpr size_t WS_QN = WS_YBR + al(3 * RW_ARR);
constexpr size_t WS_KVN = WS_QN + al((size_t)MP * 512 * 2);
constexpr size_t WS_KR = WS_KVN + al((size_t)MP * 256 * 2);
constexpr size_t WS_Q = WS_KR + al((size_t)MP * 64 * 2);
constexpr size_t WS_KNOPE = WS_Q + al((size_t)MP * 1536 * 2);
constexpr size_t WS_VTMLA = WS_KNOPE + al((size_t)MP * 1024 * 2);
constexpr size_t WS_KVT = WS_VTMLA + al((size_t)1024 * MP * 2);
constexpr int NCHUNK = LSEQ / 16;
constexpr int RC_B1 = 0, RC_B2 = 5632, RC_VT = 10752, RC_G = 13824, RC_STRIDE = 14336;
constexpr size_t WS_RCH = WS_KVT + al((size_t)NB * 8 * 16 * 128 * 128 * 4);
constexpr size_t WS_END = WS_RCH + al((size_t)NB * 16 * NCHUNK * RC_STRIDE);
static_assert((size_t)MP * FFN * 2 <= (size_t)MP * PN * 2, "ACT overlay");

constexpr int CW_QUEUE = 1024;
constexpr int CW_BAR = 4096;
constexpr int XCD_BAR_WORDS_C = 3456;
constexpr int MAX_BAR_REGIONS = 64;
#ifndef N_LAUNCH_MODE
#define N_LAUNCH_MODE 1
#endif
constexpr size_t CTL_ZERO_BYTES = (N_LAUNCH_MODE == 1) ? (size_t)(CW_BAR + XCD_BAR_WORDS_C) * 4 : CTL_BYTES;

constexpr int LDS_BYTES = 147456;
constexpr int LDS_MISC = 131072;

__device__ __forceinline__ float bf2f(unsigned short v) { return __uint_as_float(((unsigned)v) << 16); }
__device__ __forceinline__ float bflo(unsigned v) { return __uint_as_float(v << 16); }
__device__ __forceinline__ float bfhi(unsigned v) { return __uint_as_float(v & 0xffff0000u); }
__device__ __forceinline__ unsigned cvt_pk_bf16(float lo, float hi) { unsigned r; asm volatile("v_cvt_pk_bf16_f32 %0, %1, %2" : "=v"(r) : "v"(lo), "v"(hi)); return r; }
__device__ __forceinline__ unsigned short f2bf(float x) { return (unsigned short)(cvt_pk_bf16(x, 0.f) & 0xffffu); }
template <int X> __device__ __forceinline__ float sw_xor(float x) { return __int_as_float(__builtin_amdgcn_ds_swizzle(__float_as_int(x), 0x1f | (X << 10))); }
__device__ __forceinline__ float hsum32(float x) { const int v = __float_as_int(x); auto r = __builtin_amdgcn_permlane32_swap(v, v, false, false); return __int_as_float(r[0]) + __int_as_float(r[1]); }
__device__ __forceinline__ float hmax32(float x) { const int v = __float_as_int(x); auto r = __builtin_amdgcn_permlane32_swap(v, v, false, false); return fmaxf(__int_as_float(r[0]), __int_as_float(r[1])); }
__device__ __forceinline__ float wsum32(float x) { x += sw_xor<16>(x); x += sw_xor<8>(x); x += sw_xor<4>(x); x += sw_xor<2>(x); x += sw_xor<1>(x); return x; }
__device__ __forceinline__ float wsum64(float x) { x = wsum32(x); return hsum32(x); }
__device__ __forceinline__ float dpp_xor1(float x) { return __int_as_float(__builtin_amdgcn_update_dpp(0, __float_as_int(x), 0xB1, 0xF, 0xF, true)); }
__device__ __forceinline__ float dpp_xor2(float x) { return __int_as_float(__builtin_amdgcn_update_dpp(0, __float_as_int(x), 0x4E, 0xF, 0xF, true)); }
__device__ __forceinline__ float dpp_mirror(float x) { return __int_as_float(__builtin_amdgcn_update_dpp(0, __float_as_int(x), 0x140, 0xF, 0xF, true)); }
__device__ __forceinline__ float dpp_hmirror(float x) { return __int_as_float(__builtin_amdgcn_update_dpp(0, __float_as_int(x), 0x141, 0xF, 0xF, true)); }
__device__ __forceinline__ float wsum64_dpp(float x) {
    x += dpp_xor1(x); x += dpp_xor2(x); x += dpp_hmirror(x); x += dpp_mirror(x);
    x += __int_as_float(__builtin_amdgcn_update_dpp(0, __float_as_int(x), 0x142, 0xA, 0xF, false));
    x += __int_as_float(__builtin_amdgcn_update_dpp(0, __float_as_int(x), 0x143, 0xC, 0xF, false));
    return __int_as_float(__builtin_amdgcn_readlane(__float_as_int(x), 63));
}
__device__ __forceinline__ float sigmoidf_(float x) { return 1.0f / (1.0f + __expf(-x)); }
__device__ __forceinline__ u32x4 zero4u() { unsigned z; asm volatile("v_mov_b32 %0, 0" : "=v"(z)); return (u32x4){z, z, z, z}; }

#define XB_TMO      128
#define XB_XCNT(j)  (256  + 64 * (j))
#define XB_XSUB(j)  (1280 + 64 * (j))
#define XB_XGEN(j)  (2304 + 64 * (j))
#define XB_TOP      3328
#define XB_TOPGEN   3392
#define XCD_BAR_WORDS 3456
#define XB_SPIN_CAP (1u << 18)

__device__ __forceinline__ unsigned xb_ld(unsigned* p)              { return __hip_atomic_load(p, __ATOMIC_RELAXED, __HIP_MEMORY_SCOPE_AGENT); }
__device__ __forceinline__ unsigned xb_add(unsigned* p, unsigned v) { return __hip_atomic_fetch_add(p, v, __ATOMIC_RELAXED, __HIP_MEMORY_SCOPE_AGENT); }
__device__ __forceinline__ unsigned xb_xcc_id() { return (unsigned)__builtin_amdgcn_s_getreg((3 << 11) | 20) & 0xFu; }
#define XB_SPIN(cond, bar) do { unsigned _sp = 0; while (cond) { __builtin_amdgcn_s_sleep(1); \
    if ((++_sp & 255u) == 0u) { if (xb_ld(&(bar)[XB_TMO])) break; if (_sp > XB_SPIN_CAP) { atomicAdd(&(bar)[XB_TMO], 1u); break; } } } } while (0)

struct XcdBarrier { unsigned* bar; unsigned x; volatile LAS unsigned* st; };

__device__ __forceinline__ XcdBarrier xcd_barrier_post(unsigned* bar, volatile LAS unsigned* st) {
    XcdBarrier b; b.bar = bar; b.x = xb_xcc_id(); b.st = st;
    if (threadIdx.x == 0) (void)xb_add(&bar[XB_XCNT(b.x)], 1u);
    return b;
}
__device__ __forceinline__ void xcd_barrier_complete(unsigned* bar, unsigned x, unsigned& nloc, unsigned& nx) {
    const unsigned G = gridDim.x * gridDim.y * gridDim.z;
    unsigned sum, cnt, mine, sp = 0u;
    for (;;) {
        sum = 0u; cnt = 0u; mine = 0u;
#pragma unroll
        for (unsigned j = 0; j < 16; ++j) { const unsigned c = xb_ld(&bar[XB_XCNT(j)]); sum += c; cnt += (c > 0u) ? 1u : 0u; mine = (j == x) ? c : mine; }
        if (sum == G) break;
        __builtin_amdgcn_s_sleep(1);
        if ((++sp & 255u) == 0u) { if (xb_ld(&bar[XB_TMO])) break; if (sp > XB_SPIN_CAP) { atomicAdd(&bar[XB_TMO], 1u); break; } }
    }
    nloc = mine > 0u ? mine : 1u; nx = cnt > 0u ? cnt : 1u;
}
__device__ __forceinline__ void xcd_barrier(const XcdBarrier& b, const bool leader) {
    asm volatile("s_waitcnt vmcnt(0)" ::: "memory");
    __syncthreads();
    if (leader) {
        unsigned* bar = b.bar;
        __builtin_amdgcn_s_waitcnt(0);
        unsigned nloc = b.st[0], nx = b.st[1];
        if (nloc == 0u) { xcd_barrier_complete(bar, b.x, nloc, nx); b.st[0] = nloc; b.st[1] = nx; }
        const unsigned old = xb_add(&bar[XB_XSUB(b.x)], 1u);
        const unsigned gen = old / nloc;
        if (old + 1u == (gen + 1u) * nloc) {
            __builtin_amdgcn_fence(__ATOMIC_RELEASE, "agent");
            asm volatile("s_waitcnt vmcnt(0)" ::: "memory");
            const unsigned og = xb_add(&bar[XB_TOP], 1u);
            const unsigned tg = og / nx;
            if (og + 1u == (tg + 1u) * nx) xb_add(&bar[XB_TOPGEN], 1u);
            else XB_SPIN(xb_ld(&bar[XB_TOPGEN]) == tg, bar);
            __builtin_amdgcn_fence(__ATOMIC_ACQUIRE, "agent");
            xb_add(&bar[XB_XGEN(b.x)], 1u);
            asm volatile("s_waitcnt vmcnt(0)" ::: "memory");
        } else {
            XB_SPIN(xb_ld(&bar[XB_XGEN(b.x)]) == gen, bar);
            __builtin_amdgcn_fence(__ATOMIC_ACQUIRE, "agent");
            asm volatile("s_waitcnt vmcnt(0)" ::: "memory");
        }
    }
    __syncthreads();
}

__device__ __forceinline__ void unpack8(const u32x4 w, float (&x)[8]);
__device__ __forceinline__ u32x4 pack8(const float (&x)[8]);
__device__ __forceinline__ void ld8f(const float* p, float (&x)[8]);
namespace pg8 {
constexpr int BM = 256, BK = 64, HALF = 128, HTB = HALF * BK * 2, STAGE_BYTES = 8 * HTB, NXCD = 8, WGM = 8;
__host__ __device__ __forceinline__ int lds_byte(int r, int c) { const int st = (r >> 4) * 2 + (c >> 5), rr = r & 15, cc = c & 31, ob = rr * 64 + cc * 2; return st * 1024 + (ob ^ (((ob >> 9) & 1) << 5)); }
__host__ __device__ __forceinline__ void stage_rc(int b, int& R, int& C) { const int st = b / 1024, sb = b % 1024, swz = sb ^ (((sb >> 9) & 1) << 5); R = (st >> 1) * 16 + swz / 64; C = (st & 1) * 32 + (swz % 64) / 2; }
__host__ __device__ __forceinline__ int perm32(int rho) { const int n = rho >> 4, i = rho & 15; return 8 * (i >> 2) + 4 * n + (i & 3); }

struct Unit { int pm, pn; };
struct Gemm { const bf16_t* A; const bf16_t* Bt; int M, N, K; int asel_tiles; size_t asel_stride; };

struct StaticOrder {
    int nM, nN, nwg, G, c;
    __host__ __device__ void init(int M_, int N_, int G_, int c_) { nM = M_ / BM; nN = N_ / BM; nwg = nM * nN; G = G_; c = c_; }
    __host__ __device__ bool next(int i, Unit& u) const {
        const long L = (long)i * G + c; if (L >= nwg) return false;
        int wgid = (int)L; { const int q = nwg / NXCD, r = nwg % NXCD, xcd = wgid % NXCD, off = wgid / NXCD; wgid = (xcd < r ? xcd * (q + 1) : r * (q + 1) + (xcd - r) * q) + off; }
        const int nig = WGM * nN, gid = wgid / nig, fm = gid * WGM, gsz = (nM - fm) < WGM ? (nM - fm) : WGM;
        u.pm = fm + ((wgid % nig) % gsz); u.pn = (wgid % nig) / gsz; return true;
    }
    __device__ __forceinline__ void a_ready(const Unit&) const {}
    __device__ __forceinline__ void done(const Unit&) const {}
};

template <class Epi, class Sched, bool ALIGN_EPI = false, bool SP2 = false>
__device__ __forceinline__ void gemm_phase(LAS unsigned char* lds, const Gemm g, const Sched& S, const Epi& E, const int tid) {
    const int wid = __builtin_amdgcn_readfirstlane(tid >> 6), lane = tid & 63, wr = wid >> 2, wc = wid & 3, fr = lane & 15, fq = lane >> 4;
    const int K = g.K, nt = K / BK;
    unsigned voffA[2], voffB[2];
#pragma unroll
    for (int i = 0; i < 2; ++i) { int R, C; stage_rc(tid * 16 + i * 8192, R, C); const int Rb = Epi::PERM ? ((R & ~31) + perm32(R & 31)) : R;
        voffA[i] = (unsigned)(R * K + C) * 2u; voffB[i] = (unsigned)(Rb * K + C) * 2u; }
    const size_t kstep = (size_t)(BK * 2);
    const size_t hstep = (size_t)HALF * K * 2;
    const size_t tstep = 2 * hstep;
    const unsigned ldsw = (unsigned)wid * 1024u;
    const int aoff = lds_byte(wr * 64 + fr, fq * 8), boff = lds_byte(wc * 32 + fr, fq * 8);
#define PG8_SA(b, h) (((b) * 2 + (h)) * HTB)
#define PG8_SB(b, h) ((4 + (b) * 2 + (h)) * HTB)
#define PG8_STAGE(bufoff, gbase, voff) do { _Pragma("unroll") for (int _i = 0; _i < 2; ++_i) \
        __builtin_amdgcn_global_load_lds((const unsigned*)((const char*)(gbase) + (voff)[_i]), (LAS unsigned*)(lds + (bufoff) + ldsw + _i * 8192), 16, 0, 0); } while (0)
#define PG8_LDA(dst, b, h) do { _Pragma("unroll") for (int m = 0; m < 4; ++m) _Pragma("unroll") for (int k = 0; k < 2; ++k) dst[m][k] = *(const LAS bf16x8*)(lds + PG8_SA(b, h) + aoff + m * 2048 + k * 1024); } while (0)
#define PG8_LDB(dst, b, h) do { _Pragma("unroll") for (int n = 0; n < 2; ++n) _Pragma("unroll") for (int k = 0; k < 2; ++k) dst[n][k] = *(const LAS bf16x8*)(lds + PG8_SB(b, h) + boff + n * 2048 + k * 1024); } while (0)
#define PG8_MMA(ai, bj, At, Bt) do { __builtin_amdgcn_s_setprio(1); _Pragma("unroll") for (int m = 0; m < 4; ++m) _Pragma("unroll") for (int n = 0; n < 2; ++n) _Pragma("unroll") for (int k = 0; k < 2; ++k) \
        acc[ai][bj][m][n] = __builtin_amdgcn_mfma_f32_16x16x32_bf16(Bt[n][k], At[m][k], acc[ai][bj][m][n], 0, 0, 0); __builtin_amdgcn_s_setprio(0); } while (0)
#define PG8_WAIT_V(n) asm volatile("s_waitcnt vmcnt(" #n ")" ::: "memory")
#define PG8_WAIT_L(n) asm volatile("s_waitcnt lgkmcnt(" #n ")" ::: "memory")
#define PG8_BAR __builtin_amdgcn_s_barrier()
#define PG8_SCHED __builtin_amdgcn_sched_barrier(0)
#define PG8_ABASE(u) ((const char*)g.A + (g.asel_tiles ? (size_t)((u).pn / g.asel_tiles) * g.asel_stride : (size_t)0) + (size_t)(u).pm * tstep)
    Unit cur, nxt; int ui = 0;
    if (!S.next(0, cur)) return;
    f32x4 acc[2][2][4][2];
    { float zf; asm volatile("v_mov_b32 %0, 0" : "=v"(zf)); const f32x4 Z = {zf, zf, zf, zf};
#pragma unroll
    for (int a = 0; a < 2; ++a)
#pragma unroll
        for (int b = 0; b < 2; ++b)
#pragma unroll
            for (int m = 0; m < 4; ++m)
#pragma unroll
                for (int n = 0; n < 2; ++n) acc[a][b][m][n] = Z; }
    bf16x8 At[4][2], B0[2][2], B1[2][2];
    const char* cA = PG8_ABASE(cur); const char* cB = (const char*)g.Bt + (size_t)cur.pn * tstep;
    S.a_ready(cur);
    if constexpr (SP2) {
        PG8_STAGE(PG8_SB(0, 0), cB, voffB); PG8_STAGE(PG8_SB(0, 1), cB + hstep, voffB); PG8_STAGE(PG8_SA(0, 0), cA, voffA); PG8_STAGE(PG8_SA(0, 1), cA + hstep, voffA);
        if (wr == 1) PG8_BAR;
        PG8_WAIT_V(2); PG8_BAR;
        PG8_STAGE(PG8_SB(1, 0), cB + kstep, voffB); PG8_STAGE(PG8_SA(1, 0), cA + kstep, voffA); PG8_STAGE(PG8_SB(1, 1), cB + hstep + kstep, voffB);
        PG8_WAIT_V(6); PG8_BAR;
    } else {
        PG8_STAGE(PG8_SB(0, 0), cB, voffB); PG8_STAGE(PG8_SA(0, 0), cA, voffA); PG8_STAGE(PG8_SB(0, 1), cB + hstep, voffB); PG8_STAGE(PG8_SA(0, 1), cA + hstep, voffA);
        if (wr == 1) PG8_BAR;
        PG8_WAIT_V(4); PG8_BAR;
        PG8_STAGE(PG8_SB(1, 0), cB + kstep, voffB); PG8_STAGE(PG8_SA(1, 0), cA + kstep, voffA); PG8_STAGE(PG8_SB(1, 1), cB + hstep + kstep, voffB);
        PG8_WAIT_V(6); PG8_BAR;
    }
    for (;;) {
        const bool has_next = S.next(ui + 1, nxt);
        const char* nA = has_next ? PG8_ABASE(nxt) : cA; const char* nB = has_next ? (const char*)g.Bt + (size_t)nxt.pn * tstep : cB;
        for (int t = 0; t < nt; t += 2) {
            const bool last = (t == nt - 2);
            const char* a1 = cA + (size_t)(t + 1) * kstep;
            const char* a2 = last ? nA : cA + (size_t)(t + 2) * kstep; const char* b2 = last ? nB : cB + (size_t)(t + 2) * kstep;
            const char* a3 = a2 + kstep; const char* b3 = b2 + kstep;
            if (last && has_next) S.a_ready(nxt);
            if constexpr (SP2) {
            PG8_LDB(B0, 0, 0); PG8_LDB(B1, 0, 1); PG8_SCHED; PG8_LDA(At, 0, 0); PG8_STAGE(PG8_SA(1, 1), a1 + hstep, voffA);
            PG8_WAIT_V(8); PG8_WAIT_L(0); PG8_BAR; PG8_MMA(0, 0, At, B0); PG8_MMA(0, 1, At, B1); PG8_BAR; PG8_SCHED;
            PG8_LDA(At, 0, 1); PG8_STAGE(PG8_SB(0, 0), b2, voffB); PG8_STAGE(PG8_SB(0, 1), b2 + hstep, voffB); PG8_STAGE(PG8_SA(0, 0), a2, voffA);
            PG8_WAIT_V(8); PG8_WAIT_L(0); PG8_BAR; PG8_MMA(1, 0, At, B0); PG8_MMA(1, 1, At, B1); PG8_BAR; PG8_SCHED;
            PG8_LDB(B0, 1, 0); PG8_LDB(B1, 1, 1); PG8_SCHED; PG8_LDA(At, 1, 0); PG8_STAGE(PG8_SA(0, 1), a2 + hstep, voffA);
            PG8_WAIT_V(8); PG8_WAIT_L(0); PG8_BAR; PG8_MMA(0, 0, At, B0); PG8_MMA(0, 1, At, B1); PG8_BAR; PG8_SCHED;
            PG8_LDA(At, 1, 1); PG8_STAGE(PG8_SB(1, 0), b3, voffB); PG8_STAGE(PG8_SB(1, 1), b3 + hstep, voffB); PG8_STAGE(PG8_SA(1, 0), a3, voffA);
            PG8_WAIT_V(8); PG8_WAIT_L(0); PG8_BAR; PG8_MMA(1, 0, At, B0); PG8_MMA(1, 1, At, B1); PG8_BAR; PG8_SCHED;
            } else {
            PG8_LDB(B0, 0, 0); PG8_SCHED; PG8_LDA(At, 0, 0); PG8_STAGE(PG8_SA(1, 1), a1 + hstep, voffA);
            PG8_WAIT_L(8); PG8_BAR; PG8_WAIT_L(0); PG8_MMA(0, 0, At, B0); PG8_BAR; PG8_SCHED;
            PG8_LDB(B1, 0, 1); PG8_STAGE(PG8_SB(0, 0), b2, voffB);
            PG8_BAR; PG8_WAIT_L(0); PG8_MMA(0, 1, At, B1); PG8_BAR;
            PG8_LDA(At, 0, 1); PG8_STAGE(PG8_SA(0, 0), a2, voffA);
            PG8_BAR; PG8_WAIT_L(0); PG8_MMA(1, 0, At, B0); PG8_BAR; PG8_SCHED;
            PG8_STAGE(PG8_SB(0, 1), b2 + hstep, voffB);
            PG8_WAIT_V(6); PG8_BAR; PG8_MMA(1, 1, At, B1); PG8_BAR;
            PG8_LDB(B0, 1, 0); PG8_SCHED; PG8_LDA(At, 1, 0); PG8_STAGE(PG8_SA(0, 1), a2 + hstep, voffA);
            PG8_WAIT_L(8); PG8_BAR; PG8_WAIT_L(0); PG8_MMA(0, 0, At, B0); PG8_BAR; PG8_SCHED;
            PG8_LDB(B1, 1, 1); PG8_STAGE(PG8_SB(1, 0), b3, voffB);
            PG8_BAR; PG8_WAIT_L(0); PG8_MMA(0, 1, At, B1); PG8_BAR;
            PG8_LDA(At, 1, 1); PG8_STAGE(PG8_SA(1, 0), a3, voffA);
            PG8_BAR; PG8_WAIT_L(0); PG8_MMA(1, 0, At, B0); PG8_BAR; PG8_SCHED;
            PG8_STAGE(PG8_SB(1, 1), b3 + hstep, voffB);
            PG8_WAIT_V(6); PG8_BAR; PG8_MMA(1, 1, At, B1); PG8_BAR;
            }
        }
        if constexpr (ALIGN_EPI) { if (wr == 0) PG8_BAR; }
        E(acc, cur, wr, wc, fr, fq); S.done(cur);
        if (!has_next) break;
        { float zf; asm volatile("v_mov_b32 %0, 0" : "=v"(zf)); const f32x4 Z = {zf, zf, zf, zf};
#pragma unroll
        for (int a = 0; a < 2; ++a)
#pragma unroll
            for (int b = 0; b < 2; ++b)
#pragma unroll
                for (int m = 0; m < 4; ++m)
#pragma unroll
                    for (int n = 0; n < 2; ++n) acc[a][b][m][n] = Z; }
        cur = nxt; cA = nA; cB = nB; ++ui;
        if constexpr (ALIGN_EPI) { if (wr == 1) PG8_BAR; }
    }
    PG8_WAIT_V(0);
    if constexpr (!ALIGN_EPI) { if (wr == 0) PG8_BAR; }
    PG8_BAR;
#undef PG8_SA
#undef PG8_SB
#undef PG8_STAGE
#undef PG8_LDA
#undef PG8_LDB
#undef PG8_MMA
#undef PG8_WAIT_V
#undef PG8_WAIT_L
#undef PG8_BAR
#undef PG8_SCHED
#undef PG8_ABASE
}

struct EpiBf16Plain {
    static constexpr bool PERM = true;
    bf16_t* O; int ldc;
    __device__ __forceinline__ void operator()(const f32x4 (&acc)[2][2][4][2], const Unit& u, int wr, int wc, int fr, int fq) const {
        const int row0 = u.pm * BM + wr * 64 + fr; const int col0 = u.pn * BM + wc * 32 + 8 * fq;
#pragma unroll
        for (int ai = 0; ai < 2; ++ai)
#pragma unroll
            for (int m = 0; m < 4; ++m) { bf16_t* rowp = O + (size_t)(row0 + ai * HALF + m * 16) * ldc + col0;
#pragma unroll
                for (int bj = 0; bj < 2; ++bj) { const f32x4 v0 = acc[ai][bj][m][0], v1 = acc[ai][bj][m][1];
                    u32x4 w; w.x = cvt_pk_bf16(v0[0], v0[1]); w.y = cvt_pk_bf16(v0[2], v0[3]); w.z = cvt_pk_bf16(v1[0], v1[1]); w.w = cvt_pk_bf16(v1[2], v1[3]);
                    *(u32x4*)(rowp + bj * HALF) = w; } }
    }
};
struct EpiResid {
    static constexpr bool PERM = true;
    bf16_t* Hb;
    __device__ __forceinline__ void operator()(const f32x4 (&acc)[2][2][4][2], const Unit& u, int wr, int wc, int fr, int fq) const {
        const int row0 = u.pm * BM + wr * 64 + fr, col0 = u.pn * BM + wc * 32 + 8 * fq;
        bf16_t* base = Hb + (size_t)row0 * DM + col0;
        u32x4 hv[2][4][2];
#pragma unroll
        for (int ai = 0; ai < 2; ++ai)
#pragma unroll
            for (int m = 0; m < 4; ++m)
#pragma unroll
                for (int bj = 0; bj < 2; ++bj) hv[ai][m][bj] = *(const u32x4*)(base + (size_t)(ai * HALF + m * 16) * DM + bj * HALF);
#pragma unroll
        for (int ai = 0; ai < 2; ++ai)
#pragma unroll
            for (int m = 0; m < 4; ++m)
#pragma unroll
                for (int bj = 0; bj < 2; ++bj) { const f32x4 v0 = acc[ai][bj][m][0], v1 = acc[ai][bj][m][1]; float p[8]; unpack8(hv[ai][m][bj], p);
                    const float o[8] = {p[0] + v0[0], p[1] + v0[1], p[2] + v0[2], p[3] + v0[3], p[4] + v1[0], p[5] + v1[1], p[6] + v1[2], p[7] + v1[3]};
                    *(u32x4*)(base + (size_t)(ai * HALF + m * 16) * DM + bj * HALF) = pack8(o); }
    }
};
struct EpiLora {
    static constexpr bool PERM = true;
    float* wdec; bf16_t* abuf; bf16_t* gbuf; const float* w0; const float* a0;
    __device__ __forceinline__ void operator()(const f32x4 (&acc)[2][2][4][2], const Unit& u, int wr, int wc, int fr, int fq) const {
        const int row0 = u.pm * BM + wr * 64 + fr; const int type = u.pn >> 2; const int col0 = (u.pn & 3) * BM + wc * 32 + 8 * fq;
        if (type == 0) {
            f32x4 bv[2][2];
#pragma unroll
            for (int bj = 0; bj < 2; ++bj) { bv[bj][0] = *(const f32x4*)(w0 + col0 + bj * HALF); bv[bj][1] = *(const f32x4*)(w0 + col0 + bj * HALF + 4); }
#pragma unroll
            for (int ai = 0; ai < 2; ++ai)
#pragma unroll
                for (int m = 0; m < 4; ++m) { float* rowp = wdec + (size_t)(row0 + ai * HALF + m * 16) * 1024 + col0;
#pragma unroll
                    for (int bj = 0; bj < 2; ++bj)
#pragma unroll
                        for (int n = 0; n < 2; ++n) { f32x4 x = acc[ai][bj][m][n] + bv[bj][n]; f32x4 o;
#pragma unroll
                            for (int i = 0; i < 4; ++i) { const float y = -x[i]; const float sp = fmaxf(y, 0.f) + __logf(1.0f + __expf(-fabsf(y))); o[i] = __expf(-__expf(-sp - 0.5f)); }
                            *(f32x4*)(rowp + bj * HALF + 4 * n) = o; } }
        } else {
            bf16_t* ob = (type == 1) ? abuf : gbuf;
            f32x4 bv[2][2];
#pragma unroll
            for (int bj = 0; bj < 2; ++bj) { bv[bj][0] = *(const f32x4*)(a0 + col0 + bj * HALF); bv[bj][1] = *(const f32x4*)(a0 + col0 + bj * HALF + 4); }
#pragma unroll
            for (int ai = 0; ai < 2; ++ai)
#pragma unroll
                for (int m = 0; m < 4; ++m) { bf16_t* rowp = ob + (size_t)(row0 + ai * HALF + m * 16) * 1024 + col0;
#pragma unroll
                    for (int bj = 0; bj < 2; ++bj) { f32x4 v0 = acc[ai][bj][m][0], v1 = acc[ai][bj][m][1];
                        if (type == 1) { v0 = v0 + bv[bj][0]; v1 = v1 + bv[bj][1];
#pragma unroll
                            for (int i = 0; i < 4; ++i) { v0[i] = sigmoidf_(v0[i]); v1[i] = sigmoidf_(v1[i]); } }
                        u32x4 w; w.x = cvt_pk_bf16(v0[0], v0[1]); w.y = cvt_pk_bf16(v0[2], v0[3]); w.z = cvt_pk_bf16(v1[0], v1[1]); w.w = cvt_pk_bf16(v1[2], v1[3]);
                        *(u32x4*)(rowp + bj * HALF) = w; } }
        }
    }
};
struct EpiGate {
    static constexpr bool PERM = true;
    bf16_t* MG; const bf16_t* P;
    __device__ __forceinline__ void operator()(const f32x4 (&acc)[2][2][4][2], const Unit& u, int wr, int wc, int fr, int fq) const {
        const int br = u.pn >> 3; const int row0 = u.pm * BM + wr * 64 + fr; const int col0 = (u.pn & 7) * BM + wc * 32 + 8 * fq;
        const bf16_t* gbase = P + (size_t)row0 * PN + P_GATES + br * 2048 + col0; bf16_t* mbase = MG + (size_t)row0 * DM + col0;
#pragma unroll
        for (int ai = 0; ai < 2; ++ai) {
            u32x4 gv[4][2], mv[4][2];
#pragma unroll
            for (int m = 0; m < 4; ++m)
#pragma unroll
                for (int bj = 0; bj < 2; ++bj) { gv[m][bj] = *(const u32x4*)(gbase + (size_t)(ai * HALF + m * 16) * PN + bj * HALF);
                    if (br > 0) mv[m][bj] = *(const u32x4*)(mbase + (size_t)(ai * HALF + m * 16) * DM + bj * HALF); }
#pragma unroll
            for (int m = 0; m < 4; ++m)
#pragma unroll
                for (int bj = 0; bj < 2; ++bj) { const f32x4 v0 = acc[ai][bj][m][0], v1 = acc[ai][bj][m][1]; const u32x4 gt = gv[m][bj];
                    float o[8] = { v0[0] * sigmoidf_(bflo(gt.x)), v0[1] * sigmoidf_(bfhi(gt.x)), v0[2] * sigmoidf_(bflo(gt.y)), v0[3] * sigmoidf_(bfhi(gt.y)),
                                   v1[0] * sigmoidf_(bflo(gt.z)), v1[1] * sigmoidf_(bfhi(gt.z)), v1[2] * sigmoidf_(bflo(gt.w)), v1[3] * sigmoidf_(bfhi(gt.w)) };
                    if (br > 0) { float p[8]; unpack8(mv[m][bj], p);
#pragma unroll
                        for (int i = 0; i < 8; ++i) o[i] += p[i]; }
                    *(u32x4*)(mbase + (size_t)(ai * HALF + m * 16) * DM + bj * HALF) = pack8(o); }
        }
    }
};
struct BranchOrder {
    StaticOrder base;
    __device__ bool next(int i, Unit& u) const { Unit t; if (!base.next(i / 3, t)) return false; u.pm = t.pm; u.pn = (i % 3) * 8 + t.pn; return true; }
    __device__ __forceinline__ void a_ready(const Unit&) const {}
    __device__ __forceinline__ void done(const Unit&) const {}
};
struct EpiSwiglu {
    static constexpr bool PERM = true;
    bf16_t* ACT;
    __device__ __forceinline__ void operator()(const f32x4 (&acc)[2][2][4][2], const Unit& u, int wr, int wc, int fr, int fq) const {
        const int row0 = u.pm * BM + wr * 64 + fr; const int col0 = u.pn * BM + wc * 32 + 8 * fq;
#pragma unroll
        for (int ai = 0; ai < 2; ++ai)
#pragma unroll
            for (int m = 0; m < 4; ++m) { const size_t row = (size_t)(row0 + ai * HALF + m * 16);
#pragma unroll
                for (int bj = 0; bj < 2; ++bj) { const int hc = (col0 + bj * HALF) >> 1; const f32x4 g = acc[ai][bj][m][0], up = acc[ai][bj][m][1];
                    float o[4];
#pragma unroll
                    for (int i = 0; i < 4; ++i) o[i] = g[i] * sigmoidf_(g[i]) * up[i];
                    u32x2 w; w.x = cvt_pk_bf16(o[0], o[1]); w.y = cvt_pk_bf16(o[2], o[3]);
                    *(u32x2*)(ACT + row * FFN + hc) = w; } }
    }
};
}

struct Args {
    const float* in[27];
    float* out; unsigned char* ws;
    int s_lo, s_hi, bar_idx, pad;
};
struct Ctx {
    float* out; unsigned char* ws; LAS unsigned char* lds; unsigned* ctl;
    int tid, lane, wave, G, wg;
};
enum { IN_X = 0, IN_META, IN_NORM_MIX, IN_W_IN, IN_MU, IN_W0, IN_W_UP, IN_A0, IN_A_UP, IN_G_UP, IN_K_K, IN_K_A, IN_R_K, IN_LN_W, IN_LN_B, IN_NORM_Q, IN_NORM_KV, IN_W_UQ, IN_W_UKV,
       IN_BR_RWKV, IN_BR_RET, IN_BR_MLA, IN_W_OUT, IN_NORM_FFN, IN_W_GU, IN_W_DOWN, IN_FINAL_NORM };

#define WSP(T, off) ((T*)(C.ws + (off)))
constexpr int LDS_INTBL = LDS_MISC + 256;
__device__ __forceinline__ const float* inp(const Ctx& C, int i) {
    const unsigned long long v = ((volatile LAS unsigned long long*)(C.lds + LDS_INTBL))[i];
    const unsigned lo = __builtin_amdgcn_readfirstlane((unsigned)v), hi = __builtin_amdgcn_readfirstlane((unsigned)(v >> 32));
    return (const float*)(GAS const float*)(((unsigned long long)hi << 32) | lo);
}

__device__ __forceinline__ void ph_rope_tables(const Ctx& C) {
    float* rt = WSP(float, WS_ROPE);
    float* cm = rt; float* sm = rt + LSEQ * 32; float* cr = rt + LSEQ * 64; float* sr = rt + LSEQ * 128;
    for (int i = C.wg * 512 + C.tid; i < LSEQ * 96; i += C.G * 512) {
        const int pos = i / 96, j = i % 96;
        if (j < 32) { const float inv = powf(10000.0f, -((float)(2 * j) / 64.0f)); const float ang = (float)pos * inv; cm[pos * 32 + j] = cosf(ang); sm[pos * 32 + j] = sinf(ang); }
        else { const int jj = j - 32; const float inv = powf(10000.0f, -((float)(2 * jj) / 128.0f)); const float ang = (float)pos * inv; cr[pos * 64 + jj] = cosf(ang); sr[pos * 64 + jj] = sinf(ang); }
    }
}

template <class RowPtr>
__device__ __forceinline__ void conv_T(const Ctx& C, const float* __restrict__ src, int ld, int K, int c0, int ncols, const float* __restrict__ gain, const RowPtr& rowptr, int& tbase) {
    LAS float* tile = (LAS float*)C.lds;
    const int nkt = K / 64, ntile = nkt * (ncols / 64);
    const int t = C.tid, kk = t >> 3, n8 = (t & 7) * 8;
    int ti = (C.wg - (tbase % C.G) + C.G) % C.G;
    tbase += ntile;
    if (ti >= ntile) return;
    f32x4 a, b; float gn;
    { const int k0 = (ti % nkt) * 64, n0 = c0 + (ti / nkt) * 64; const float* sp = src + (size_t)(k0 + kk) * ld + n0 + n8; a = *(const f32x4*)sp; b = *(const f32x4*)(sp + 4); gn = gain ? gain[k0 + kk] : 1.0f; }
    for (; ti < ntile; ti += C.G) {
        const int k0 = (ti % nkt) * 64, n0 = c0 + (ti / nkt) * 64;
        { LAS float* tp = tile + kk * 65 + n8;
          tp[0] = a[0] * gn; tp[1] = a[1] * gn; tp[2] = a[2] * gn; tp[3] = a[3] * gn; tp[4] = b[0] * gn; tp[5] = b[1] * gn; tp[6] = b[2] * gn; tp[7] = b[3] * gn; }
        { const int tn = ti + C.G; if (tn < ntile) { const int k1 = (tn % nkt) * 64, n1 = c0 + (tn / nkt) * 64; const float* sp = src + (size_t)(k1 + kk) * ld + n1 + n8; a = *(const f32x4*)sp; b = *(const f32x4*)(sp + 4); gn = gain ? gain[k1 + kk] : 1.0f; } }
        __syncthreads();
        { const int n = t >> 3, k8 = (t & 7) * 8; bf16_t* dp = rowptr(n0 + n);
          if (dp) { float v[8];
#pragma unroll
              for (int i = 0; i < 8; ++i) v[i] = tile[(k8 + i) * 65 + n];
              u32x4 w; w.x = cvt_pk_bf16(v[0], v[1]); w.y = cvt_pk_bf16(v[2], v[3]); w.z = cvt_pk_bf16(v[4], v[5]); w.w = cvt_pk_bf16(v[6], v[7]);
              *(u32x4*)(dp + k0 + k8) = w; } }
        __syncthreads();
    }
}
struct RpLinear { bf16_t* base; int ldk; int coff; int roff; __device__ __forceinline__ bf16_t* operator()(int n) const { return base + (size_t)(n - coff + roff) * ldk; } };
struct RpWin { bf16_t* win; bf16_t* wvret; __device__ __forceinline__ bf16_t* operator()(int n) const {
    if (n < 5568) return win + (size_t)n * DM; if (n < 6592) return wvret + (size_t)(n - 5568) * DM; return win + (size_t)(n - 1024) * DM; } };
struct RpUkv { bf16_t* wuk; bf16_t* wuv; __device__ __forceinline__ bf16_t* operator()(int n) const { const int h = n >> 8, j = n & 255; return (j < 128 ? wuk + (size_t)(h * 128 + j) * 256 : wuv + (size_t)(h * 128 + j - 128) * 256); } };
struct RpOut3 { bf16_t* base; int seg; __device__ __forceinline__ bf16_t* operator()(int n) const { return base + (size_t)n * 6144 + seg * 2048; } };
struct RpGu { bf16_t* base; __device__ __forceinline__ bf16_t* operator()(int n) const { const int which = n >= FFN ? 1 : 0; const int j = n - which * FFN; return base + (size_t)(8 * (j >> 2) + 4 * which + (j & 3)) * DM; } };

__device__ __forceinline__ void ph_convB(const Ctx& C, int l) {
    int tb = 0;
    conv_T(C, inp(C, IN_W_DOWN) + (size_t)l * FFN * DM, DM, FFN, 0, DM, nullptr, RpLinear{WSP(bf16_t, WS_WD), FFN, 0, 0}, tb);
    conv_T(C, inp(C, IN_W_OUT) + (size_t)l * DM * DM, DM, DM, 0, DM, nullptr, RpLinear{WSP(bf16_t, WS_WOUT), DM, 0, 0}, tb);
    conv_T(C, inp(C, IN_BR_RWKV) + (size_t)l * 1024 * DM, DM, 1024, 0, DM, nullptr, RpLinear{WSP(bf16_t, WS_WBR), 1024, 0, 0}, tb);
    conv_T(C, inp(C, IN_BR_RET) + (size_t)l * 1024 * DM, DM, 1024, 0, DM, nullptr, RpLinear{WSP(bf16_t, WS_WBR), 1024, 0, 2048}, tb);
    conv_T(C, inp(C, IN_BR_MLA) + (size_t)l * 1024 * DM, DM, 1024, 0, DM, nullptr, RpLinear{WSP(bf16_t, WS_WBR), 1024, 0, 4096}, tb);
}

__device__ __forceinline__ void ph_conv(const Ctx& C, int l) {
    int tb = 0;
    conv_T(C, inp(C, IN_W_IN) + (size_t)l * DM * IN_COLS, IN_COLS, DM, 0, IN_COLS, inp(C, IN_NORM_MIX) + l * DM, RpWin{WSP(bf16_t, WS_WIN), WSP(bf16_t, WS_WVRET)}, tb);
    conv_T(C, inp(C, IN_W_GU) + (size_t)l * DM * 2 * FFN, 2 * FFN, DM, 0, 2 * FFN, inp(C, IN_NORM_FFN) + l * DM, RpGu{WSP(bf16_t, WS_WGU)}, tb);
    conv_T(C, inp(C, IN_W_UQ) + (size_t)l * 512 * 1536, 1536, 512, 0, 1536, inp(C, IN_NORM_Q) + l * 512, RpLinear{WSP(bf16_t, WS_WUQ), 512, 0, 0}, tb);
    conv_T(C, inp(C, IN_W_UKV) + (size_t)l * 256 * 2048, 2048, 256, 0, 2048, inp(C, IN_NORM_KV) + l * 256, RpUkv{WSP(bf16_t, WS_WUK), WSP(bf16_t, WS_WUV)}, tb);
    { bf16_t* wl = WSP(bf16_t, WS_WLORA); const float* wup = inp(C, IN_W_UP) + (size_t)l * 96 * 1024; const float* aup = inp(C, IN_A_UP) + (size_t)l * 96 * 1024; const float* gup = inp(C, IN_G_UP) + (size_t)l * 256 * 1024;
      static_assert((LORA_N * LORA_K) % 4 == 0, "lora conversion");
      for (int i0 = (C.wg * 512 + C.tid) * 4; i0 < LORA_N * LORA_K; i0 += C.G * 512 * 4) { float v[4];
#pragma unroll
          for (int e = 0; e < 4; ++e) { const int i = i0 + e, n = i / LORA_K, k = i % LORA_K; v[e] = 0.f;
              if (n < 1024) { if (k < 96) v[e] = wup[k * 1024 + n]; } else if (n < 2048) { if (k >= 96 && k < 192) v[e] = aup[(k - 96) * 1024 + (n - 1024)]; } else { if (k >= 192 && k < 448) v[e] = gup[(k - 192) * 1024 + (n - 2048)]; } }
          *(u32x2*)(wl + i0) = (u32x2){cvt_pk_bf16(v[0], v[1]), cvt_pk_bf16(v[2], v[3])}; } }
}

template <bool FIRST>
__device__ __forceinline__ void ph_norm(const Ctx& C) {
    bf16_t* H = WSP(bf16_t, WS_H); bf16_t* U = WSP(bf16_t, WS_U);
    for (int r0 = C.wg * 8 + C.wave; r0 < MP; r0 += C.G * 16) {
        int rows[2]; rows[0] = r0; rows[1] = r0 + C.G * 8;
        float v[2][4][8]; u32x4 raw[2][4];
#pragma unroll
        for (int rr = 0; rr < 2; ++rr)
#pragma unroll
            for (int i = 0; i < 4; ++i) raw[rr][i] = zero4u();
#pragma unroll
        for (int rr = 0; rr < 2; ++rr) { const int row = rows[rr]; if (row >= M) continue;
            if (FIRST) { const int b = row / LSEQ, pos = row % LSEQ; const float* sp = pos < NMETA ? inp(C, IN_META) + (size_t)pos * DM : inp(C, IN_X) + ((size_t)b * SEQ + (pos - NMETA)) * DM;
#pragma unroll
                for (int i = 0; i < 4; ++i) ld8f(sp + (i * 64 + C.lane) * 8, v[rr][i]); }
            else { const bf16_t* hp = H + (size_t)row * DM;
#pragma unroll
                for (int i = 0; i < 4; ++i) raw[rr][i] = *(const u32x4*)(hp + (i * 64 + C.lane) * 8); } }
        __builtin_amdgcn_sched_barrier(0);
        if (!FIRST) {
#pragma unroll
            for (int rr = 0; rr < 2; ++rr)
#pragma unroll
                for (int i = 0; i < 4; ++i) unpack8(raw[rr][i], v[rr][i]); }
#pragma unroll
        for (int rr = 0; rr < 2; ++rr) { const int row = rows[rr]; if (row >= MP) continue;
            bf16_t* up = U + (size_t)row * DM;
            if (row >= M) { const u32x4 z = zero4u(); for (int i = 0; i < 4; ++i) *(u32x4*)(up + (i * 64 + C.lane) * 8) = z; continue; }
            bf16_t* hp = H + (size_t)row * DM; float ss = 0.f;
#pragma unroll
            for (int i = 0; i < 4; ++i)
#pragma unroll
                for (int j = 0; j < 8; ++j) ss += v[rr][i][j] * v[rr][i][j];
            ss = wsum64(ss); const float rstd = rsqrtf(ss * (1.0f / DM) + NORM_EPS);
#pragma unroll
            for (int i = 0; i < 4; ++i) { if (FIRST) *(u32x4*)(hp + (i * 64 + C.lane) * 8) = pack8(v[rr][i]);
                float o[8];
#pragma unroll
                for (int j = 0; j < 8; ++j) o[j] = v[rr][i][j] * rstd;
                *(u32x4*)(up + (i * 64 + C.lane) * 8) = pack8(o); } }
    }
}
__device__ __forceinline__ void ph_final(const Ctx& C) {
    const bf16_t* H = WSP(bf16_t, WS_H); const float* fn = inp(C, IN_FINAL_NORM);
    f32x4 gn[4][2];
#pragma unroll
    for (int i = 0; i < 4; ++i) { gn[i][0] = *(const f32x4*)(fn + (i * 64 + C.lane) * 8); gn[i][1] = *(const f32x4*)(fn + (i * 64 + C.lane) * 8 + 4); }
    for (int r = C.wg * 8 + C.wave; r < NB * SEQ; r += C.G * 8) {
        const int b = r / SEQ, t = r % SEQ; const bf16_t* sp = H + ((size_t)b * LSEQ + NMETA + t) * DM; float* op = C.out + (size_t)r * DM;
        float v[4][8]; float ss = 0.f; u32x4 raw[4];
#pragma unroll
        for (int i = 0; i < 4; ++i) raw[i] = *(const u32x4*)(sp + (i * 64 + C.lane) * 8);
        __builtin_amdgcn_sched_barrier(0);
#pragma unroll
        for (int i = 0; i < 4; ++i) { unpack8(raw[i], v[i]);
#pragma unroll
            for (int j = 0; j < 8; ++j) ss += v[i][j] * v[i][j]; }
        ss = wsum64(ss); const float rstd = rsqrtf(ss * (1.0f / DM) + NORM_EPS);
#pragma unroll
        for (int i = 0; i < 4; ++i) { const int c = (i * 64 + C.lane) * 8; const f32x4 g0 = gn[i][0], g1 = gn[i][1];
            *(f32x4*)(op + c) = (f32x4){v[i][0] * rstd * g0[0], v[i][1] * rstd * g0[1], v[i][2] * rstd * g0[2], v[i][3] * rstd * g0[3]};
            *(f32x4*)(op + c + 4) = (f32x4){v[i][4] * rstd * g1[0], v[i][5] * rstd * g1[1], v[i][6] * rstd * g1[2], v[i][7] * rstd * g1[3]}; }
    }
}
__device__ __forceinline__ void unpack8(const u32x4 w, float (&x)[8]) { x[0] = bflo(w.x); x[1] = bfhi(w.x); x[2] = bflo(w.y); x[3] = bfhi(w.y); x[4] = bflo(w.z); x[5] = bfhi(w.z); x[6] = bflo(w.w); x[7] = bfhi(w.w); }
__device__ __forceinline__ u32x4 pack8(const float (&x)[8]) { u32x4 w; w.x = cvt_pk_bf16(x[0], x[1]); w.y = cvt_pk_bf16(x[2], x[3]); w.z = cvt_pk_bf16(x[4], x[5]); w.w = cvt_pk_bf16(x[6], x[7]); return w; }

__device__ __forceinline__ void ph_prepA(const Ctx& C, int l) {
    const bf16_t* P = WSP(bf16_t, WS_P); bf16_t* XL = WSP(bf16_t, WS_XL); bf16_t* QN = WSP(bf16_t, WS_QN); bf16_t* KVN = WSP(bf16_t, WS_KVN); bf16_t* KR = WSP(bf16_t, WS_KR);
    const float* mu = inp(C, IN_MU) + (size_t)l * RW_COLS; const float* rt = WSP(float, WS_ROPE); const float* cm = rt; const float* sm = rt + LSEQ * 32;
    const int lane = C.lane;
    for (int row = C.wg * 8 + C.wave; row < MP; row += C.G * 8) {
        if (row >= M) { const u32x4 z = zero4u(); *(u32x4*)(XL + (size_t)row * 512 + 8 * lane) = z; *(u32x4*)(QN + (size_t)row * 512 + 8 * lane) = z;
            if (lane < 32) *(u32x4*)(KVN + (size_t)row * 256 + 8 * lane) = z; KR[(size_t)row * 64 + lane] = (bf16_t)z.x; continue; }
        const int pos = row % LSEQ; const bf16_t* pr = P + (size_t)row * PN;
        const int khl = lane >> 3, kc8 = (lane & 7) * 8; bf16_t* kbase = WSP(bf16_t, WS_P) + (size_t)row * PN + P_KRET + khl * 128 + kc8;
        const u32x4 kx1 = *(const u32x4*)kbase, kx2 = *(const u32x4*)(kbase + 64);
        float kcc[8], kss[8]; ld8f(rt + LSEQ * 64 + pos * 64 + kc8, kcc); ld8f(rt + LSEQ * 128 + pos * 64 + kc8, kss);
        const bool lact = lane < 56; const int lc = 3072 + 8 * (lact ? lane : 0);
        const u32x4 lz = *(const u32x4*)(pr + lc), lpz = *(const u32x4*)((pos > 0 ? pr - PN : pr) + lc); const f32x4 lm0 = *(const f32x4*)(mu + lc), lm1 = *(const f32x4*)(mu + lc + 4);
        const u32x4 qdw = *(const u32x4*)(pr + P_QD + 8 * lane), kvw = *(const u32x4*)(pr + P_KVD + 8 * (lane & 31));
        const bf16_t kr1 = pr[P_KRD + (lane & 31)], kr2 = pr[P_KRD + 32 + (lane & 31)]; const float krc = cm[pos * 32 + (lane & 31)], krs = sm[pos * 32 + (lane & 31)];
        { u32x4 o = zero4u();
          if (lact) { float z[8], pz[8];
              unpack8(lz, z);
              if (pos > 0) unpack8(lpz, pz); else { for (int i = 0; i < 8; ++i) pz[i] = 0.f; }
              const float mm[8] = {lm0[0], lm0[1], lm0[2], lm0[3], lm1[0], lm1[1], lm1[2], lm1[3]};
              float x[8];
#pragma unroll
              for (int i = 0; i < 8; ++i) { const float zs = z[i] + (pz[i] - z[i]) * mm[i]; x[i] = (lane < 12) ? tanhf(zs) : (lane < 24 ? zs : sigmoidf_(zs)); }
              o = pack8(x); }
          *(u32x4*)(XL + (size_t)row * 512 + 8 * lane) = o; }
        { float x[8]; unpack8(qdw, x); float ss = 0.f;
#pragma unroll
          for (int i = 0; i < 8; ++i) ss += x[i] * x[i];
          ss = wsum64(ss); const float rstd = rsqrtf(ss * (1.0f / 512.0f) + NORM_EPS);
#pragma unroll
          for (int i = 0; i < 8; ++i) x[i] *= rstd;
          *(u32x4*)(QN + (size_t)row * 512 + 8 * lane) = pack8(x); }
        { float x[8]; if (lane < 32) unpack8(kvw, x); else { for (int i = 0; i < 8; ++i) x[i] = 0.f; }
          float ss = 0.f;
#pragma unroll
          for (int i = 0; i < 8; ++i) ss += x[i] * x[i];
          ss = wsum64(ss); const float rstd = rsqrtf(ss * (1.0f / 256.0f) + NORM_EPS);
#pragma unroll
          for (int i = 0; i < 8; ++i) x[i] *= rstd;
          if (lane < 32) *(u32x4*)(KVN + (size_t)row * 256 + 8 * lane) = pack8(x); }
        { float x1[8], x2[8], o1[8], o2[8]; unpack8(kx1, x1); unpack8(kx2, x2);
#pragma unroll
          for (int i = 0; i < 8; ++i) { o1[i] = (x1[i] * kcc[i] - x2[i] * kss[i]) * 0.08838834764831845f; o2[i] = (x2[i] * kcc[i] + x1[i] * kss[i]) * 0.08838834764831845f; }
          *(u32x4*)kbase = pack8(o1); *(u32x4*)(kbase + 64) = pack8(o2); }
        if (lane < 32) { const float x1 = bf2f(kr1), x2 = bf2f(kr2); const float c = krc, s = krs;
            KR[(size_t)row * 64 + lane] = f2bf(x1 * c - x2 * s); KR[(size_t)row * 64 + 32 + lane] = f2bf(x2 * c + x1 * s); }
    }
}
__device__ __forceinline__ float sum8(float x) { x += dpp_xor1(x); x += dpp_xor2(x); x += dpp_hmirror(x); return x; }
__device__ __forceinline__ void ld8f(const float* p, float (&x)[8]) { const f32x4 a = *(const f32x4*)p, b = *(const f32x4*)(p + 4); x[0] = a[0]; x[1] = a[1]; x[2] = a[2]; x[3] = a[3]; x[4] = b[0]; x[5] = b[1]; x[6] = b[2]; x[7] = b[3]; }
__device__ __forceinline__ void ph_qrope(const Ctx& C) {
    bf16_t* Q = WSP(bf16_t, WS_Q); const float* rt = WSP(float, WS_ROPE); const float* cm = rt; const float* sm = rt + LSEQ * 32;
    const int lane = C.lane, hl = lane >> 3;
    for (int r0 = C.wg * 8 + C.wave; r0 < M; r0 += C.G * 16) {
        int rows[2]; bool ok[2]; rows[0] = r0; ok[0] = true; rows[1] = r0 + C.G * 8; ok[1] = rows[1] < M; if (!ok[1]) rows[1] = r0;
        u32x2 m1w[2], m2w[2];
#pragma unroll
        for (int rr = 0; rr < 2; ++rr) { const bf16_t* mb = Q + (size_t)rows[rr] * 1536 + hl * 192 + 128 + (lane & 7) * 4; m1w[rr] = *(const u32x2*)mb; m2w[rr] = *(const u32x2*)(mb + 32); }
#pragma unroll
        for (int rr = 0; rr < 2; ++rr) { if (!ok[rr]) continue;
            const int pos = rows[rr] % LSEQ; bf16_t* base = Q + (size_t)rows[rr] * 1536 + hl * 192 + 128 + (lane & 7) * 4; const u32x2 w1 = m1w[rr], w2 = m2w[rr];
            const f32x4 c4 = *(const f32x4*)(cm + pos * 32 + (lane & 7) * 4), s4 = *(const f32x4*)(sm + pos * 32 + (lane & 7) * 4);
            const float x1[4] = {bflo(w1.x), bfhi(w1.x), bflo(w1.y), bfhi(w1.y)}, x2[4] = {bflo(w2.x), bfhi(w2.x), bflo(w2.y), bfhi(w2.y)};
            float o1[4], o2[4];
#pragma unroll
            for (int i = 0; i < 4; ++i) { o1[i] = x1[i] * c4[i] - x2[i] * s4[i]; o2[i] = x2[i] * c4[i] + x1[i] * s4[i]; }
            *(u32x2*)base = (u32x2){cvt_pk_bf16(o1[0], o1[1]), cvt_pk_bf16(o1[2], o1[3])}; *(u32x2*)(base + 32) = (u32x2){cvt_pk_bf16(o2[0], o2[1]), cvt_pk_bf16(o2[2], o2[3])}; }
    }
}
__device__ __forceinline__ void ph_post(const Ctx& C, int l) {
    unsigned char* rw = C.ws + WS_RW; const float* YR = (const float*)(rw + RW_YRAW);
    const bf16_t* Gb = (const bf16_t*)(rw + RW_A + 1 * RW_ARR); const float* BS = (const float*)(rw + RW_A + 2 * RW_ARR); const bf16_t* P = WSP(bf16_t, WS_P);
    bf16_t* YA = WSP(bf16_t, WS_YBR);
    const float* mu_v = inp(C, IN_MU) + (size_t)l * RW_COLS + 2048; const float* ln_w = inp(C, IN_LN_W) + l * 1024; const float* ln_b = inp(C, IN_LN_B) + l * 1024;
    const int lane = C.lane, hl = lane >> 3, c8 = (lane & 7) * 8;
    for (int r0 = C.wg * 8 + C.wave; r0 < MP; r0 += C.G * 16) {
        int rows[2]; bool live[2]; rows[0] = r0; rows[1] = r0 + C.G * 8; live[0] = rows[0] < M; live[1] = rows[1] < M;
#pragma unroll
        for (int rr = 0; rr < 2; ++rr) if (rows[rr] < MP && !live[rr]) { const u32x4 z = zero4u(); *(u32x4*)(YA + (size_t)rows[rr] * 1024 + 16 * lane) = z; *(u32x4*)(YA + (size_t)rows[rr] * 1024 + 16 * lane + 8) = z; }
        u32x4 wv_[2][2], wp_[2][2], wg_[2][2]; f32x4 ya[2][2], yb[2][2]; float bsv[2][2], hpf[2];
#pragma unroll
        for (int rr = 0; rr < 2; ++rr) { const int row = live[rr] ? rows[rr] : 0; const bool hp = (row % LSEQ) > 0; hpf[rr] = hp ? 1.0f : 0.0f;
            const bf16_t* pr = P + (size_t)row * PN + 2048; const bf16_t* pp = hp ? pr - PN : pr;
#pragma unroll
            for (int ps = 0; ps < 2; ++ps) { const int c = (8 * ps + hl) * 64 + c8; const size_t o = (size_t)row * 1024 + c;
                ya[rr][ps] = *(const f32x4*)(YR + o); yb[rr][ps] = *(const f32x4*)(YR + o + 4); wv_[rr][ps] = *(const u32x4*)(pr + c); wp_[rr][ps] = *(const u32x4*)(pp + c); wg_[rr][ps] = *(const u32x4*)(Gb + o);
                bsv[rr][ps] = BS[(size_t)row * 16 + 8 * ps + hl]; } }
#pragma unroll
        for (int ps = 0; ps < 2; ++ps) {
            const int c = (8 * ps + hl) * 64 + c8; float mv[8], lw[8], lb[8];
            ld8f(mu_v + c, mv); ld8f(ln_w + c, lw); ld8f(ln_b + c, lb);
#pragma unroll
            for (int rr = 0; rr < 2; ++rr) {
                float y[8] = {ya[rr][ps][0], ya[rr][ps][1], ya[rr][ps][2], ya[rr][ps][3], yb[rr][ps][0], yb[rr][ps][1], yb[rr][ps][2], yb[rr][ps][3]}, zv[8], qv[8], gg[8], out[8];
                unpack8(wv_[rr][ps], zv); unpack8(wp_[rr][ps], qv); unpack8(wg_[rr][ps], gg);
                const float bs = bsv[rr][ps];
                float s = 0.f;
#pragma unroll
                for (int i = 0; i < 8; ++i) s += y[i];
                const float mean = sum8(s) * (1.0f / 64.0f);
                float q = 0.f;
#pragma unroll
                for (int i = 0; i < 8; ++i) { y[i] -= mean; q += y[i] * y[i]; }
                const float rstd = rsqrtf(sum8(q) * (1.0f / 64.0f) + GN_EPS);
#pragma unroll
                for (int i = 0; i < 8; ++i) { const float vv = zv[i] + (qv[i] * hpf[rr] - zv[i]) * mv[i]; out[i] = (y[i] * rstd * lw[i] + lb[i] + bs * vv) * gg[i]; }
                if (live[rr]) *(u32x4*)(YA + (size_t)rows[rr] * 1024 + c) = pack8(out);
            }
        }
    }
}

#define MFMA_DRAIN(acc) asm volatile("s_nop 15\n\ts_nop 4" : "+v"(acc))
__device__ __forceinline__ void ph_rwkvpre(const Ctx& C, int l) {
    constexpr int WSC = 10240;
    LAS unsigned char* sc = C.lds + C.wave * WSC;
    LAS float* Gm = (LAS float*)sc;
    LAS float* TM = (LAS float*)(sc + 4608);
    LAS float* TMT = TM + 256; LAS float* FT = TM + 512; LAS float* W2 = TM + 768; LAS float* YBT = TM + 1024;
    unsigned char* rw = C.ws + WS_RW;
    const float* WD = (const float*)(rw + RW_WDEC); const bf16_t* Ag = (const bf16_t*)(rw + RW_A); const bf16_t* P = WSP(bf16_t, WS_P);
    float* BS = (float*)(rw + RW_A + 2 * RW_ARR);
    const float* mu = inp(C, IN_MU) + (size_t)l * RW_COLS; const float* k_k = inp(C, IN_K_K) + l * 1024; const float* k_a = inp(C, IN_K_A) + l * 1024; const float* r_k = inp(C, IN_R_K) + l * 1024;
    unsigned char* RCH = C.ws + WS_RCH;
    const int lane = C.lane, ql = lane & 31, hh = lane >> 5, t = lane & 15, q4 = (lane >> 4) * 4;
    for (int u = C.wg * 8 + C.wave; u < NB * 16 * NCHUNK; u += C.G * 8) {
        const int bh = u / NCHUNK, c = u - bh * NCHUNK;
        const int hd = bh & 15, chn = hd * 64 + lane; const size_t row0 = (size_t)(bh >> 4) * LSEQ + 16 * c;
        unsigned char* rec = RCH + (size_t)u * RC_STRIDE;
        float Kb[16], Rb[16], Kh[16], Bh[16]; unsigned vpk[8]; float gC;
        {
            unsigned short zr[17], zk[17], zv[17], za[16]; float wv[16];
#pragma unroll
            for (int i = 0; i < 17; ++i) { const size_t pr = (row0 + (size_t)((i == 0 && c == 0) ? 0 : i - 1)) * PN + chn; zr[i] = P[pr]; zk[i] = P[pr + 1024]; zv[i] = P[pr + 2048]; }
#pragma unroll
            for (int i = 0; i < 16; ++i) { const size_t o = (row0 + i) * 1024 + chn; za[i] = Ag[o]; wv[i] = WD[o]; }
            const float mur = mu[chn], muk = mu[1024 + chn], muv = mu[2048 + chn], kkc = k_k[chn], kac = k_a[chn], rkc = r_k[chn];
            float g = 1.0f; float vxs[16]; int bsv = 0;
#pragma unroll
            for (int i = 0; i < 16; ++i) {
                const float hp = (i == 0 && c == 0) ? 0.0f : 1.0f;
                const float cr = bf2f(zr[i + 1]), ck = bf2f(zk[i + 1]), cv = bf2f(zv[i + 1]);
                const float rr = cr + (bf2f(zr[i]) * hp - cr) * mur, kx = ck + (bf2f(zk[i]) * hp - ck) * muk, vx = cv + (bf2f(zv[i]) * hp - cv) * muv;
                const float av = bf2f(za[i]);
                float kkx = kx * kkc; const float n2 = wsum64_dpp(kkx * kkx); kkx *= __builtin_amdgcn_rsqf(fmaxf(n2, 1e-24f));
                const float kpx = kx * (1.0f + (av - 1.0f) * kac), bbx = kkx * av;
                const float bs = wsum64_dpp(rr * kpx * rkc); bsv = (lane == i) ? __float_as_int(bs) : bsv;
                const float gp = g; g *= wv[i]; const float ig = __builtin_amdgcn_rcpf(g);
                Kb[i] = kkx * gp; Rb[i] = rr * g; Kh[i] = kpx * ig; Bh[i] = bbx * ig;
                vxs[i] = vx;
                *(LAS bf16_t*)(sc + i * 144 + lane * 2) = f2bf(Kh[i]); *(LAS bf16_t*)(sc + (16 + i) * 144 + lane * 2) = f2bf(Bh[i]);
                *(LAS bf16_t*)(sc + 4608 + i * 144 + lane * 2) = f2bf(Kb[i]); *(LAS bf16_t*)(sc + 4608 + (16 + i) * 144 + lane * 2) = f2bf(Rb[i]); }
#pragma unroll
            for (int i = 0; i < 16; ++i) { Kh[i] *= g; Bh[i] *= g; }
            gC = g;
#pragma unroll
            for (int i = 0; i < 8; ++i) vpk[i] = cvt_pk_bf16(vxs[2 * i], vxs[2 * i + 1]);
            if (lane < 16) BS[(row0 + lane) * 16 + hd] = __int_as_float(bsv);
        }
        __builtin_amdgcn_wave_barrier();
        {
            f32x16 acc;
#pragma unroll
            for (int r = 0; r < 16; ++r) acc[r] = 0.f;
#pragma unroll
            for (int s = 0; s < 4; ++s) { const bf16x8 a = *(const LAS bf16x8*)(sc + ql * 144 + 32 * s + 16 * hh); const bf16x8 bq = *(const LAS bf16x8*)(sc + 4608 + ql * 144 + 32 * s + 16 * hh);
                acc = __builtin_amdgcn_mfma_f32_32x32x16_bf16(a, bq, acc, 0, 0, 0); }
            __builtin_amdgcn_wave_barrier();
#pragma unroll
            for (int r = 0; r < 16; ++r) { const int row = (r & 3) + 8 * (r >> 2) + 4 * hh, i = row & 15; const bool keep = (ql >= 16) ? (i <= (ql & 15)) : (i < ql); Gm[row * 36 + ql] = keep ? acc[r] : 0.f; }
        }
        __builtin_amdgcn_wave_barrier();
        {
            float X[16];
#pragma unroll
            for (int i = 15; i >= 0; --i) { float x = (t == i) ? 1.0f : 0.0f; const LAS float* er = Gm + (16 + i) * 36;
#pragma unroll
                for (int j = i + 1; j < 16; ++j) x -= er[j] * X[j];
                X[i] = x; }
#pragma unroll
            for (int i = 0; i < 16; ++i) TM[i * 16 + t] = X[i];
#pragma unroll
            for (int i = 0; i < 4; ++i) *(LAS f32x4*)(TMT + t * 16 + 4 * i) = (f32x4){X[4 * i], X[4 * i + 1], X[4 * i + 2], X[4 * i + 3]};
            float E2c[16];
#pragma unroll
            for (int j = 0; j < 16; ++j) E2c[j] = Gm[(16 + j) * 36 + 16 + t];
#pragma unroll
            for (int e = 0; e < 4; ++e) { const LAS float* ar = Gm + (q4 + e) * 36; float s = 0.f;
#pragma unroll
                for (int i = 0; i < 16; ++i) s += ar[i] * X[i];
                W2[(q4 + e) * 16 + t] = s; }
            __builtin_amdgcn_wave_barrier();
            f32x4 fv, yv;
#pragma unroll
            for (int e = 0; e < 4; ++e) { const LAS float* tr = TM + (q4 + e) * 16; const LAS float* wr = W2 + (q4 + e) * 16; float s = 0.f, y = Gm[(q4 + e) * 36 + 16 + t];
#pragma unroll
                for (int j = 0; j < 16; ++j) { s += tr[j] * E2c[j]; y -= wr[j] * E2c[j]; }
                fv[e] = s; yv[e] = y; }
            *(LAS f32x4*)(FT + t * 16 + q4) = fv; *(LAS f32x4*)(YBT + t * 16 + q4) = yv;
        }
        __builtin_amdgcn_wave_barrier();
        {
            { unsigned char* b2 = rec + RC_B2 + lane * 80;
              *(u32x4*)(b2) = (u32x4){cvt_pk_bf16(-Bh[0], -Bh[1]), cvt_pk_bf16(-Bh[2], -Bh[3]), cvt_pk_bf16(-Bh[4], -Bh[5]), cvt_pk_bf16(-Bh[6], -Bh[7])};
              *(u32x4*)(b2 + 16) = (u32x4){cvt_pk_bf16(-Bh[8], -Bh[9]), cvt_pk_bf16(-Bh[10], -Bh[11]), cvt_pk_bf16(-Bh[12], -Bh[13]), cvt_pk_bf16(-Bh[14], -Bh[15])}; }
            u32x4 kb0, kb1, rb0, rb1, bh0, bh1, kh0, kh1;
#define RC_BOP(src_, t0_, t1_) do { _Pragma("unroll") for (int e = 0; e < 4; ++e) { const unsigned x_ = cvt_pk_bf16(src_[2 * e], src_[2 * e + 1]), y_ = cvt_pk_bf16(src_[8 + 2 * e], src_[9 + 2 * e]); \
                const auto sw_ = __builtin_amdgcn_permlane32_swap(x_, y_, false, false); t0_[e] = sw_[0]; t1_[e] = sw_[1]; } } while (0)
            RC_BOP(Kb, kb0, kb1); RC_BOP(Rb, rb0, rb1); RC_BOP(Bh, bh0, bh1); RC_BOP(Kh, kh0, kh1);
#undef RC_BOP
            const bool lo16 = ql < 16; const int m16 = ql & 15;
            u32x4 aPA, aPB, aIlo, aIhi;
            { const LAS float* ap = (lo16 ? TMT : FT) + m16 * 16 + 8 * hh; const f32x4 a0 = *(const LAS f32x4*)ap, a1 = *(const LAS f32x4*)(ap + 4); const float sg = lo16 ? 1.0f : -1.0f;
              aPA = (u32x4){cvt_pk_bf16(a0[0] * sg, a0[1] * sg), cvt_pk_bf16(a0[2] * sg, a0[3] * sg), cvt_pk_bf16(a1[0] * sg, a1[1] * sg), cvt_pk_bf16(a1[2] * sg, a1[3] * sg)};
              const LAS float* wp = W2 + m16 * 16 + 8 * hh; const f32x4 w0 = *(const LAS f32x4*)wp, w1 = *(const LAS f32x4*)(wp + 4); const float sw = lo16 ? -1.0f : 0.0f;
              aPB = (u32x4){cvt_pk_bf16(w0[0] * sw, w0[1] * sw), cvt_pk_bf16(w0[2] * sw, w0[3] * sw), cvt_pk_bf16(w1[0] * sw, w1[1] * sw), cvt_pk_bf16(w1[2] * sw, w1[3] * sw)};
#pragma unroll
              for (int e = 0; e < 4; ++e) { const unsigned idv = (m16 == 8 * hh + 2 * e ? 0x3F80u : 0u) | (m16 == 8 * hh + 2 * e + 1 ? 0x3F800000u : 0u); aIlo[e] = lo16 ? idv : 0u; aIhi[e] = lo16 ? 0u : idv; } }
            bf16x8 fa, fb, fc, fi;
            bf16_t* b1 = (bf16_t*)rec + ql + (4 * hh) * 88;
            unsigned char* q0 = rec + RC_B2 + ql * 80 + 32 + 8 * hh;
            __builtin_memcpy(&fa, &aPA, 16); __builtin_memcpy(&fi, &aIhi, 16);
#pragma unroll
            for (int T = 0; T < 2; ++T) {
                f32x16 pa;
#pragma unroll
                for (int r = 0; r < 16; ++r) pa[r] = 0.f;
                __builtin_memcpy(&fb, T ? &kb1 : &kb0, 16); __builtin_memcpy(&fc, T ? &rb1 : &rb0, 16);
                pa = __builtin_amdgcn_mfma_f32_32x32x16_bf16(fa, fb, pa, 0, 0, 0); pa = __builtin_amdgcn_mfma_f32_32x32x16_bf16(fi, fc, pa, 0, 0, 0);
                MFMA_DRAIN(pa);
#pragma unroll
                for (int r = 0; r < 16; ++r) b1[((r & 3) + 8 * (r >> 2)) * 88 + 32 * T] = f2bf(pa[r]);
            }
            __builtin_memcpy(&fa, &aPB, 16); __builtin_memcpy(&fi, &aIlo, 16);
#pragma unroll
            for (int T = 0; T < 2; ++T) {
                f32x16 pb;
#pragma unroll
                for (int r = 0; r < 16; ++r) pb[r] = 0.f;
                __builtin_memcpy(&fb, T ? &bh1 : &bh0, 16); __builtin_memcpy(&fc, T ? &kh1 : &kh0, 16);
                pb = __builtin_amdgcn_mfma_f32_32x32x16_bf16(fa, fb, pb, 0, 0, 0); pb = __builtin_amdgcn_mfma_f32_32x32x16_bf16(fi, fc, pb, 0, 0, 0);
                MFMA_DRAIN(pb);
                *(u32x2*)(q0 + T * 32 * 80) = (u32x2){cvt_pk_bf16(pb[0], pb[1]), cvt_pk_bf16(pb[2], pb[3])}; *(u32x2*)(q0 + T * 32 * 80 + 16) = (u32x2){cvt_pk_bf16(pb[4], pb[5]), cvt_pk_bf16(pb[6], pb[7])};
            }
            { const int tr_ = lane >> 2, part = lane & 3; const f32x4 y4 = *(const LAS f32x4*)(YBT + tr_ * 16 + 4 * part);
              unsigned zz; asm volatile("v_mov_b32 %0, 0" : "=v"(zz));
              *(u32x2*)(rec + tr_ * 176 + 128 + 8 * part) = (u32x2){zz, zz};
              *(u32x2*)(rec + (16 + tr_) * 176 + 128 + 8 * part) = (u32x2){cvt_pk_bf16(y4[0], y4[1]), cvt_pk_bf16(y4[2], y4[3])}; }
            unsigned char* vt = rec + RC_VT + lane * 48;
            *(u32x4*)(vt) = (u32x4){vpk[0], vpk[1], vpk[2], vpk[3]}; *(u32x4*)(vt + 16) = (u32x4){vpk[4], vpk[5], vpk[6], vpk[7]};
            *(float*)(rec + RC_G + 4 * lane) = gC;
        }
        __builtin_amdgcn_wave_barrier();
    }
    __syncthreads();
}

#define SEQ_BAR() asm volatile("s_waitcnt lgkmcnt(0)\n\ts_barrier" ::: "memory")
__device__ __forceinline__ void rwkv_seq_unit(const Ctx& C, int b, int hd) {
    constexpr int NR = 8, PF = 6;
    LAS unsigned char* ring = C.lds; LAS unsigned char* Zi = C.lds + NR * RC_STRIDE; LAS unsigned char* Ui = Zi + 64 * 144;
    const unsigned char* recs = C.ws + WS_RCH + (size_t)(b * 16 + hd) * NCHUNK * RC_STRIDE;
    float* YR = (float*)(C.ws + WS_RW + RW_YRAW) + (size_t)b * LSEQ * 1024 + hd * 64;
    const int tid = C.tid, w = C.wave, lane = C.lane, ql = lane & 31, hh = lane >> 5;
    const int lw = w - 4;
    for (int i = tid; i < 576; i += 512) *(LAS u32x4*)(Zi + 16 * i) = zero4u();
    auto issue = [&](int c) {
        const unsigned char* src = recs + (size_t)c * RC_STRIDE + lane * 16; LAS unsigned char* dst = ring + (c & (NR - 1)) * RC_STRIDE;
#pragma unroll
        for (int k = 0; k < 4; ++k) { const int q = lw + 4 * k; if (q < 14) __builtin_amdgcn_global_load_lds((const unsigned*)(src + q * 1024), (LAS unsigned*)(dst + q * 1024), 16, 0, 0); }
    };
    if (w >= 4) {
#pragma unroll
        for (int c = 0; c < PF; ++c) issue(c);
        if (lw < 2) asm volatile("s_waitcnt vmcnt(20)" ::: "memory"); else asm volatile("s_waitcnt vmcnt(15)" ::: "memory");
    }
    f32x16 Zt;
    { float zf; asm volatile("v_mov_b32 %0, 0" : "=v"(zf));
#pragma unroll
      for (int r = 0; r < 16; ++r) Zt[r] = zf; }
    __syncthreads();
    for (int c = 0; c < NCHUNK; ++c) {
        const LAS unsigned char* rec = ring + (c & (NR - 1)) * RC_STRIDE;
        if (w < 2) {
            f32x16 p;
#pragma unroll
            for (int r = 0; r < 16; ++r) p[r] = 0.f;
            const LAS unsigned char* ap = rec + RC_B1 + ql * 176 + hh * 16; const LAS unsigned char* bp = Zi + (32 * w + ql) * 144 + hh * 16;
#pragma unroll
            for (int s = 0; s < 4; ++s) { const bf16x8 a = *(const LAS bf16x8*)(ap + 32 * s); const bf16x8 bq = *(const LAS bf16x8*)(bp + 32 * s); p = __builtin_amdgcn_mfma_f32_32x32x16_bf16(a, bq, p, 0, 0, 0); }
            { const bf16x8 a = *(const LAS bf16x8*)(ap + 128); const bf16x8 bq = *(const LAS bf16x8*)(rec + RC_VT + (32 * w + ql) * 48 + hh * 16); p = __builtin_amdgcn_mfma_f32_32x32x16_bf16(a, bq, p, 0, 0, 0); }
            MFMA_DRAIN(p);
            LAS unsigned char* up = Ui + (32 * w + ql) * 48 + hh * 8;
            *(LAS u32x2*)up = (u32x2){cvt_pk_bf16(p[0], p[1]), cvt_pk_bf16(p[2], p[3])}; *(LAS u32x2*)(up + 16) = (u32x2){cvt_pk_bf16(p[4], p[5]), cvt_pk_bf16(p[6], p[7])};
            float* yp = YR + (size_t)(16 * c + 4 * hh) * 1024 + 32 * w + ql;
#pragma unroll
            for (int r = 8; r < 16; ++r) yp[((r & 3) + 8 * ((r - 8) >> 2)) * 1024] = p[r];
        } else if (w >= 4) {
            if (c + PF < NCHUNK) issue(c + PF);
        }
        SEQ_BAR();
        if (w < 4) {
            const int ti = w >> 1, tj = w & 1;
            const LAS float* gp = (const LAS float*)(rec + RC_G) + 32 * ti + 4 * hh;
#pragma unroll
            for (int q = 0; q < 4; ++q) { const f32x4 g4 = *(const LAS f32x4*)(gp + 8 * q); Zt[4 * q] *= g4[0]; Zt[4 * q + 1] *= g4[1]; Zt[4 * q + 2] *= g4[2]; Zt[4 * q + 3] *= g4[3]; }
            const LAS unsigned char* ap = rec + RC_B2 + (32 * ti + ql) * 80 + hh * 16;
            const bf16x8 a0 = *(const LAS bf16x8*)ap, a1 = *(const LAS bf16x8*)(ap + 32);
            const bf16x8 b0 = *(const LAS bf16x8*)(Ui + (32 * tj + ql) * 48 + hh * 16), b1 = *(const LAS bf16x8*)(rec + RC_VT + (32 * tj + ql) * 48 + hh * 16);
            Zt = __builtin_amdgcn_mfma_f32_32x32x16_bf16(a0, b0, Zt, 0, 0, 0);
            Zt = __builtin_amdgcn_mfma_f32_32x32x16_bf16(a1, b1, Zt, 0, 0, 0);
            MFMA_DRAIN(Zt);
            LAS unsigned char* zp = Zi + (32 * tj + ql) * 144 + (32 * ti + 4 * hh) * 2;
#pragma unroll
            for (int q = 0; q < 4; ++q) *(LAS u32x2*)(zp + 16 * q) = (u32x2){cvt_pk_bf16(Zt[4 * q], Zt[4 * q + 1]), cvt_pk_bf16(Zt[4 * q + 2], Zt[4 * q + 3])};
        } else {
            if (c + PF < NCHUNK) { if (lw < 2) asm volatile("s_waitcnt vmcnt(20)" ::: "memory"); else asm volatile("s_waitcnt vmcnt(15)" ::: "memory"); }
            else asm volatile("s_waitcnt vmcnt(0)" ::: "memory");
        }
        SEQ_BAR();
    }
}

template <int MODE>
__device__ __forceinline__ void attn_unit(const Ctx& C, int b, int hd, int qblk) {
    constexpr int DQ = MODE == 0 ? 192 : 128, NS = DQ / 16, KP = DQ * 2 + 16, VP = 136;
    constexpr int KB_BYTES = 64 * KP, VB_BYTES = 128 * VP, NKPC = 64 * (DQ / 8) / 512;
    LAS unsigned char* Kb = C.lds; LAS unsigned char* Vbuf = C.lds + 2 * KB_BYTES;
    const bf16_t* P = WSP(bf16_t, WS_P); const bf16_t* Qm = WSP(bf16_t, WS_Q); const bf16_t* KN = WSP(bf16_t, WS_KNOPE); const bf16_t* KRp = WSP(bf16_t, WS_KR);
    const bf16_t* VT = MODE == 0 ? WSP(bf16_t, WS_VTMLA) : WSP(bf16_t, WS_VTRET);
    bf16_t* Y = WSP(bf16_t, WS_YBR) + (MODE == 0 ? 2 : 1) * (size_t)MP * 1024;
    const int tid = C.tid, w = C.wave, lane = C.lane, ql = lane & 31, hh = lane >> 5;
    const size_t rb = (size_t)b * LSEQ;
    const int qpos = 256 * qblk + 32 * w + ql; const bool qvalid = qpos < LSEQ; const int qposc = qvalid ? qpos : LSEQ - 1;
    const int wqmin = 256 * qblk + 32 * w; const bool wactive = wqmin < LSEQ; const int wqmax = (wqmin + 31 < LSEQ - 1) ? wqmin + 31 : LSEQ - 1;
    const int nkt = (4 * qblk + 4 < 65) ? 4 * qblk + 4 : 65;
    const int j0 = MODE == 1 ? 4 * qblk : 0;
    bf16x8 Qf[NS];
    { const bf16_t* qrow = MODE == 0 ? Qm + (rb + qposc) * 1536 + hd * 192 : P + (rb + qposc) * PN + P_QRET + hd * 128;
#pragma unroll
      for (int s = 0; s < NS; ++s) Qf[s] = *(const bf16x8*)(qrow + 16 * s + 8 * hh); }
    if (MODE == 1) {
        const float* rt = WSP(float, WS_ROPE);
        constexpr int NP = MODE == 0 ? 2 : 4, S0 = MODE == 0 ? 8 : 0, DS = MODE == 0 ? 2 : 4;
        const float* cp = MODE == 0 ? rt + (size_t)qposc * 32 + 8 * hh : rt + (size_t)LSEQ * 64 + (size_t)qposc * 64 + 8 * hh;
        const float* sp = MODE == 0 ? rt + (size_t)LSEQ * 32 + (size_t)qposc * 32 + 8 * hh : rt + (size_t)LSEQ * 128 + (size_t)qposc * 64 + 8 * hh;
#pragma unroll
        for (int s = 0; s < NP; ++s) { u32x4 w1, w2; __builtin_memcpy(&w1, &Qf[S0 + s], 16); __builtin_memcpy(&w2, &Qf[S0 + s + DS], 16);
            float x1[8], x2[8], cc[8], ss[8], o1[8], o2[8]; unpack8(w1, x1); unpack8(w2, x2); ld8f(cp + 16 * s, cc); ld8f(sp + 16 * s, ss);
#pragma unroll
            for (int e = 0; e < 8; ++e) { o1[e] = x1[e] * cc[e] - x2[e] * ss[e]; o2[e] = x2[e] * cc[e] + x1[e] * ss[e]; }
            w1 = pack8(o1); w2 = pack8(o2); __builtin_memcpy(&Qf[S0 + s], &w1, 16); __builtin_memcpy(&Qf[S0 + s + DS], &w2, 16); }
    }
    f32x16 O[4];
#pragma unroll
    for (int d = 0; d < 4; ++d)
#pragma unroll
        for (int r = 0; r < 16; ++r) O[d][r] = 0.f;
    float m_run = -INFINITY, lsum = 0.f;
    const float csm = 0.07216878364870322f * 1.4426950408889634f;
    const float lg2g = MODE == 1 ? log1pf(-exp2f(-5.0f - (float)hd)) * 1.4426950408889634f : 0.f;
    u32x4 kreg[NKPC], vreg[2];
    auto gload = [&](int j) {
#pragma unroll
        for (int i = 0; i < NKPC; ++i) { const int pi = tid + i * 512, r = pi / (DQ / 8), c = pi % (DQ / 8); const size_t krow = rb + 64 * j + r;
            const bf16_t* sp;
            if (MODE == 0) sp = (c < 16) ? KN + krow * 1024 + hd * 128 + 8 * c : KRp + krow * 64 + 8 * (c - 16);
            else sp = P + krow * PN + P_KRET + hd * 128 + 8 * c;
            kreg[i] = *(const u32x4*)sp; }
#pragma unroll
        for (int i = 0; i < 2; ++i) { const int pi = tid + i * 512, dv = pi >> 3, c = pi & 7; vreg[i] = *(const u32x4*)(VT + (size_t)(hd * 128 + dv) * MP + rb + 64 * j + 8 * c); }
    };
    auto lstore = [&](int buf) {
#pragma unroll
        for (int i = 0; i < NKPC; ++i) { const int pi = tid + i * 512, r = pi / (DQ / 8), c = pi % (DQ / 8); *(LAS u32x4*)(Kb + buf * KB_BYTES + r * KP + 16 * c) = kreg[i]; }
#pragma unroll
        for (int i = 0; i < 2; ++i) { const int pi = tid + i * 512, dv = pi >> 3, c = pi & 7; LAS unsigned char* dp = Vbuf + buf * VB_BYTES + dv * VP + 16 * c;
            *(LAS u32x2*)dp = (u32x2){vreg[i].x, vreg[i].y}; *(LAS u32x2*)(dp + 8) = (u32x2){vreg[i].z, vreg[i].w}; }
    };
    gload(j0);
    if (MODE == 1 && qblk > 0) {
        constexpr int RP = 272; LAS unsigned char* RT = C.lds + 2 * KB_BYTES + 2 * VB_BYTES;
        const float* KVT = WSP(float, WS_KVT) + (size_t)((b * 8 + hd) * 16) * 16384;
        const int dvr = tid >> 2, d0 = (tid & 3) * 32;
        f32x4 acc8[8];
#pragma unroll
        for (int i = 0; i < 8; ++i) acc8[i] = (f32x4){0.f, 0.f, 0.f, 0.f};
#pragma unroll 2
        for (int kp = 0; kp < qblk; ++kp) { const float f = __builtin_amdgcn_exp2f(lg2g * 256.0f * (float)(qblk - 1 - kp)); const float* sp = KVT + (size_t)kp * 16384 + dvr * 128 + d0;
#pragma unroll
            for (int i = 0; i < 8; ++i) acc8[i] = acc8[i] + *(const f32x4*)(sp + 4 * i) * f; }
#pragma unroll
        for (int i = 0; i < 4; ++i) { u32x4 wv; wv.x = cvt_pk_bf16(acc8[2 * i][0], acc8[2 * i][1]); wv.y = cvt_pk_bf16(acc8[2 * i][2], acc8[2 * i][3]); wv.z = cvt_pk_bf16(acc8[2 * i + 1][0], acc8[2 * i + 1][1]); wv.w = cvt_pk_bf16(acc8[2 * i + 1][2], acc8[2 * i + 1][3]);
            *(LAS u32x4*)(RT + dvr * RP + (d0 + 8 * i) * 2) = wv; }
        __syncthreads();
        if (wactive) {
#pragma unroll
            for (int d = 0; d < 4; ++d)
#pragma unroll
                for (int s = 0; s < NS; ++s) { const bf16x8 a = *(const LAS bf16x8*)(RT + (32 * d + ql) * RP + (16 * s + 8 * hh) * 2); O[d] = __builtin_amdgcn_mfma_f32_32x32x16_bf16(a, Qf[s], O[d], 0, 0, 0); }
            const float fq = __builtin_amdgcn_exp2f(lg2g * (float)(qposc - 256 * qblk + 1));
#pragma unroll
            for (int d = 0; d < 4; ++d)
#pragma unroll
                for (int r = 0; r < 16; ++r) O[d][r] *= fq;
        }
    }
    lstore(0);
    __syncthreads();
    for (int j = j0; j < nkt; ++j) {
        if (j + 1 < nkt) gload(j + 1);
        if (wactive && 64 * j <= wqmax) {
            const LAS unsigned char* kb = Kb + ((j - j0) & 1) * KB_BYTES; const LAS unsigned char* vb = Vbuf + ((j - j0) & 1) * VB_BYTES;
            f32x16 st[2];
#pragma unroll
            for (int kt = 0; kt < 2; ++kt) {
#pragma unroll
                for (int r = 0; r < 16; ++r) st[kt][r] = 0.f;
#pragma unroll
                for (int s = 0; s < NS; ++s) { const bf16x8 a = *(const LAS bf16x8*)(kb + (32 * kt + ql) * KP + (16 * s + 8 * hh) * 2); st[kt] = __builtin_amdgcn_mfma_f32_32x32x16_bf16(a, Qf[s], st[kt], 0, 0, 0); }
            }
            const int kbase = 64 * j + 4 * hh;
            if (MODE == 0) {
                if (64 * j + 63 > wqmin) {
#pragma unroll
                    for (int kt = 0; kt < 2; ++kt)
#pragma unroll
                        for (int r = 0; r < 16; ++r) { const int kpos = kbase + 32 * kt + (r & 3) + 8 * (r >> 2); if (kpos > qposc) st[kt][r] = -INFINITY; }
                }
                float tm0 = fmaxf(st[0][0], st[1][0]), tm1 = fmaxf(st[0][1], st[1][1]);
#pragma unroll
                for (int r = 2; r < 16; r += 2) { tm0 = fmaxf(tm0, fmaxf(st[0][r], st[1][r])); tm1 = fmaxf(tm1, fmaxf(st[0][r + 1], st[1][r + 1])); }
                const float tmax = hmax32(fmaxf(tm0, tm1));
                if (__builtin_amdgcn_ballot_w64(tmax > m_run) != 0ull) {
                    const float m_new = fmaxf(m_run, tmax);
                    const float alpha = __builtin_amdgcn_exp2f((m_run - m_new) * csm);
                    m_run = m_new; lsum *= alpha;
#pragma unroll
                    for (int d = 0; d < 4; ++d)
#pragma unroll
                        for (int r = 0; r < 16; ++r) O[d][r] *= alpha;
                }
                const float mb = m_run * csm;
                float ps = 0.f;
#pragma unroll
                for (int kt = 0; kt < 2; ++kt)
#pragma unroll
                    for (int r = 0; r < 16; ++r) { const float p = __builtin_amdgcn_exp2f(st[kt][r] * csm - mb); st[kt][r] = p; ps += p; }
                lsum += ps;
            } else {
#pragma unroll
                for (int kt = 0; kt < 2; ++kt)
#pragma unroll
                    for (int r = 0; r < 16; ++r) { const int kpos = kbase + 32 * kt + (r & 3) + 8 * (r >> 2); const int dd = qposc - kpos;
                        st[kt][r] = dd >= 0 ? st[kt][r] * __builtin_amdgcn_exp2f(lg2g * (float)dd) : 0.f; }
            }
#pragma unroll
            for (int kt = 0; kt < 2; ++kt)
#pragma unroll
                for (int s2 = 0; s2 < 2; ++s2) {
                    u32x4 pw; pw.x = cvt_pk_bf16(st[kt][8 * s2 + 0], st[kt][8 * s2 + 1]); pw.y = cvt_pk_bf16(st[kt][8 * s2 + 2], st[kt][8 * s2 + 3]);
                    pw.z = cvt_pk_bf16(st[kt][8 * s2 + 4], st[kt][8 * s2 + 5]); pw.w = cvt_pk_bf16(st[kt][8 * s2 + 6], st[kt][8 * s2 + 7]);
                    bf16x8 pf; __builtin_memcpy(&pf, &pw, 16);
#pragma unroll
                    for (int d = 0; d < 4; ++d) { const LAS unsigned char* ap = vb + (32 * d + ql) * VP + (32 * kt + 16 * s2 + 4 * hh) * 2;
                        const u32x2 lo = *(const LAS u32x2*)ap, hi = *(const LAS u32x2*)(ap + 16); u32x4 aw = (u32x4){lo.x, lo.y, hi.x, hi.y}; bf16x8 af; __builtin_memcpy(&af, &aw, 16);
                        O[d] = __builtin_amdgcn_mfma_f32_32x32x16_bf16(af, pf, O[d], 0, 0, 0); }
                }
        }
        if (j + 1 < nkt) lstore((j + 1 - j0) & 1);
        __syncthreads();
    }
    if (MODE == 0) {
        const float lt = hsum32(lsum); const float inv = 1.0f / lt;
        if (qvalid) { bf16_t* yp = Y + (rb + qpos) * 1024 + hd * 128;
#pragma unroll
            for (int d = 0; d < 4; ++d)
#pragma unroll
                for (int rg = 0; rg < 4; ++rg) { const int dv0 = 32 * d + 8 * rg + 4 * hh;
                    *(u32x2*)(yp + dv0) = (u32x2){cvt_pk_bf16(O[d][4 * rg] * inv, O[d][4 * rg + 1] * inv), cvt_pk_bf16(O[d][4 * rg + 2] * inv, O[d][4 * rg + 3] * inv)}; } }
    } else {
        u32x2 gws[4][4];
        { const bf16_t* gp = P + (rb + qposc) * PN + P_GRET + hd * 128 + 4 * hh;
#pragma unroll
          for (int d = 0; d < 4; ++d)
#pragma unroll
              for (int rg = 0; rg < 4; ++rg) gws[d][rg] = *(const u32x2*)(gp + 32 * d + 8 * rg); }
        float ss = 0.f;
#pragma unroll
        for (int d = 0; d < 4; ++d)
#pragma unroll
            for (int r = 0; r < 16; ++r) ss += O[d][r] * O[d][r];
        ss = hsum32(ss); const float rstd = rsqrtf(ss * (1.0f / 128.0f) + NORM_EPS);
        if (qvalid) { bf16_t* yp = Y + (rb + qpos) * 1024 + hd * 128;
#pragma unroll
            for (int d = 0; d < 4; ++d)
#pragma unroll
                for (int rg = 0; rg < 4; ++rg) { const int dv0 = 32 * d + 8 * rg + 4 * hh; const u32x2 gw = gws[d][rg];
                    const float g0 = bflo(gw.x), g1 = bfhi(gw.x), g2 = bflo(gw.y), g3 = bfhi(gw.y);
                    const float o0 = O[d][4 * rg] * rstd * g0 * sigmoidf_(g0), o1 = O[d][4 * rg + 1] * rstd * g1 * sigmoidf_(g1), o2 = O[d][4 * rg + 2] * rstd * g2 * sigmoidf_(g2), o3 = O[d][4 * rg + 3] * rstd * g3 * sigmoidf_(g3);
                    *(u32x2*)(yp + dv0) = (u32x2){cvt_pk_bf16(o0, o1), cvt_pk_bf16(o2, o3)}; } }
    }
}

__device__ __forceinline__ void ph_retkv(const Ctx& C) {
    constexpr int VP = 136, TB = 128 * VP;
    LAS unsigned char* Vb = C.lds; LAS unsigned char* Kt = C.lds + TB;
    const bf16_t* P = WSP(bf16_t, WS_P); const bf16_t* VT = WSP(bf16_t, WS_VTRET); float* KVT = WSP(float, WS_KVT);
    const int tid = C.tid, w = C.wave, lane = C.lane, ql = lane & 31, hh = lane >> 5;
    for (int u = C.wg; u < NB * 8 * 16; u += C.G) {
        const int b = u >> 7, hd = (u >> 4) & 7, kb = u & 15; const size_t rb = (size_t)b * LSEQ + 256 * kb;
        const float lg2g = log1pf(-exp2f(-5.0f - (float)hd)) * 1.4426950408889634f;
        f32x16 acc[2];
#pragma unroll
        for (int r = 0; r < 16; ++r) { acc[0][r] = 0.f; acc[1][r] = 0.f; }
        for (int j = 0; j < 4; ++j) {
            __syncthreads();
#pragma unroll
            for (int i = 0; i < 2; ++i) { const int pi = tid + i * 512;
                { const int dv = pi >> 3, c = pi & 7; const u32x4 v = *(const u32x4*)(VT + (size_t)(hd * 128 + dv) * MP + rb + 64 * j + 8 * c); LAS unsigned char* dp = Vb + dv * VP + 16 * c;
                  *(LAS u32x2*)dp = (u32x2){v.x, v.y}; *(LAS u32x2*)(dp + 8) = (u32x2){v.z, v.w}; }
                { const int key = pi >> 4, c = pi & 15; float x[8]; unpack8(*(const u32x4*)(P + (rb + 64 * j + key) * PN + P_KRET + hd * 128 + 8 * c), x);
                  const float f = __builtin_amdgcn_exp2f(lg2g * (float)(255 - 64 * j - key));
#pragma unroll
                  for (int e = 0; e < 8; ++e) *(LAS bf16_t*)(Kt + (8 * c + e) * VP + key * 2) = f2bf(x[e] * f); } }
            __syncthreads();
#pragma unroll
            for (int s = 0; s < 4; ++s) {
                const LAS unsigned char* ap = Vb + (32 * (w >> 1) + ql) * VP + (16 * s + 8 * hh) * 2; const u32x2 alo = *(const LAS u32x2*)ap, ahi = *(const LAS u32x2*)(ap + 8);
                u32x4 aw = (u32x4){alo.x, alo.y, ahi.x, ahi.y}; bf16x8 af; __builtin_memcpy(&af, &aw, 16);
#pragma unroll
                for (int t = 0; t < 2; ++t) { const LAS unsigned char* bp = Kt + (32 * (2 * (w & 1) + t) + ql) * VP + (16 * s + 8 * hh) * 2; const u32x2 blo = *(const LAS u32x2*)bp, bhi = *(const LAS u32x2*)(bp + 8);
                    u32x4 bw = (u32x4){blo.x, blo.y, bhi.x, bhi.y}; bf16x8 bf; __builtin_memcpy(&bf, &bw, 16);
                    acc[t] = __builtin_amdgcn_mfma_f32_32x32x16_bf16(af, bf, acc[t], 0, 0, 0); }
            }
        }
        float* op = KVT + (size_t)u * 16384;
#pragma unroll
        for (int t = 0; t < 2; ++t)
#pragma unroll
            for (int r = 0; r < 16; ++r) { const int dv = 32 * (w >> 1) + (r & 3) + 8 * (r >> 2) + 4 * hh; op[dv * 128 + 32 * (2 * (w & 1) + t) + ql] = acc[t][r]; }
    }
    __syncthreads();
}

__device__ __forceinline__ int q_pop(const Ctx& C, unsigned* head) {
    volatile LAS int* item = (volatile LAS int*)(C.lds + LDS_MISC + 64);
    __syncthreads();
    if (C.tid == 0) *item = (int)__hip_atomic_fetch_add(head, 1u, __ATOMIC_RELAXED, __HIP_MEMORY_SCOPE_AGENT);
    __syncthreads();
    return *item;
}
__device__ __forceinline__ void ph_mix(const Ctx& C, int l) {
    unsigned* head = C.ctl + CW_QUEUE + 256 * l;
    for (;;) { const int it = q_pop(C, head); if (it >= 64) break; rwkv_seq_unit(C, it >> 4, it & 15); }
    for (;;) { const int it = q_pop(C, head + 128); if (it >= 17 * 32) break; attn_unit<1>(C, (it & 31) >> 3, it & 7, 16 - (it >> 5)); }
    for (;;) { const int it = q_pop(C, head + 64); if (it >= 17 * 32) break; attn_unit<0>(C, (it & 31) >> 3, it & 7, 16 - (it >> 5)); }
}

constexpr int MMAIN = 16384;
template <int KIND>
__device__ __forceinline__ void tail_units(const Ctx& C, const bf16_t* A, const bf16_t* Bt, const int K, const int nunits, bf16_t* Hb, bf16_t* Ob, const bf16_t* P) {
    constexpr int NB = KIND == 1 ? 2 : 1, NBR = KIND == 2 ? 3 : 1;
    const int ql = C.lane & 31, hh = C.lane >> 5, w = C.wave; const int KS = K / 8;
    LAS float* red = (LAS float*)C.lds;
    for (int t = C.wg; t < nunits; t += C.G) {
        float tot[4] = {0.f, 0.f, 0.f, 0.f};
        for (int br = 0; br < NBR; ++br) {
        f32x16 acc[NB][2];
#pragma unroll
        for (int q = 0; q < NB; ++q)
#pragma unroll
            for (int r = 0; r < 16; ++r) { acc[q][0][r] = 0.f; acc[q][1][r] = 0.f; }
        const bf16_t* Au = (KIND == 2) ? A + (size_t)br * MP * 1024 : A;
        const bf16_t* a0 = Au + (size_t)(MMAIN + ql) * K + w * KS + 8 * hh;
        const bf16_t* bp[NB];
        if (KIND == 1) { const int j = 32 * t + ql; const int grow = 8 * (j >> 2) + (j & 3); bp[0] = Bt + (size_t)grow * K + w * KS + 8 * hh; bp[NB - 1] = Bt + (size_t)(grow + 4) * K + w * KS + 8 * hh; }
        else bp[0] = Bt + (size_t)(br * 2048 + 32 * t + ql) * K + w * KS + 8 * hh;
        for (int k = 0; k < KS; k += 64) { bf16x8 af0[4], af1[4], bfr[NB][4];
#pragma unroll
            for (int u = 0; u < 4; ++u) { af0[u] = *(const bf16x8*)(a0 + k + 16 * u); af1[u] = *(const bf16x8*)(a0 + (size_t)32 * K + k + 16 * u);
#pragma unroll
                for (int q = 0; q < NB; ++q) bfr[q][u] = *(const bf16x8*)(bp[q] + k + 16 * u); }
#pragma unroll
            for (int u = 0; u < 4; ++u)
#pragma unroll
                for (int q = 0; q < NB; ++q) { acc[q][0] = __builtin_amdgcn_mfma_f32_32x32x16_bf16(af0[u], bfr[q][u], acc[q][0], 0, 0, 0); acc[q][1] = __builtin_amdgcn_mfma_f32_32x32x16_bf16(af1[u], bfr[q][u], acc[q][1], 0, 0, 0); } }
        __syncthreads();
#pragma unroll
        for (int q = 0; q < NB; ++q)
#pragma unroll
            for (int hf = 0; hf < 2; ++hf)
#pragma unroll
                for (int r = 0; r < 16; ++r) red[((q * 8 + w) * 32 + hf * 16 + r) * 64 + C.lane] = acc[q][hf][r];
        __syncthreads();
#pragma unroll
        for (int i = 0; i < 4; ++i) { const int hr = 4 * w + i, hf = hr >> 4, r = hr & 15; float s0 = 0.f, s1 = 0.f;
#pragma unroll
            for (int ww = 0; ww < 8; ++ww) { s0 += red[(ww * 32 + hr) * 64 + C.lane]; if (NB == 2) s1 += red[((8 + ww) * 32 + hr) * 64 + C.lane]; }
            const int row = MMAIN + 32 * hf + (r & 3) + 8 * (r >> 2) + 4 * hh; const int c = 32 * t + ql;
            if (KIND == 0) { bf16_t* p = Hb + (size_t)row * DM + c; *p = f2bf(bf2f(*p) + s0); }
            else if (KIND == 1) Ob[(size_t)row * FFN + c] = f2bf(s0 * sigmoidf_(s0) * s1);
            else { tot[i] += s0 * sigmoidf_(bf2f(P[(size_t)row * PN + P_GATES + br * 2048 + c])); if (br == NBR - 1) Ob[(size_t)row * DM + c] = f2bf(tot[i]); } }
        }
    }
    __syncthreads();
}
#define T16_STEP(NS, k) do { bf16x8 a_[NS], b0_[NS], b1_[NS]; \
        _Pragma("unroll") for (int s_ = 0; s_ < NS; ++s_) { a_[s_] = *(const bf16x8*)(ap + (k) + 32 * s_); b0_[s_] = *(const bf16x8*)(bp + (k) + 32 * s_); b1_[s_] = *(const bf16x8*)(bp + (size_t)16 * K + (k) + 32 * s_); } \
        _Pragma("unroll") for (int s_ = 0; s_ < NS; ++s_) { acc0 = __builtin_amdgcn_mfma_f32_16x16x32_bf16(a_[s_], b0_[s_], acc0, 0, 0, 0); acc1 = __builtin_amdgcn_mfma_f32_16x16x32_bf16(a_[s_], b1_[s_], acc1, 0, 0, 0); } } while (0)
template <int KIND>
__device__ __forceinline__ void tail16(const Ctx& C, const bf16_t* A, const bf16_t* Bt, const int K, bf16_t* Hb, bf16_t* Ob, const bf16_t* P) {
    constexpr int NBR = KIND == 2 ? 3 : 1;
    const int r = C.lane & 15, kq = C.lane >> 4, w = C.wave; const int KS = K / 8;
    LAS float* red = (LAS float*)C.lds;
    for (int un = C.wg; un < 256; un += C.G) {
        const int rg = (un >> 3) & 3, t = (un & 7) + 8 * (un >> 5);
        float tot = 0.f;
        for (int br = 0; br < NBR; ++br) {
            f32x4 acc0 = {0.f, 0.f, 0.f, 0.f}, acc1 = {0.f, 0.f, 0.f, 0.f};
            const bf16_t* Au = (KIND == 2) ? A + (size_t)br * MP * 1024 : A;
            const bf16_t* ap = Au + (size_t)(MMAIN + 16 * rg + r) * K + w * KS + 8 * kq;
            const bf16_t* bp = Bt + (size_t)(br * 2048 + 32 * t + r) * K + w * KS + 8 * kq;
            int k = 0;
            for (; k + 128 <= KS; k += 128) T16_STEP(4, k);
            for (; k < KS; k += 64) T16_STEP(2, k);
            __syncthreads();
#pragma unroll
            for (int j = 0; j < 4; ++j) { red[(w * 8 + j) * 64 + C.lane] = acc0[j]; red[(w * 8 + 4 + j) * 64 + C.lane] = acc1[j]; }
            __syncthreads();
            float s = 0.f;
#pragma unroll
            for (int ww = 0; ww < 8; ++ww) s += red[(ww * 8 + w) * 64 + C.lane];
            const int row = MMAIN + 16 * rg + 4 * kq + (w & 3), c = 32 * t + 16 * (w >> 2) + r;
            if (KIND == 0) { bf16_t* p = Hb + (size_t)row * DM + c; *p = f2bf(bf2f(*p) + s); }
            else { tot += s * sigmoidf_(bf2f(P[(size_t)row * PN + P_GATES + br * 2048 + c])); if (br == NBR - 1) Ob[(size_t)row * DM + c] = f2bf(tot); }
        }
    }
    __syncthreads();
}
#undef T16_STEP
__device__ __forceinline__ void ph_sum3(const Ctx& C) {
    const bf16_t* GT = WSP(bf16_t, WS_RW); bf16_t* MG = WSP(bf16_t, WS_U);
    for (int row = C.wg * 8 + C.wave; row < M; row += C.G * 8) {
        const bf16_t* gp = GT + (size_t)row * 6144;
#pragma unroll
        for (int i = 0; i < 4; ++i) { const int c = (i * 64 + C.lane) * 8; float a[8], b[8], d[8];
            unpack8(*(const u32x4*)(gp + c), a); unpack8(*(const u32x4*)(gp + 2048 + c), b); unpack8(*(const u32x4*)(gp + 4096 + c), d);
#pragma unroll
            for (int e = 0; e < 8; ++e) a[e] = a[e] + b[e] + d[e];
            *(u32x4*)(MG + (size_t)row * DM + c) = pack8(a); }
    }
}

constexpr int NSTEP_LAYER = 13, STEP_FINAL = 1 + DEPTH * NSTEP_LAYER, NSTEPS = STEP_FINAL + 1;
__device__ __forceinline__ Ctx mkctx(const Args& args, LAS unsigned char* lds, int wave_s) {
    Ctx C; GAS unsigned char* wsg = (GAS unsigned char*)args.ws; asm volatile("" : "+s"(wsg)); unsigned char* ws = (unsigned char*)wsg; int wv = wave_s; asm volatile("" : "+s"(wv));
    int lane; asm volatile("v_mbcnt_lo_u32_b32 %0, -1, 0\n\tv_mbcnt_hi_u32_b32 %0, -1, %0" : "=v"(lane));
    C.out = (float*)(GAS float*)args.out; C.ws = ws; C.lds = lds; C.ctl = (unsigned*)(ws + WS_CTL);
    C.tid = wv * 64 + lane; C.lane = lane; C.wave = wv; C.G = gridDim.x; C.wg = blockIdx.x;
    return C;
}
__global__ void __launch_bounds__(512, 2) trunk_fwd(Args args) {
    extern __shared__ __attribute__((aligned(16))) unsigned char lds_raw[];
    LAS unsigned char* lds = (LAS unsigned char*)lds_raw;
    volatile LAS unsigned* misc = (volatile LAS unsigned*)(lds + LDS_MISC);
    if (threadIdx.x < 32) misc[threadIdx.x] = 0u;
    if (threadIdx.x == 0) { volatile LAS unsigned long long* tb = (volatile LAS unsigned long long*)(lds + LDS_INTBL);
#pragma unroll
        for (int i = 0; i < 27; ++i) tb[i] = (unsigned long long)args.in[i]; }
    __syncthreads();
    const int s_lo = args.s_lo, s_hi = args.s_hi;
    const int wave_s = __builtin_amdgcn_readfirstlane(threadIdx.x >> 6);
    unsigned* const barw = (unsigned*)(args.ws + WS_CTL) + CW_BAR + args.bar_idx * XCD_BAR_WORDS;
    XcdBarrier bar; bar.bar = barw; bar.x = 0; bar.st = misc;
    if (s_hi - s_lo > 1) bar = xcd_barrier_post(barw, misc);
#ifndef PMASK
#define PMASK 0xFFFFF
#endif
#define RUN(k, s) (((PMASK >> (k)) & 1) && (s) >= s_lo && (s) < s_hi)
#define SEAM(s) do { if ((s) >= s_lo && (s) + 1 < s_hi) { GAS unsigned* bw_ = (GAS unsigned*)barw; asm volatile("" : "+s"(bw_)); bar.bar = (unsigned*)bw_; int ln_; asm volatile("v_mbcnt_lo_u32_b32 %0, -1, 0\n\tv_mbcnt_hi_u32_b32 %0, -1, %0" : "=v"(ln_)); xcd_barrier(bar, wave_s == 0 && ln_ == 0); } } while (0)
    using namespace pg8;
    if (RUN(14, 0)) { const Ctx C = mkctx(args, lds, wave_s); ph_rope_tables(C); } SEAM(0);
    for (int l = 0; l < DEPTH; ++l) {
        const int sb = 1 + l * NSTEP_LAYER;
        if (RUN(0, sb + 0)) { const Ctx C = mkctx(args, lds, wave_s); ph_conv(C, l); if (l == 0) ph_norm<true>(C); else ph_norm<false>(C); } SEAM(sb + 0);
        if (RUN(1, sb + 1)) { const Ctx C = mkctx(args, lds, wave_s); Gemm g{WSP(bf16_t, WS_U), WSP(bf16_t, WS_WIN), MP, PN, DM, 0, 0}; StaticOrder S; S.init(MP, PN, C.G, C.wg);
            EpiBf16Plain E{WSP(bf16_t, WS_P), PN}; gemm_phase<EpiBf16Plain, StaticOrder, true, true>(lds, g, S, E, C.tid); }
        if (RUN(1, sb + 1)) { const Ctx C = mkctx(args, lds, wave_s); Gemm g{WSP(bf16_t, WS_WVRET), WSP(bf16_t, WS_U), 1024, MP, DM, 0, 0}; StaticOrder S; S.init(1024, MP, C.G, (C.wg + 121) % C.G);
            EpiBf16Plain E{WSP(bf16_t, WS_VTRET), MP}; gemm_phase<EpiBf16Plain, StaticOrder, true, true>(lds, g, S, E, C.tid); }
        if (RUN(1, sb + 1)) { Ctx C = mkctx(args, lds, wave_s);
            int idx = C.wg, cnt = C.G;
            if (C.G == 256) { const bool idle = C.wg >= 117 && !(C.wg >= 135 && C.wg <= 138); idx = idle ? C.wg - 117 - (C.wg > 138 ? 4 : 0) : -1; cnt = 135; }
            if (idx >= 0) { C.wg = idx; C.G = cnt; __syncthreads(); ph_convB(C, l); } }
        SEAM(sb + 1);
        if (RUN(2, sb + 2)) { const Ctx C = mkctx(args, lds, wave_s); ph_prepA(C, l); } SEAM(sb + 2);
        if (RUN(3, sb + 3)) { const Ctx C = mkctx(args, lds, wave_s);
            unsigned char* rw = C.ws + WS_RW;
            { Gemm g{WSP(bf16_t, WS_XL), WSP(bf16_t, WS_WLORA), MP, LORA_N, LORA_K, 0, 0}; StaticOrder S; S.init(MP, LORA_N, C.G, C.wg);
              EpiLora E{(float*)(rw + RW_WDEC), (bf16_t*)(rw + RW_A), (bf16_t*)(rw + RW_A + RW_ARR), inp(C, IN_W0) + l * 1024, inp(C, IN_A0) + l * 1024}; gemm_phase<EpiLora, StaticOrder, true, true>(lds, g, S, E, C.tid); }
        }
        if (RUN(3, sb + 3)) { const Ctx C = mkctx(args, lds, wave_s); Gemm g{WSP(bf16_t, WS_QN), WSP(bf16_t, WS_WUQ), MP, 1536, 512, 0, 0}; StaticOrder S; S.init(MP, 1536, C.G, (C.wg + 140) % C.G);
            EpiBf16Plain E{WSP(bf16_t, WS_Q), 1536}; gemm_phase<EpiBf16Plain, StaticOrder, true, true>(lds, g, S, E, C.tid); }
        if (RUN(3, sb + 3)) { const Ctx C = mkctx(args, lds, wave_s); Gemm g{WSP(bf16_t, WS_KVN), WSP(bf16_t, WS_WUK), MP, 1024, 256, 0, 0}; StaticOrder S; S.init(MP, 1024, C.G, (C.wg + 236) % C.G);
            EpiBf16Plain E{WSP(bf16_t, WS_KNOPE), 1024}; gemm_phase<EpiBf16Plain, StaticOrder, true, true>(lds, g, S, E, C.tid); }
        if (RUN(3, sb + 3)) { const Ctx C = mkctx(args, lds, wave_s); Gemm g{WSP(bf16_t, WS_WUV), WSP(bf16_t, WS_KVN), 1024, MP, 256, 0, 0}; StaticOrder S; S.init(1024, MP, C.G, (C.wg + 232) % C.G);
            EpiBf16Plain E{WSP(bf16_t, WS_VTMLA), MP}; gemm_phase<EpiBf16Plain, StaticOrder, true, true>(lds, g, S, E, C.tid); }
        SEAM(sb + 3);
        if (RUN(5, sb + 5)) { const Ctx C = mkctx(args, lds, wave_s); ph_qrope(C); }
        if (RUN(5, sb + 5)) { const Ctx C = mkctx(args, lds, wave_s); ph_retkv(C); }
        if (RUN(5, sb + 5)) { const Ctx C = mkctx(args, lds, wave_s); ph_rwkvpre(C, l); } SEAM(sb + 5);
        if (RUN(6, sb + 6)) { const Ctx C = mkctx(args, lds, wave_s); ph_mix(C, l); } SEAM(sb + 6);
        if (RUN(7, sb + 7)) { const Ctx C = mkctx(args, lds, wave_s); ph_post(C, l); } SEAM(sb + 7);
        if (RUN(8, sb + 8)) { const Ctx C = mkctx(args, lds, wave_s); Gemm g{WSP(bf16_t, WS_YBR), WSP(bf16_t, WS_WBR), MMAIN, 6144, 1024, 8, (size_t)MP * 1024 * 2}; BranchOrder S; S.base.init(MMAIN, DM, C.G, C.wg);
            EpiGate E{WSP(bf16_t, WS_U), WSP(bf16_t, WS_P)}; gemm_phase<EpiGate, BranchOrder, true, true>(lds, g, S, E, C.tid); }
        if (RUN(8, sb + 8)) { const Ctx C = mkctx(args, lds, wave_s); tail16<2>(C, WSP(bf16_t, WS_YBR), WSP(bf16_t, WS_WBR), 1024, nullptr, WSP(bf16_t, WS_U), WSP(bf16_t, WS_P)); }
        SEAM(sb + 8);
        if (RUN(9, sb + 9)) { const Ctx C = mkctx(args, lds, wave_s); Gemm g{WSP(bf16_t, WS_U), WSP(bf16_t, WS_WOUT), MMAIN, DM, DM, 0, 0}; StaticOrder S; S.init(MMAIN, DM, C.G, C.wg);
            EpiResid E{WSP(bf16_t, WS_H)}; gemm_phase<EpiResid, StaticOrder, true, true>(lds, g, S, E, C.tid); }
        if (RUN(9, sb + 9)) { const Ctx C = mkctx(args, lds, wave_s); tail16<0>(C, WSP(bf16_t, WS_U), WSP(bf16_t, WS_WOUT), DM, WSP(bf16_t, WS_H), nullptr, nullptr); }
        SEAM(sb + 9);
        if (RUN(10, sb + 10)) { const Ctx C = mkctx(args, lds, wave_s); ph_norm<false>(C); } SEAM(sb + 10);
        if (RUN(11, sb + 11)) { const Ctx C = mkctx(args, lds, wave_s); Gemm g{WSP(bf16_t, WS_U), WSP(bf16_t, WS_WGU), MMAIN, 2 * FFN, DM, 0, 0}; StaticOrder S; S.init(MMAIN, 2 * FFN, C.G, C.wg);
            EpiSwiglu E{WSP(bf16_t, WS_P)}; gemm_phase<EpiSwiglu, StaticOrder, true, true>(lds, g, S, E, C.tid); }
        if (RUN(11, sb + 11)) { const Ctx C = mkctx(args, lds, wave_s); tail_units<1>(C, WSP(bf16_t, WS_U), WSP(bf16_t, WS_WGU), DM, FFN / 32, nullptr, WSP(bf16_t, WS_P), nullptr); }
        SEAM(sb + 11);
        if (RUN(12, sb + 12)) { const Ctx C = mkctx(args, lds, wave_s); Gemm g{WSP(bf16_t, WS_P), WSP(bf16_t, WS_WD), MMAIN, DM, FFN, 0, 0}; StaticOrder S; S.init(MMAIN, DM, C.G, C.wg);
            EpiResid E{WSP(bf16_t, WS_H)}; gemm_phase<EpiResid, StaticOrder, true, true>(lds, g, S, E, C.tid); }
        if (RUN(12, sb + 12)) { const Ctx C = mkctx(args, lds, wave_s); tail16<0>(C, WSP(bf16_t, WS_P), WSP(bf16_t, WS_WD), FFN, WSP(bf16_t, WS_H), nullptr, nullptr); }
        SEAM(sb + 12);
    }
    if (RUN(15, STEP_FINAL)) { const Ctx C = mkctx(args, lds, wave_s); ph_final(C); }
#undef RUN
#undef SEAM
}

extern "C" void kernel_launch(void* const* d_in, const int* in_sizes, int n_in, void* d_out, int out_size, void* d_ws, size_t ws_size, hipStream_t stream) {
    static int grid = 0;
    if (grid == 0) {
        if (n_in != 27 || ws_size < WS_END) { fprintf(stderr, "kernel_launch: unexpected n_in %d or ws_size %zu (< %zu)\n", n_in, ws_size, (size_t)WS_END); grid = -1; return; }
        int dev = 0, cus = 0, per_cu = 0;
        if (hipGetDevice(&dev) != hipSuccess || hipDeviceGetAttribute(&cus, hipDeviceAttributeMultiprocessorCount, dev) != hipSuccess) { grid = -1; return; }
        if (hipFuncSetAttribute((const void*)trunk_fwd, hipFuncAttributeMaxDynamicSharedMemorySize, LDS_BYTES) != hipSuccess) { fprintf(stderr, "kernel_launch: hipFuncSetAttribute failed\n"); grid = -1; return; }
        if (hipOccupancyMaxActiveBlocksPerMultiprocessor(&per_cu, (const void*)trunk_fwd, 512, LDS_BYTES) != hipSuccess || per_cu < 1) { fprintf(stderr, "kernel_launch: occupancy query says %d\n", per_cu); }
        (void)hipGetLastError();
        grid = cus;
    }
    if (grid < 0) return;
    (void)hipMemsetAsync((char*)d_ws + WS_CTL, 0, CTL_ZERO_BYTES, stream);
    Args a{};
    for (int i = 0; i < 27; ++i) a.in[i] = (const float*)d_in[i];
    a.out = (float*)d_out; a.ws = (unsigned char*)d_ws; a.pad = 0;
#if N_LAUNCH_MODE == 1
    a.s_lo = 0; a.s_hi = NSTEPS; a.bar_idx = 0;
    hipLaunchKernelGGL(trunk_fwd, dim3(grid), dim3(512), LDS_BYTES, stream, a);
#else
    for (int s = 0; s < NSTEPS; ++s) { a.s_lo = s; a.s_hi = s + 1; a.bar_idx = 0; hipLaunchKernelGGL(trunk_fwd, dim3(grid), dim3(512), LDS_BYTES, stream, a); }
#endif
}
```

```cpp
#include <hip/hip_runtime.h>
#include <cstdio>
#include <cstdint>

#define LAS __attribute__((address_space(3)))
#define GAS __attribute__((address_space(1)))
typedef unsigned short bf16_t;
typedef short bf16x8 __attribute__((ext_vector_type(8)));
typedef float f32x4 __attribute__((ext_vector_type(4)));
typedef float f32x2 __attribute__((ext_vector_type(2)));
typedef float f32x16 __attribute__((ext_vector_type(16)));
typedef unsigned u32x4 __attribute__((ext_vector_type(4)));
typedef unsigned u32x2 __attribute__((ext_vector_type(2)));

constexpr int DM = 2048, NB = 4, SEQ = 4096, NMETA = 16, LSEQ = 4112, M = NB * LSEQ  , MP = 16640  , DEPTH = 4;
constexpr int RWW = 1024, RW_COLS = 3520, IN_COLS = 14592, PN = 13568  ;
constexpr int P_QRET = 3520, P_KRET = 4544, P_GRET = 5568, P_QD = 6592, P_KVD = 7104, P_KRD = 7360, P_GATES = 7424;
constexpr int FFN = 5632, LORA_K = 512, LORA_N = 3072;
constexpr float NORM_EPS = 1e-6f, GN_EPS = 64.0f * 1e-5f;

constexpr size_t MiB = 1u << 20;
constexpr size_t al(size_t x) { return (x + MiB - 1) / MiB * MiB; }
constexpr size_t WS_CTL = 0, CTL_BYTES = 2 * MiB;
constexpr size_t WS_WIN = WS_CTL + CTL_BYTES;
constexpr size_t WS_WVRET = WS_WIN + al((size_t)PN * DM * 2);
constexpr size_t WS_WLORA = WS_WVRET + al((size_t)1024 * DM * 2);
constexpr size_t WS_WUQ = WS_WLORA + al((size_t)LORA_N * LORA_K * 2);
constexpr size_t WS_WUK = WS_WUQ + al((size_t)1536 * 512 * 2);
constexpr size_t WS_WUV = WS_WUK + al((size_t)1024 * 256 * 2);
constexpr size_t WS_WBR = WS_WUV + al((size_t)1024 * 256 * 2);
constexpr size_t WS_WOUT = WS_WBR + al((size_t)6144 * 1024 * 2);
constexpr size_t WS_WGU = WS_WOUT + al((size_t)2048 * 6144 * 2);
constexpr size_t WS_WD = WS_WGU + al((size_t)11264 * 2048 * 2);
constexpr size_t WS_ROPE = WS_WD + al((size_t)2048 * FFN * 2);
constexpr size_t WS_H = WS_ROPE + al((size_t)LSEQ * 192 * 4);
constexpr size_t WS_U = WS_H + al((size_t)MP * DM * 4);
constexpr size_t WS_P = WS_U + al((size_t)MP * DM * 2);
constexpr size_t WS_VTRET = WS_P + al((size_t)MP * PN * 2);
constexpr size_t WS_XL = WS_VTRET + al((size_t)1024 * MP * 2);
constexpr size_t WS_RW = WS_XL + al((size_t)MP * 512 * 2);
constexpr size_t RW_WDEC = 0;
constexpr size_t RW_A = RW_WDEC + (size_t)MP * 1024 * 4;
constexpr size_t RW_ARR = (size_t)MP * 1024 * 2;
constexpr size_t RW_YRAW = RW_A + 7 * RW_ARR;
constexpr size_t RW_BYTES = RW_YRAW + (size_t)MP * 1024 * 4;
static_assert(RW_BYTES >= (size_t)MP * 6144 * 2, "GT overlay");
constexpr size_t WS_YBR = WS_RW + al(RW_BYTES);
constexpr size_t WS_QN = WS_YBR + al(3 * RW_ARR);
constexpr size_t WS_KVN = WS_QN + al((size_t)MP * 512 * 2);
constexpr size_t WS_KR = WS_KVN + al((size_t)MP * 256 * 2);
constexpr size_t WS_Q = WS_KR + al((size_t)MP * 64 * 2);
constexpr size_t WS_KNOPE = WS_Q + al((size_t)MP * 1536 * 2);
constexpr size_t WS_VTMLA = WS_KNOPE + al((size_t)MP * 1024 * 2);
constexpr size_t WS_KVT = WS_VTMLA + al((size_t)1024 * MP * 2);
constexpr int NCHUNK = LSEQ / 16;
constexpr int RC_B1 = 0, RC_B2 = 5632, RC_VT = 10752, RC_G = 13824, RC_STRIDE = 14336;
constexpr size_t WS_RCH = WS_KVT + al((size_t)NB * 8 * 16 * 128 * 128 * 4);
constexpr size_t WS_END = WS_RCH + al((size_t)NB * 16 * NCHUNK * RC_STRIDE);
static_assert((size_t)MP * FFN * 2 <= (size_t)MP * PN * 2, "ACT overlay");

constexpr int CW_QUEUE = 1024;
constexpr int CW_BAR = 4096;
constexpr int XCD_BAR_WORDS_C = 3456;
constexpr int MAX_BAR_REGIONS = 64;
#ifndef N_LAUNCH_MODE
#define N_LAUNCH_MODE 1
#endif
constexpr size_t CTL_ZERO_BYTES = (N_LAUNCH_MODE == 1) ? (size_t)(CW_BAR + XCD_BAR_WORDS_C) * 4 : CTL_BYTES;

constexpr int LDS_BYTES = 147456;
constexpr int LDS_MISC = 131072;

__device__ __forceinline__ float bf2f(unsigned short v) { return __uint_as_float(((unsigned)v) << 16); }
__device__ __forceinline__ float bflo(unsigned v) { return __uint_as_float(v << 16); }
__device__ __forceinline__ float bfhi(unsigned v) { return __uint_as_float(v & 0xffff0000u); }
__device__ __forceinline__ unsigned cvt_pk_bf16(float lo, float hi) { unsigned r; asm volatile("v_cvt_pk_bf16_f32 %0, %1, %2" : "=v"(r) : "v"(lo), "v"(hi)); return r; }
__device__ __forceinline__ unsigned short f2bf(float x) { return (unsigned short)(cvt_pk_bf16(x, 0.f) & 0xffffu); }
template <int X> __device__ __forceinline__ float sw_xor(float x) { return __int_as_float(__builtin_amdgcn_ds_swizzle(__float_as_int(x), 0x1f | (X << 10))); }
__device__ __forceinline__ float hsum32(float x) { const int v = __float_as_int(x); auto r = __builtin_amdgcn_permlane32_swap(v, v, false, false); return __int_as_float(r[0]) + __int_as_float(r[1]); }
__device__ __forceinline__ float hmax32(float x) { const int v = __float_as_int(x); auto r = __builtin_amdgcn_permlane32_swap(v, v, false, false); return fmaxf(__int_as_float(r[0]), __int_as_float(r[1])); }
__device__ __forceinline__ float wsum32(float x) { x += sw_xor<16>(x); x += sw_xor<8>(x); x += sw_xor<4>(x); x += sw_xor<2>(x); x += sw_xor<1>(x); return x; }
__device__ __forceinline__ float wsum64(float x) { x = wsum32(x); return hsum32(x); }
__device__ __forceinline__ float dpp_xor1(float x) { return __int_as_float(__builtin_amdgcn_update_dpp(0, __float_as_int(x), 0xB1, 0xF, 0xF, true)); }
__device__ __forceinline__ float dpp_xor2(float x) { return __int_as_float(__builtin_amdgcn_update_dpp(0, __float_as_int(x), 0x4E, 0xF, 0xF, true)); }
__device__ __forceinline__ float dpp_mirror(float x) { return __int_as_float(__builtin_amdgcn_update_dpp(0, __float_as_int(x), 0x140, 0xF, 0xF, true)); }
__device__ __forceinline__ float dpp_hmirror(float x) { return __int_as_float(__builtin_amdgcn_update_dpp(0, __float_as_int(x), 0x141, 0xF, 0xF, true)); }
__device__ __forceinline__ float wsum64_dpp(float x) {
    x += dpp_xor1(x); x += dpp_xor2(x); x += dpp_hmirror(x); x += dpp_mirror(x);
    x += __int_as_float(__builtin_amdgcn_update_dpp(0, __float_as_int(x), 0x142, 0xA, 0xF, false));
    x += __int_as_float(__builtin_amdgcn_update_dpp(0, __float_as_int(x), 0x143, 0xC, 0xF, false));
    return __int_as_float(__builtin_amdgcn_readlane(__float_as_int(x), 63));
}
__device__ __forceinline__ float sigmoidf_(float x) { return __builtin_amdgcn_rcpf(1.0f + __expf(-x)); }
__device__ __forceinline__ u32x4 zero4u() { unsigned z; asm volatile("v_mov_b32 %0, 0" : "=v"(z)); return (u32x4){z, z, z, z}; }

#define XB_TMO      128
#define XB_XCNT(j)  (256  + 64 * (j))
#define XB_XSUB(j)  (1280 + 64 * (j))
#define XB_XGEN(j)  (2304 + 64 * (j))
#define XB_TOP      3328
#define XB_TOPGEN   3392
#define XCD_BAR_WORDS 3456
#define XB_SPIN_CAP (1u << 18)

__device__ __forceinline__ unsigned xb_ld(unsigned* p)              { return __hip_atomic_load(p, __ATOMIC_RELAXED, __HIP_MEMORY_SCOPE_AGENT); }
__device__ __forceinline__ unsigned xb_add(unsigned* p, unsigned v) { return __hip_atomic_fetch_add(p, v, __ATOMIC_RELAXED, __HIP_MEMORY_SCOPE_AGENT); }
__device__ __forceinline__ unsigned xb_xcc_id() { return (unsigned)__builtin_amdgcn_s_getreg((3 << 11) | 20) & 0xFu; }
#define XB_SPIN(cond, bar) do { unsigned _sp = 0; while (cond) { __builtin_amdgcn_s_sleep(1); \
    if ((++_sp & 255u) == 0u) { if (xb_ld(&(bar)[XB_TMO])) break; if (_sp > XB_SPIN_CAP) { atomicAdd(&(bar)[XB_TMO], 1u); break; } } } } while (0)

struct XcdBarrier { unsigned* bar; unsigned x; volatile LAS unsigned* st; };

__device__ __forceinline__ XcdBarrier xcd_barrier_post(unsigned* bar, volatile LAS unsigned* st) {
    XcdBarrier b; b.bar = bar; b.x = xb_xcc_id(); b.st = st;
    if (threadIdx.x == 0) (void)xb_add(&bar[XB_XCNT(b.x)], 1u);
    return b;
}
__device__ __forceinline__ void xcd_barrier_complete(unsigned* bar, unsigned x, unsigned& nloc, unsigned& nx) {
    const unsigned G = gridDim.x * gridDim.y * gridDim.z;
    unsigned sum, cnt, mine, sp = 0u;
    for (;;) {
        sum = 0u; cnt = 0u; mine = 0u;
#pragma unroll
        for (unsigned j = 0; j < 16; ++j) { const unsigned c = xb_ld(&bar[XB_XCNT(j)]); sum += c; cnt += (c > 0u) ? 1u : 0u; mine = (j == x) ? c : mine; }
        if (sum == G) break;
        __builtin_amdgcn_s_sleep(1);
        if ((++sp & 255u) == 0u) { if (xb_ld(&bar[XB_TMO])) break; if (sp > XB_SPIN_CAP) { atomicAdd(&bar[XB_TMO], 1u); break; } }
    }
    nloc = mine > 0u ? mine : 1u; nx = cnt > 0u ? cnt : 1u;
}
__device__ __forceinline__ void xcd_barrier(const XcdBarrier& b, const bool leader) {
    asm volatile("s_waitcnt vmcnt(0)" ::: "memory");
    __syncthreads();
    if (leader) {
        unsigned* bar = b.bar;
        __builtin_amdgcn_s_waitcnt(0);
        unsigned nloc = b.st[0], nx = b.st[1];
        if (nloc == 0u) { xcd_barrier_complete(bar, b.x, nloc, nx); b.st[0] = nloc; b.st[1] = nx; }
        const unsigned old = xb_add(&bar[XB_XSUB(b.x)], 1u);
        const unsigned gen = old / nloc;
        if (old + 1u == (gen + 1u) * nloc) {
            __builtin_amdgcn_fence(__ATOMIC_RELEASE, "agent");
            asm volatile("s_waitcnt vmcnt(0)" ::: "memory");
            const unsigned og = xb_add(&bar[XB_TOP], 1u);
            const unsigned tg = og / nx;
            if (og + 1u == (tg + 1u) * nx) xb_add(&bar[XB_TOPGEN], 1u);
            else XB_SPIN(xb_ld(&bar[XB_TOPGEN]) == tg, bar);
            __builtin_amdgcn_fence(__ATOMIC_ACQUIRE, "agent");
            xb_add(&bar[XB_XGEN(b.x)], 1u);
            asm volatile("s_waitcnt vmcnt(0)" ::: "memory");
        } else {
            XB_SPIN(xb_ld(&bar[XB_XGEN(b.x)]) == gen, bar);
            __builtin_amdgcn_fence(__ATOMIC_ACQUIRE, "agent");
            asm volatile("s_waitcnt vmcnt(0)" ::: "memory");
        }
    }
    __syncthreads();
}

__device__ __forceinline__ void unpack8(const u32x4 w, float (&x)[8]);
__device__ __forceinline__ u32x4 pack8(const float (&x)[8]);
__device__ __forceinline__ void ld8f(const float* p, float (&x)[8]);
namespace pg8 {
constexpr int BM = 256, BK = 64, HALF = 128, HTB = HALF * BK * 2, STAGE_BYTES = 8 * HTB, NXCD = 8, WGM = 8;
__host__ __device__ __forceinline__ int lds_byte(int r, int c) { const int st = (r >> 4) * 2 + (c >> 5), rr = r & 15, cc = c & 31, ob = rr * 64 + cc * 2; return st * 1024 + (ob ^ (((ob >> 9) & 1) << 5)); }
__host__ __device__ __forceinline__ void stage_rc(int b, int& R, int& C) { const int st = b / 1024, sb = b % 1024, swz = sb ^ (((sb >> 9) & 1) << 5); R = (st >> 1) * 16 + swz / 64; C = (st & 1) * 32 + (swz % 64) / 2; }
__host__ __device__ __forceinline__ int perm32(int rho) { const int n = rho >> 4, i = rho & 15; return 8 * (i >> 2) + 4 * n + (i & 3); }

struct Unit { int pm, pn; };
struct Gemm { const bf16_t* A; const bf16_t* Bt; int M, N, K; int asel_tiles; size_t asel_stride; };

struct StaticOrder {
    int nM, nN, nwg, G, c;
    __host__ __device__ void init(int M_, int N_, int G_, int c_) { nM = M_ / BM; nN = N_ / BM; nwg = nM * nN; G = G_; c = c_; }
    __host__ __device__ bool next(int i, Unit& u) const {
        const long L = (long)i * G + c; if (L >= nwg) return false;
        int wgid = (int)L; { const int q = nwg / NXCD, r = nwg % NXCD, xcd = wgid % NXCD, off = wgid / NXCD; wgid = (xcd < r ? xcd * (q + 1) : r * (q + 1) + (xcd - r) * q) + off; }
        const int nig = WGM * nN, gid = wgid / nig, fm = gid * WGM, gsz = (nM - fm) < WGM ? (nM - fm) : WGM;
        u.pm = fm + ((wgid % nig) % gsz); u.pn = (wgid % nig) / gsz; return true;
    }
    __device__ __forceinline__ void a_ready(const Unit&) const {}
    __device__ __forceinline__ void done(const Unit&) const {}
};

template <class Epi, class Sched, bool ALIGN_EPI = false, bool SP2 = false>
__device__ __forceinline__ void gemm_phase(LAS unsigned char* lds, const Gemm g, const Sched& S, const Epi& E, const int tid) {
    const int wid = __builtin_amdgcn_readfirstlane(tid >> 6), lane = tid & 63, wr = wid >> 2, wc = wid & 3, fr = lane & 15, fq = lane >> 4;
    const int K = g.K, nt = K / BK;
    unsigned voffA[2], voffB[2];
#pragma unroll
    for (int i = 0; i < 2; ++i) { int R, C; stage_rc(tid * 16 + i * 8192, R, C); const int Rb = Epi::PERM ? ((R & ~31) + perm32(R & 31)) : R;
        voffA[i] = (unsigned)(R * K + C) * 2u; voffB[i] = (unsigned)(Rb * K + C) * 2u; }
    const size_t kstep = (size_t)(BK * 2);
    const size_t hstep = (size_t)HALF * K * 2;
    const size_t tstep = 2 * hstep;
    const unsigned ldsw = (unsigned)wid * 1024u;
    const int aoff = lds_byte(wr * 64 + fr, fq * 8), boff = lds_byte(wc * 32 + fr, fq * 8);
#define PG8_SA(b, h) (((b) * 2 + (h)) * HTB)
#define PG8_SB(b, h) ((4 + (b) * 2 + (h)) * HTB)
#define PG8_STAGE(bufoff, gbase, voff) do { _Pragma("unroll") for (int _i = 0; _i < 2; ++_i) \
        __builtin_amdgcn_global_load_lds((const unsigned*)((const char*)(gbase) + (voff)[_i]), (LAS unsigned*)(lds + (bufoff) + ldsw + _i * 8192), 16, 0, 0); } while (0)
#define PG8_LDA(dst, b, h) do { _Pragma("unroll") for (int m = 0; m < 4; ++m) _Pragma("unroll") for (int k = 0; k < 2; ++k) dst[m][k] = *(const LAS bf16x8*)(lds + PG8_SA(b, h) + aoff + m * 2048 + k * 1024); } while (0)
#define PG8_LDB(dst, b, h) do { _Pragma("unroll") for (int n = 0; n < 2; ++n) _Pragma("unroll") for (int k = 0; k < 2; ++k) dst[n][k] = *(const LAS bf16x8*)(lds + PG8_SB(b, h) + boff + n * 2048 + k * 1024); } while (0)
#define PG8_MMA(ai, bj, At, Bt) do { __builtin_amdgcn_s_setprio(1); _Pragma("unroll") for (int m = 0; m < 4; ++m) _Pragma("unroll") for (int n = 0; n < 2; ++n) _Pragma("unroll") for (int k = 0; k < 2; ++k) \
        acc[ai][bj][m][n] = __builtin_amdgcn_mfma_f32_16x16x32_bf16(Bt[n][k], At[m][k], acc[ai][bj][m][n], 0, 0, 0); __builtin_amdgcn_s_setprio(0); } while (0)
#define PG8_WAIT_V(n) asm volatile("s_waitcnt vmcnt(" #n ")" ::: "memory")
#define PG8_WAIT_L(n) asm volatile("s_waitcnt lgkmcnt(" #n ")" ::: "memory")
#define PG8_BAR __builtin_amdgcn_s_barrier()
#define PG8_SCHED __builtin_amdgcn_sched_barrier(0)
#define PG8_ABASE(u) ((const char*)g.A + (g.asel_tiles ? (size_t)((u).pn / g.asel_tiles) * g.asel_stride : (size_t)0) + (size_t)(u).pm * tstep)
    Unit cur, nxt; int ui = 0;
    if (!S.next(0, cur)) return;
    f32x4 acc[2][2][4][2];
    { float zf; asm volatile("v_mov_b32 %0, 0" : "=v"(zf)); const f32x4 Z = {zf, zf, zf, zf};
#pragma unroll
    for (int a = 0; a < 2; ++a)
#pragma unroll
        for (int b = 0; b < 2; ++b)
#pragma unroll
            for (int m = 0; m < 4; ++m)
#pragma unroll
                for (int n = 0; n < 2; ++n) acc[a][b][m][n] = Z; }
    bf16x8 At[4][2], B0[2][2], B1[2][2];
    const char* cA = PG8_ABASE(cur); const char* cB = (const char*)g.Bt + (size_t)cur.pn * tstep;
    S.a_ready(cur);
    if constexpr (SP2) {
        PG8_STAGE(PG8_SB(0, 0), cB, voffB); PG8_STAGE(PG8_SB(0, 1), cB + hstep, voffB); PG8_STAGE(PG8_SA(0, 0), cA, voffA); PG8_STAGE(PG8_SA(0, 1), cA + hstep, voffA);
        if (wr == 1) PG8_BAR;
        PG8_WAIT_V(2); PG8_BAR;
        PG8_STAGE(PG8_SB(1, 0), cB + kstep, voffB); PG8_STAGE(PG8_SA(1, 0), cA + kstep, voffA); PG8_STAGE(PG8_SB(1, 1), cB + hstep + kstep, voffB);
        PG8_WAIT_V(6); PG8_BAR;
    } else {
        PG8_STAGE(PG8_SB(0, 0), cB, voffB); PG8_STAGE(PG8_SA(0, 0), cA, voffA); PG8_STAGE(PG8_SB(0, 1), cB + hstep, voffB); PG8_STAGE(PG8_SA(0, 1), cA + hstep, voffA);
        if (wr == 1) PG8_BAR;
        PG8_WAIT_V(4); PG8_BAR;
        PG8_STAGE(PG8_SB(1, 0), cB + kstep, voffB); PG8_STAGE(PG8_SA(1, 0), cA + kstep, voffA); PG8_STAGE(PG8_SB(1, 1), cB + hstep + kstep, voffB);
        PG8_WAIT_V(6); PG8_BAR;
    }
    for (;;) {
        const bool has_next = S.next(ui + 1, nxt);
        const char* nA = has_next ? PG8_ABASE(nxt) : cA; const char* nB = has_next ? (const char*)g.Bt + (size_t)nxt.pn * tstep : cB;
        for (int t = 0; t < nt; t += 2) {
            const bool last = (t == nt - 2);
            const char* a1 = cA + (size_t)(t + 1) * kstep;
            const char* a2 = last ? nA : cA + (size_t)(t + 2) * kstep; const char* b2 = last ? nB : cB + (size_t)(t + 2) * kstep;
            const char* a3 = a2 + kstep; const char* b3 = b2 + kstep;
            if (last && has_next) S.a_ready(nxt);
            if constexpr (SP2) {
            PG8_LDB(B0, 0, 0); PG8_LDB(B1, 0, 1); PG8_SCHED; PG8_LDA(At, 0, 0); PG8_STAGE(PG8_SA(1, 1), a1 + hstep, voffA);
            PG8_WAIT_V(8); PG8_WAIT_L(0); PG8_BAR; PG8_MMA(0, 0, At, B0); PG8_MMA(0, 1, At, B1); PG8_BAR; PG8_SCHED;
            PG8_LDA(At, 0, 1); PG8_STAGE(PG8_SB(0, 0), b2, voffB); PG8_STAGE(PG8_SB(0, 1), b2 + hstep, voffB); PG8_STAGE(PG8_SA(0, 0), a2, voffA);
            PG8_WAIT_V(8); PG8_WAIT_L(0); PG8_BAR; PG8_MMA(1, 0, At, B0); PG8_MMA(1, 1, At, B1); PG8_BAR; PG8_SCHED;
            PG8_LDB(B0, 1, 0); PG8_LDB(B1, 1, 1); PG8_SCHED; PG8_LDA(At, 1, 0); PG8_STAGE(PG8_SA(0, 1), a2 + hstep, voffA);
            PG8_WAIT_V(8); PG8_WAIT_L(0); PG8_BAR; PG8_MMA(0, 0, At, B0); PG8_MMA(0, 1, At, B1); PG8_BAR; PG8_SCHED;
            PG8_LDA(At, 1, 1); PG8_STAGE(PG8_SB(1, 0), b3, voffB); PG8_STAGE(PG8_SB(1, 1), b3 + hstep, voffB); PG8_STAGE(PG8_SA(1, 0), a3, voffA);
            PG8_WAIT_V(8); PG8_WAIT_L(0); PG8_BAR; PG8_MMA(1, 0, At, B0); PG8_MMA(1, 1, At, B1); PG8_BAR; PG8_SCHED;
            } else {
            PG8_LDB(B0, 0, 0); PG8_SCHED; PG8_LDA(At, 0, 0); PG8_STAGE(PG8_SA(1, 1), a1 + hstep, voffA);
            PG8_WAIT_L(8); PG8_BAR; PG8_WAIT_L(0); PG8_MMA(0, 0, At, B0); PG8_BAR; PG8_SCHED;
            PG8_LDB(B1, 0, 1); PG8_STAGE(PG8_SB(0, 0), b2, voffB);
            PG8_BAR; PG8_WAIT_L(0); PG8_MMA(0, 1, At, B1); PG8_BAR;
            PG8_LDA(At, 0, 1); PG8_STAGE(PG8_SA(0, 0), a2, voffA);
            PG8_BAR; PG8_WAIT_L(0); PG8_MMA(1, 0, At, B0); PG8_BAR; PG8_SCHED;
            PG8_STAGE(PG8_SB(0, 1), b2 + hstep, voffB);
            PG8_WAIT_V(6); PG8_BAR; PG8_MMA(1, 1, At, B1); PG8_BAR;
            PG8_LDB(B0, 1, 0); PG8_SCHED; PG8_LDA(At, 1, 0); PG8_STAGE(PG8_SA(0, 1), a2 + hstep, voffA);
            PG8_WAIT_L(8); PG8_BAR; PG8_WAIT_L(0); PG8_MMA(0, 0, At, B0); PG8_BAR; PG8_SCHED;
            PG8_LDB(B1, 1, 1); PG8_STAGE(PG8_SB(1, 0), b3, voffB);
            PG8_BAR; PG8_WAIT_L(0); PG8_MMA(0, 1, At, B1); PG8_BAR;
            PG8_LDA(At, 1, 1); PG8_STAGE(PG8_SA(1, 0), a3, voffA);
            PG8_BAR; PG8_WAIT_L(0); PG8_MMA(1, 0, At, B0); PG8_BAR; PG8_SCHED;
            PG8_STAGE(PG8_SB(1, 1), b3 + hstep, voffB);
            PG8_WAIT_V(6); PG8_BAR; PG8_MMA(1, 1, At, B1); PG8_BAR;
            }
        }
        if constexpr (ALIGN_EPI) { if (wr == 0) PG8_BAR; }
        E(acc, cur, wr, wc, fr, fq); S.done(cur);
        if (!has_next) break;
        { float zf; asm volatile("v_mov_b32 %0, 0" : "=v"(zf)); const f32x4 Z = {zf, zf, zf, zf};
#pragma unroll
        for (int a = 0; a < 2; ++a)
#pragma unroll
            for (int b = 0; b < 2; ++b)
#pragma unroll
                for (int m = 0; m < 4; ++m)
#pragma unroll
                    for (int n = 0; n < 2; ++n) acc[a][b][m][n] = Z; }
        cur = nxt; cA = nA; cB = nB; ++ui;
        if constexpr (ALIGN_EPI) { if (wr == 1) PG8_BAR; }
    }
    PG8_WAIT_V(0);
    if constexpr (!ALIGN_EPI) { if (wr == 0) PG8_BAR; }
    PG8_BAR;
#undef PG8_SA
#undef PG8_SB
#undef PG8_STAGE
#undef PG8_LDA
#undef PG8_LDB
#undef PG8_MMA
#undef PG8_WAIT_V
#undef PG8_WAIT_L
#undef PG8_BAR
#undef PG8_SCHED
#undef PG8_ABASE
}

struct EpiBf16Plain {
    static constexpr bool PERM = true;
    bf16_t* O; int ldc;
    __device__ __forceinline__ void operator()(const f32x4 (&acc)[2][2][4][2], const Unit& u, int wr, int wc, int fr, int fq) const {
        const int row0 = u.pm * BM + wr * 64 + fr; const int col0 = u.pn * BM + wc * 32 + 8 * fq;
#pragma unroll
        for (int ai = 0; ai < 2; ++ai)
#pragma unroll
            for (int m = 0; m < 4; ++m) { bf16_t* rowp = O + (size_t)(row0 + ai * HALF + m * 16) * ldc + col0;
#pragma unroll
                for (int bj = 0; bj < 2; ++bj) { const f32x4 v0 = acc[ai][bj][m][0], v1 = acc[ai][bj][m][1];
                    u32x4 w; w.x = cvt_pk_bf16(v0[0], v0[1]); w.y = cvt_pk_bf16(v0[2], v0[3]); w.z = cvt_pk_bf16(v1[0], v1[1]); w.w = cvt_pk_bf16(v1[2], v1[3]);
                    *(u32x4*)(rowp + bj * HALF) = w; } }
    }
};
struct EpiResid {
    static constexpr bool PERM = true;
    bf16_t* Hb;
    __device__ __forceinline__ void operator()(const f32x4 (&acc)[2][2][4][2], const Unit& u, int wr, int wc, int fr, int fq) const {
        const int row0 = u.pm * BM + wr * 64 + fr, col0 = u.pn * BM + wc * 32 + 8 * fq;
        bf16_t* base = Hb + (size_t)row0 * DM + col0;
        u32x4 hv[2][4][2];
#pragma unroll
        for (int ai = 0; ai < 2; ++ai)
#pragma unroll
            for (int m = 0; m < 4; ++m)
#pragma unroll
                for (int bj = 0; bj < 2; ++bj) hv[ai][m][bj] = *(const u32x4*)(base + (size_t)(ai * HALF + m * 16) * DM + bj * HALF);
#pragma unroll
        for (int ai = 0; ai < 2; ++ai)
#pragma unroll
            for (int m = 0; m < 4; ++m)
#pragma unroll
                for (int bj = 0; bj < 2; ++bj) { const f32x4 v0 = acc[ai][bj][m][0], v1 = acc[ai][bj][m][1]; float p[8]; unpack8(hv[ai][m][bj], p);
                    const float o[8] = {p[0] + v0[0], p[1] + v0[1], p[2] + v0[2], p[3] + v0[3], p[4] + v1[0], p[5] + v1[1], p[6] + v1[2], p[7] + v1[3]};
                    *(u32x4*)(base + (size_t)(ai * HALF + m * 16) * DM + bj * HALF) = pack8(o); }
    }
};
struct EpiLora {
    static constexpr bool PERM = true;
    float* wdec; bf16_t* abuf; bf16_t* gbuf; const float* w0; const float* a0;
    __device__ __forceinline__ void operator()(const f32x4 (&acc)[2][2][4][2], const Unit& u, int wr, int wc, int fr, int fq) const {
        const int row0 = u.pm * BM + wr * 64 + fr; const int type = u.pn >> 2; const int col0 = (u.pn & 3) * BM + wc * 32 + 8 * fq;
        if (type == 0) {
            f32x4 bv[2][2];
#pragma unroll
            for (int bj = 0; bj < 2; ++bj) { bv[bj][0] = *(const f32x4*)(w0 + col0 + bj * HALF); bv[bj][1] = *(const f32x4*)(w0 + col0 + bj * HALF + 4); }
#pragma unroll
            for (int ai = 0; ai < 2; ++ai)
#pragma unroll
                for (int m = 0; m < 4; ++m) { float* rowp = wdec + (size_t)(row0 + ai * HALF + m * 16) * 1024 + col0;
#pragma unroll
                    for (int bj = 0; bj < 2; ++bj)
#pragma unroll
                        for (int n = 0; n < 2; ++n) { f32x4 x = acc[ai][bj][m][n] + bv[bj][n]; f32x4 o;
#pragma unroll
                            for (int i = 0; i < 4; ++i) { const float y = -x[i]; const float sp = fmaxf(y, 0.f) + __logf(1.0f + __expf(-fabsf(y))); o[i] = __expf(-__expf(-sp - 0.5f)); }
                            *(f32x4*)(rowp + bj * HALF + 4 * n) = o; } }
        } else {
            bf16_t* ob = (type == 1) ? abuf : gbuf;
            f32x4 bv[2][2];
#pragma unroll
            for (int bj = 0; bj < 2; ++bj) { bv[bj][0] = *(const f32x4*)(a0 + col0 + bj * HALF); bv[bj][1] = *(const f32x4*)(a0 + col0 + bj * HALF + 4); }
#pragma unroll
            for (int ai = 0; ai < 2; ++ai)
#pragma unroll
                for (int m = 0; m < 4; ++m) { bf16_t* rowp = ob + (size_t)(row0 + ai * HALF + m * 16) * 1024 + col0;
#pragma unroll
                    for (int bj = 0; bj < 2; ++bj) { f32x4 v0 = acc[ai][bj][m][0], v1 = acc[ai][bj][m][1];
                        if (type == 1) { v0 = v0 + bv[bj][0]; v1 = v1 + bv[bj][1];
#pragma unroll
                            for (int i = 0; i < 4; ++i) { v0[i] = sigmoidf_(v0[i]); v1[i] = sigmoidf_(v1[i]); } }
                        u32x4 w; w.x = cvt_pk_bf16(v0[0], v0[1]); w.y = cvt_pk_bf16(v0[2], v0[3]); w.z = cvt_pk_bf16(v1[0], v1[1]); w.w = cvt_pk_bf16(v1[2], v1[3]);
                        *(u32x4*)(rowp + bj * HALF) = w; } }
        }
    }
};
struct EpiGate {
    static constexpr bool PERM = true;
    bf16_t* MG; const bf16_t* P;
    __device__ __forceinline__ void operator()(const f32x4 (&acc)[2][2][4][2], const Unit& u, int wr, int wc, int fr, int fq) const {
        const int br = u.pn >> 3; const int row0 = u.pm * BM + wr * 64 + fr; const int col0 = (u.pn & 7) * BM + wc * 32 + 8 * fq;
        const bf16_t* gbase = P + (size_t)row0 * PN + P_GATES + br * 2048 + col0; bf16_t* mbase = MG + (size_t)row0 * DM + col0;
#pragma unroll
        for (int ai = 0; ai < 2; ++ai) {
            u32x4 gv[4][2], mv[4][2];
#pragma unroll
            for (int m = 0; m < 4; ++m)
#pragma unroll
                for (int bj = 0; bj < 2; ++bj) { gv[m][bj] = *(const u32x4*)(gbase + (size_t)(ai * HALF + m * 16) * PN + bj * HALF);
                    if (br > 0) mv[m][bj] = *(const u32x4*)(mbase + (size_t)(ai * HALF + m * 16) * DM + bj * HALF); }
#pragma unroll
            for (int m = 0; m < 4; ++m)
#pragma unroll
                for (int bj = 0; bj < 2; ++bj) { const f32x4 v0 = acc[ai][bj][m][0], v1 = acc[ai][bj][m][1]; const u32x4 gt = gv[m][bj];
                    float o[8] = { v0[0] * sigmoidf_(bflo(gt.x)), v0[1] * sigmoidf_(bfhi(gt.x)), v0[2] * sigmoidf_(bflo(gt.y)), v0[3] * sigmoidf_(bfhi(gt.y)),
                                   v1[0] * sigmoidf_(bflo(gt.z)), v1[1] * sigmoidf_(bfhi(gt.z)), v1[2] * sigmoidf_(bflo(gt.w)), v1[3] * sigmoidf_(bfhi(gt.w)) };
                    if (br > 0) { float p[8]; unpack8(mv[m][bj], p);
#pragma unroll
                        for (int i = 0; i < 8; ++i) o[i] += p[i]; }
                    *(u32x4*)(mbase + (size_t)(ai * HALF + m * 16) * DM + bj * HALF) = pack8(o); }
        }
    }
};
struct BranchOrder {
    StaticOrder base;
    __device__ bool next(int i, Unit& u) const { Unit t; if (!base.next(i / 3, t)) return false; u.pm = t.pm; u.pn = (i % 3) * 8 + t.pn; return true; }
    __device__ __forceinline__ void a_ready(const Unit&) const {}
    __device__ __forceinline__ void done(const Unit&) const {}
};
struct EpiSwiglu {
    static constexpr bool PERM = true;
    bf16_t* ACT;
    __device__ __forceinline__ void operator()(const f32x4 (&acc)[2][2][4][2], const Unit& u, int wr, int wc, int fr, int fq) const {
        const int row0 = u.pm * BM + wr * 64 + fr; const int col0 = u.pn * BM + wc * 32 + 8 * fq;
#pragma unroll
        for (int ai = 0; ai < 2; ++ai)
#pragma unroll
            for (int m = 0; m < 4; ++m) { const size_t row = (size_t)(row0 + ai * HALF + m * 16);
#pragma unroll
                for (int bj = 0; bj < 2; ++bj) { const int hc = (col0 + bj * HALF) >> 1; const f32x4 g = acc[ai][bj][m][0], up = acc[ai][bj][m][1];
                    float o[4];
#pragma unroll
                    for (int i = 0; i < 4; ++i) o[i] = g[i] * sigmoidf_(g[i]) * up[i];
                    u32x2 w; w.x = cvt_pk_bf16(o[0], o[1]); w.y = cvt_pk_bf16(o[2], o[3]);
                    *(u32x2*)(ACT + row * FFN + hc) = w; } }
    }
};
}

struct Args {
    const float* in[27];
    float* out; unsigned char* ws;
    int s_lo, s_hi, bar_idx, pad;
};
struct Ctx {
    float* out; unsigned char* ws; LAS unsigned char* lds; unsigned* ctl;
    int tid, lane, wave, G, wg;
};
enum { IN_X = 0, IN_META, IN_NORM_MIX, IN_W_IN, IN_MU, IN_W0, IN_W_UP, IN_A0, IN_A_UP, IN_G_UP, IN_K_K, IN_K_A, IN_R_K, IN_LN_W, IN_LN_B, IN_NORM_Q, IN_NORM_KV, IN_W_UQ, IN_W_UKV,
       IN_BR_RWKV, IN_BR_RET, IN_BR_MLA, IN_W_OUT, IN_NORM_FFN, IN_W_GU, IN_W_DOWN, IN_FINAL_NORM };

#define WSP(T, off) ((T*)(C.ws + (off)))
constexpr int LDS_INTBL = LDS_MISC + 256;
__device__ __forceinline__ const float* inp(const Ctx& C, int i) {
    const unsigned long long v = ((volatile LAS unsigned long long*)(C.lds + LDS_INTBL))[i];
    const unsigned lo = __builtin_amdgcn_readfirstlane((unsigned)v), hi = __builtin_amdgcn_readfirstlane((unsigned)(v >> 32));
    return (const float*)(GAS const float*)(((unsigned long long)hi << 32) | lo);
}

__device__ __forceinline__ void ph_rope_tables(const Ctx& C) {
    float* rt = WSP(float, WS_ROPE);
    float* cm = rt; float* sm = rt + LSEQ * 32; float* cr = rt + LSEQ * 64; float* sr = rt + LSEQ * 128;
    for (int i = C.wg * 512 + C.tid; i < LSEQ * 96; i += C.G * 512) {
        const int pos = i / 96, j = i % 96;
        if (j < 32) { const float inv = powf(10000.0f, -((float)(2 * j) / 64.0f)); const float ang = (float)pos * inv; cm[pos * 32 + j] = cosf(ang); sm[pos * 32 + j] = sinf(ang); }
        else { const int jj = j - 32; const float inv = powf(10000.0f, -((float)(2 * jj) / 128.0f)); const float ang = (float)pos * inv; cr[pos * 64 + jj] = cosf(ang); sr[pos * 64 + jj] = sinf(ang); }
    }
}

template <class RowPtr>
__device__ __forceinline__ void conv_T(const Ctx& C, const float* __restrict__ src, int ld, int K, int c0, int ncols, const float* __restrict__ gain, const RowPtr& rowptr, int& tbase) {
    LAS float* tile = (LAS float*)C.lds;
    const int nkt = K / 64, ntile = nkt * (ncols / 64);
    const int t = C.tid, kk = t >> 3, n8 = (t & 7) * 8;
    int ti = (C.wg - (tbase % C.G) + C.G) % C.G;
    tbase += ntile;
    if (ti >= ntile) return;
    f32x4 a, b; float gn;
    { const int k0 = (ti % nkt) * 64, n0 = c0 + (ti / nkt) * 64; const float* sp = src + (size_t)(k0 + kk) * ld + n0 + n8; a = *(const f32x4*)sp; b = *(const f32x4*)(sp + 4); gn = gain ? gain[k0 + kk] : 1.0f; }
    for (; ti < ntile; ti += C.G) {
        const int k0 = (ti % nkt) * 64, n0 = c0 + (ti / nkt) * 64;
        { LAS float* tp = tile + kk * 65 + n8;
          tp[0] = a[0] * gn; tp[1] = a[1] * gn; tp[2] = a[2] * gn; tp[3] = a[3] * gn; tp[4] = b[0] * gn; tp[5] = b[1] * gn; tp[6] = b[2] * gn; tp[7] = b[3] * gn; }
        { const int tn = ti + C.G; if (tn < ntile) { const int k1 = (tn % nkt) * 64, n1 = c0 + (tn / nkt) * 64; const float* sp = src + (size_t)(k1 + kk) * ld + n1 + n8; a = *(const f32x4*)sp; b = *(const f32x4*)(sp + 4); gn = gain ? gain[k1 + kk] : 1.0f; } }
        __syncthreads();
        { const int n = t >> 3, k8 = (t & 7) * 8; bf16_t* dp = rowptr(n0 + n);
          if (dp) { float v[8];
#pragma unroll
              for (int i = 0; i < 8; ++i) v[i] = tile[(k8 + i) * 65 + n];
              u32x4 w; w.x = cvt_pk_bf16(v[0], v[1]); w.y = cvt_pk_bf16(v[2], v[3]); w.z = cvt_pk_bf16(v[4], v[5]); w.w = cvt_pk_bf16(v[6], v[7]);
              *(u32x4*)(dp + k0 + k8) = w; } }
        __syncthreads();
    }
}
struct RpLinear { bf16_t* base; int ldk; int coff; int roff; __device__ __forceinline__ bf16_t* operator()(int n) const { return base + (size_t)(n - coff + roff) * ldk; } };
struct RpWin { bf16_t* win; bf16_t* wvret; __device__ __forceinline__ bf16_t* operator()(int n) const {
    if (n < 5568) return win + (size_t)n * DM; if (n < 6592) return wvret + (size_t)(n - 5568) * DM; return win + (size_t)(n - 1024) * DM; } };
struct RpUkv { bf16_t* wuk; bf16_t* wuv; __device__ __forceinline__ bf16_t* operator()(int n) const { const int h = n >> 8, j = n & 255; return (j < 128 ? wuk + (size_t)(h * 128 + j) * 256 : wuv + (size_t)(h * 128 + j - 128) * 256); } };
struct RpOut3 { bf16_t* base; int seg; __device__ __forceinline__ bf16_t* operator()(int n) const { return base + (size_t)n * 6144 + seg * 2048; } };
struct RpGu { bf16_t* base; __device__ __forceinline__ bf16_t* operator()(int n) const { const int which = n >= FFN ? 1 : 0; const int j = n - which * FFN; return base + (size_t)(8 * (j >> 2) + 4 * which + (j & 3)) * DM; } };

__device__ __forceinline__ void ph_convB(const Ctx& C, int l) {
    int tb = 0;
    conv_T(C, inp(C, IN_W_DOWN) + (size_t)l * FFN * DM, DM, FFN, 0, DM, nullptr, RpLinear{WSP(bf16_t, WS_WD), FFN, 0, 0}, tb);
    conv_T(C, inp(C, IN_W_OUT) + (size_t)l * DM * DM, DM, DM, 0, DM, nullptr, RpLinear{WSP(bf16_t, WS_WOUT), DM, 0, 0}, tb);
    conv_T(C, inp(C, IN_BR_RWKV) + (size_t)l * 1024 * DM, DM, 1024, 0, DM, nullptr, RpLinear{WSP(bf16_t, WS_WBR), 1024, 0, 0}, tb);
    conv_T(C, inp(C, IN_BR_RET) + (size_t)l * 1024 * DM, DM, 1024, 0, DM, nullptr, RpLinear{WSP(bf16_t, WS_WBR), 1024, 0, 2048}, tb);
    conv_T(C, inp(C, IN_BR_MLA) + (size_t)l * 1024 * DM, DM, 1024, 0, DM, nullptr, RpLinear{WSP(bf16_t, WS_WBR), 1024, 0, 4096}, tb);
}

__device__ __forceinline__ void ph_conv(const Ctx& C, int l) {
    int tb = 0;
    conv_T(C, inp(C, IN_W_IN) + (size_t)l * DM * IN_COLS, IN_COLS, DM, 0, IN_COLS, inp(C, IN_NORM_MIX) + l * DM, RpWin{WSP(bf16_t, WS_WIN), WSP(bf16_t, WS_WVRET)}, tb);
    conv_T(C, inp(C, IN_W_GU) + (size_t)l * DM * 2 * FFN, 2 * FFN, DM, 0, 2 * FFN, inp(C, IN_NORM_FFN) + l * DM, RpGu{WSP(bf16_t, WS_WGU)}, tb);
    conv_T(C, inp(C, IN_W_UQ) + (size_t)l * 512 * 1536, 1536, 512, 0, 1536, inp(C, IN_NORM_Q) + l * 512, RpLinear{WSP(bf16_t, WS_WUQ), 512, 0, 0}, tb);
    conv_T(C, inp(C, IN_W_UKV) + (size_t)l * 256 * 2048, 2048, 256, 0, 2048, inp(C, IN_NORM_KV) + l * 256, RpUkv{WSP(bf16_t, WS_WUK), WSP(bf16_t, WS_WUV)}, tb);
    { bf16_t* wl = WSP(bf16_t, WS_WLORA); const float* wup = inp(C, IN_W_UP) + (size_t)l * 96 * 1024; const float* aup = inp(C, IN_A_UP) + (size_t)l * 96 * 1024; const float* gup = inp(C, IN_G_UP) + (size_t)l * 256 * 1024;
      static_assert((LORA_N * LORA_K) % 4 == 0, "lora conversion");
      for (int i0 = (C.wg * 512 + C.tid) * 4; i0 < LORA_N * LORA_K; i0 += C.G * 512 * 4) { float v[4];
#pragma unroll
          for (int e = 0; e < 4; ++e) { const int i = i0 + e, n = i / LORA_K, k = i % LORA_K; v[e] = 0.f;
              if (n < 1024) { if (k < 96) v[e] = wup[k * 1024 + n]; } else if (n < 2048) { if (k >= 96 && k < 192) v[e] = aup[(k - 96) * 1024 + (n - 1024)]; } else { if (k >= 192 && k < 448) v[e] = gup[(k - 192) * 1024 + (n - 2048)]; } }
          *(u32x2*)(wl + i0) = (u32x2){cvt_pk_bf16(v[0], v[1]), cvt_pk_bf16(v[2], v[3])}; } }
}

template <bool FIRST>
__device__ __forceinline__ void ph_norm(const Ctx& C) {
    bf16_t* H = WSP(bf16_t, WS_H); bf16_t* U = WSP(bf16_t, WS_U);
    for (int r0 = C.wg * 8 + C.wave; r0 < MP; r0 += C.G * 16) {
        int rows[2]; rows[0] = r0; rows[1] = r0 + C.G * 8;
        float v[2][4][8]; u32x4 raw[2][4];
#pragma unroll
        for (int rr = 0; rr < 2; ++rr)
#pragma unroll
            for (int i = 0; i < 4; ++i) raw[rr][i] = zero4u();
#pragma unroll
        for (int rr = 0; rr < 2; ++rr) { const int row = rows[rr]; if (row >= M) continue;
            if (FIRST) { const int b = row / LSEQ, pos = row % LSEQ; const float* sp = pos < NMETA ? inp(C, IN_META) + (size_t)pos * DM : inp(C, IN_X) + ((size_t)b * SEQ + (pos - NMETA)) * DM;
#pragma unroll
                for (int i = 0; i < 4; ++i) ld8f(sp + (i * 64 + C.lane) * 8, v[rr][i]); }
            else { const bf16_t* hp = H + (size_t)row * DM;
#pragma unroll
                for (int i = 0; i < 4; ++i) raw[rr][i] = *(const u32x4*)(hp + (i * 64 + C.lane) * 8); } }
        __builtin_amdgcn_sched_barrier(0);
        if (!FIRST) {
#pragma unroll
            for (int rr = 0; rr < 2; ++rr)
#pragma unroll
                for (int i = 0; i < 4; ++i) unpack8(raw[rr][i], v[rr][i]); }
#pragma unroll
        for (int rr = 0; rr < 2; ++rr) { const int row = rows[rr]; if (row >= MP) continue;
            bf16_t* up = U + (size_t)row * DM;
            if (row >= M) { const u32x4 z = zero4u(); for (int i = 0; i < 4; ++i) *(u32x4*)(up + (i * 64 + C.lane) * 8) = z; continue; }
            bf16_t* hp = H + (size_t)row * DM; float ss = 0.f;
#pragma unroll
            for (int i = 0; i < 4; ++i)
#pragma unroll
                for (int j = 0; j < 8; ++j) ss += v[rr][i][j] * v[rr][i][j];
            ss = wsum64(ss); const float rstd = rsqrtf(ss * (1.0f / DM) + NORM_EPS);
#pragma unroll
            for (int i = 0; i < 4; ++i) { if (FIRST) *(u32x4*)(hp + (i * 64 + C.lane) * 8) = pack8(v[rr][i]);
                float o[8];
#pragma unroll
                for (int j = 0; j < 8; ++j) o[j] = v[rr][i][j] * rstd;
                *(u32x4*)(up + (i * 64 + C.lane) * 8) = pack8(o); } }
    }
}
__device__ __forceinline__ void ph_final(const Ctx& C) {
    const bf16_t* H = WSP(bf16_t, WS_H); const float* fn = inp(C, IN_FINAL_NORM);
    f32x4 gn[4][2];
#pragma unroll
    for (int i = 0; i < 4; ++i) { gn[i][0] = *(const f32x4*)(fn + (i * 64 + C.lane) * 8); gn[i][1] = *(const f32x4*)(fn + (i * 64 + C.lane) * 8 + 4); }
    for (int r = C.wg * 8 + C.wave; r < NB * SEQ; r += C.G * 8) {
        const int b = r / SEQ, t = r % SEQ; const bf16_t* sp = H + ((size_t)b * LSEQ + NMETA + t) * DM; float* op = C.out + (size_t)r * DM;
        float v[4][8]; float ss = 0.f; u32x4 raw[4];
#pragma unroll
        for (int i = 0; i < 4; ++i) raw[i] = *(const u32x4*)(sp + (i * 64 + C.lane) * 8);
        __builtin_amdgcn_sched_barrier(0);
#pragma unroll
        for (int i = 0; i < 4; ++i) { unpack8(raw[i], v[i]);
#pragma unroll
            for (int j = 0; j < 8; ++j) ss += v[i][j] * v[i][j]; }
        ss = wsum64(ss); const float rstd = rsqrtf(ss * (1.0f / DM) + NORM_EPS);
#pragma unroll
        for (int i = 0; i < 4; ++i) { const int c = (i * 64 + C.lane) * 8; const f32x4 g0 = gn[i][0], g1 = gn[i][1];
            *(f32x4*)(op + c) = (f32x4){v[i][0] * rstd * g0[0], v[i][1] * rstd * g0[1], v[i][2] * rstd * g0[2], v[i][3] * rstd * g0[3]};
            *(f32x4*)(op + c + 4) = (f32x4){v[i][4] * rstd * g1[0], v[i][5] * rstd * g1[1], v[i][6] * rstd * g1[2], v[i][7] * rstd * g1[3]}; }
    }
}
__device__ __forceinline__ void unpack8(const u32x4 w, float (&x)[8]) { x[0] = bflo(w.x); x[1] = bfhi(w.x); x[2] = bflo(w.y); x[3] = bfhi(w.y); x[4] = bflo(w.z); x[5] = bfhi(w.z); x[6] = bflo(w.w); x[7] = bfhi(w.w); }
__device__ __forceinline__ u32x4 pack8(const float (&x)[8]) { u32x4 w; w.x = cvt_pk_bf16(x[0], x[1]); w.y = cvt_pk_bf16(x[2], x[3]); w.z = cvt_pk_bf16(x[4], x[5]); w.w = cvt_pk_bf16(x[6], x[7]); return w; }

__device__ __forceinline__ void ph_prepA(const Ctx& C, int l) {
    const bf16_t* P = WSP(bf16_t, WS_P); bf16_t* XL = WSP(bf16_t, WS_XL); bf16_t* QN = WSP(bf16_t, WS_QN); bf16_t* KVN = WSP(bf16_t, WS_KVN); bf16_t* KR = WSP(bf16_t, WS_KR);
    const float* mu = inp(C, IN_MU) + (size_t)l * RW_COLS; const float* rt = WSP(float, WS_ROPE); const float* cm = rt; const float* sm = rt + LSEQ * 32;
    const int lane = C.lane;
    for (int row = C.wg * 8 + C.wave; row < MP; row += C.G * 8) {
        if (row >= M) { const u32x4 z = zero4u(); *(u32x4*)(XL + (size_t)row * 512 + 8 * lane) = z; *(u32x4*)(QN + (size_t)row * 512 + 8 * lane) = z;
            if (lane < 32) *(u32x4*)(KVN + (size_t)row * 256 + 8 * lane) = z; KR[(size_t)row * 64 + lane] = (bf16_t)z.x; continue; }
        const int pos = row % LSEQ; const bf16_t* pr = P + (size_t)row * PN;
        const int khl = lane >> 3, kc8 = (lane & 7) * 8; bf16_t* kbase = WSP(bf16_t, WS_P) + (size_t)row * PN + P_KRET + khl * 128 + kc8;
        const u32x4 kx1 = *(const u32x4*)kbase, kx2 = *(const u32x4*)(kbase + 64);
        float kcc[8], kss[8]; ld8f(rt + LSEQ * 64 + pos * 64 + kc8, kcc); ld8f(rt + LSEQ * 128 + pos * 64 + kc8, kss);
        const bool lact = lane < 56; const int lc = 3072 + 8 * (lact ? lane : 0);
        const u32x4 lz = *(const u32x4*)(pr + lc), lpz = *(const u32x4*)((pos > 0 ? pr - PN : pr) + lc); const f32x4 lm0 = *(const f32x4*)(mu + lc), lm1 = *(const f32x4*)(mu + lc + 4);
        const u32x4 qdw = *(const u32x4*)(pr + P_QD + 8 * lane), kvw = *(const u32x4*)(pr + P_KVD + 8 * (lane & 31));
        const bf16_t kr1 = pr[P_KRD + (lane & 31)], kr2 = pr[P_KRD + 32 + (lane & 31)]; const float krc = cm[pos * 32 + (lane & 31)], krs = sm[pos * 32 + (lane & 31)];
        { u32x4 o = zero4u();
          if (lact) { float z[8], pz[8];
              unpack8(lz, z);
              if (pos > 0) unpack8(lpz, pz); else { for (int i = 0; i < 8; ++i) pz[i] = 0.f; }
              const float mm[8] = {lm0[0], lm0[1], lm0[2], lm0[3], lm1[0], lm1[1], lm1[2], lm1[3]};
              float x[8];
#pragma unroll
              for (int i = 0; i < 8; ++i) { const float zs = z[i] + (pz[i] - z[i]) * mm[i]; x[i] = (lane < 12) ? tanhf(zs) : (lane < 24 ? zs : sigmoidf_(zs)); }
              o = pack8(x); }
          *(u32x4*)(XL + (size_t)row * 512 + 8 * lane) = o; }
        { float x[8]; unpack8(qdw, x); float ss = 0.f;
#pragma unroll
          for (int i = 0; i < 8; ++i) ss += x[i] * x[i];
          ss = wsum64(ss); const float rstd = rsqrtf(ss * (1.0f / 512.0f) + NORM_EPS);
#pragma unroll
          for (int i = 0; i < 8; ++i) x[i] *= rstd;
          *(u32x4*)(QN + (size_t)row * 512 + 8 * lane) = pack8(x); }
        { float x[8]; if (lane < 32) unpack8(kvw, x); else { for (int i = 0; i < 8; ++i) x[i] = 0.f; }
          float ss = 0.f;
#pragma unroll
          for (int i = 0; i < 8; ++i) ss += x[i] * x[i];
          ss = wsum64(ss); const float rstd = rsqrtf(ss * (1.0f / 256.0f) + NORM_EPS);
#pragma unroll
          for (int i = 0; i < 8; ++i) x[i] *= rstd;
          if (lane < 32) *(u32x4*)(KVN + (size_t)row * 256 + 8 * lane) = pack8(x); }
        { float x1[8], x2[8], o1[8], o2[8]; unpack8(kx1, x1); unpack8(kx2, x2);
#pragma unroll
          for (int i = 0; i < 8; ++i) { o1[i] = (x1[i] * kcc[i] - x2[i] * kss[i]) * 0.08838834764831845f; o2[i] = (x2[i] * kcc[i] + x1[i] * kss[i]) * 0.08838834764831845f; }
          *(u32x4*)kbase = pack8(o1); *(u32x4*)(kbase + 64) = pack8(o2); }
        if (lane < 32) { const float x1 = bf2f(kr1), x2 = bf2f(kr2); const float c = krc, s = krs;
            KR[(size_t)row * 64 + lane] = f2bf(x1 * c - x2 * s); KR[(size_t)row * 64 + 32 + lane] = f2bf(x2 * c + x1 * s); }
    }
}
__device__ __forceinline__ float sum8(float x) { x += dpp_xor1(x); x += dpp_xor2(x); x += dpp_hmirror(x); return x; }
__device__ __forceinline__ void ld8f(const float* p, float (&x)[8]) { const f32x4 a = *(const f32x4*)p, b = *(const f32x4*)(p + 4); x[0] = a[0]; x[1] = a[1]; x[2] = a[2]; x[3] = a[3]; x[4] = b[0]; x[5] = b[1]; x[6] = b[2]; x[7] = b[3]; }
__device__ __forceinline__ void ph_qrope(const Ctx& C) {
    bf16_t* Q = WSP(bf16_t, WS_Q); const float* rt = WSP(float, WS_ROPE); const float* cm = rt; const float* sm = rt + LSEQ * 32;
    const int lane = C.lane, hl = lane >> 3;
    for (int r0 = C.wg * 8 + C.wave; r0 < M; r0 += C.G * 16) {
        int rows[2]; bool ok[2]; rows[0] = r0; ok[0] = true; rows[1] = r0 + C.G * 8; ok[1] = rows[1] < M; if (!ok[1]) rows[1] = r0;
        u32x2 m1w[2], m2w[2];
#pragma unroll
        for (int rr = 0; rr < 2; ++rr) { const bf16_t* mb = Q + (size_t)rows[rr] * 1536 + hl * 192 + 128 + (lane & 7) * 4; m1w[rr] = *(const u32x2*)mb; m2w[rr] = *(const u32x2*)(mb + 32); }
#pragma unroll
        for (int rr = 0; rr < 2; ++rr) { if (!ok[rr]) continue;
            const int pos = rows[rr] % LSEQ; bf16_t* base = Q + (size_t)rows[rr] * 1536 + hl * 192 + 128 + (lane & 7) * 4; const u32x2 w1 = m1w[rr], w2 = m2w[rr];
            const f32x4 c4 = *(const f32x4*)(cm + pos * 32 + (lane & 7) * 4), s4 = *(const f32x4*)(sm + pos * 32 + (lane & 7) * 4);
            const float x1[4] = {bflo(w1.x), bfhi(w1.x), bflo(w1.y), bfhi(w1.y)}, x2[4] = {bflo(w2.x), bfhi(w2.x), bflo(w2.y), bfhi(w2.y)};
            float o1[4], o2[4];
#pragma unroll
            for (int i = 0; i < 4; ++i) { o1[i] = x1[i] * c4[i] - x2[i] * s4[i]; o2[i] = x2[i] * c4[i] + x1[i] * s4[i]; }
            *(u32x2*)base = (u32x2){cvt_pk_bf16(o1[0], o1[1]), cvt_pk_bf16(o1[2], o1[3])}; *(u32x2*)(base + 32) = (u32x2){cvt_pk_bf16(o2[0], o2[1]), cvt_pk_bf16(o2[2], o2[3])}; }
    }
}
__device__ __forceinline__ void ph_post(const Ctx& C, int l) {
    unsigned char* rw = C.ws + WS_RW; const float* YR = (const float*)(rw + RW_YRAW);
    const bf16_t* Gb = (const bf16_t*)(rw + RW_A + 1 * RW_ARR); const float* BS = (const float*)(rw + RW_A + 2 * RW_ARR); const bf16_t* P = WSP(bf16_t, WS_P);
    bf16_t* YA = WSP(bf16_t, WS_YBR);
    const float* mu_v = inp(C, IN_MU) + (size_t)l * RW_COLS + 2048; const float* ln_w = inp(C, IN_LN_W) + l * 1024; const float* ln_b = inp(C, IN_LN_B) + l * 1024;
    const int lane = C.lane, hl = lane >> 3, c8 = (lane & 7) * 8;
    for (int r0 = C.wg * 8 + C.wave; r0 < MP; r0 += C.G * 16) {
        int rows[2]; bool live[2]; rows[0] = r0; rows[1] = r0 + C.G * 8; live[0] = rows[0] < M; live[1] = rows[1] < M;
#pragma unroll
        for (int rr = 0; rr < 2; ++rr) if (rows[rr] < MP && !live[rr]) { const u32x4 z = zero4u(); *(u32x4*)(YA + (size_t)rows[rr] * 1024 + 16 * lane) = z; *(u32x4*)(YA + (size_t)rows[rr] * 1024 + 16 * lane + 8) = z; }
        u32x4 wv_[2][2], wp_[2][2], wg_[2][2]; f32x4 ya[2][2], yb[2][2]; float bsv[2][2], hpf[2];
#pragma unroll
        for (int rr = 0; rr < 2; ++rr) { const int row = live[rr] ? rows[rr] : 0; const bool hp = (row % LSEQ) > 0; hpf[rr] = hp ? 1.0f : 0.0f;
            const bf16_t* pr = P + (size_t)row * PN + 2048; const bf16_t* pp = hp ? pr - PN : pr;
#pragma unroll
            for (int ps = 0; ps < 2; ++ps) { const int c = (8 * ps + hl) * 64 + c8; const size_t o = (size_t)row * 1024 + c;
                ya[rr][ps] = *(const f32x4*)(YR + o); yb[rr][ps] = *(const f32x4*)(YR + o + 4); wv_[rr][ps] = *(const u32x4*)(pr + c); wp_[rr][ps] = *(const u32x4*)(pp + c); wg_[rr][ps] = *(const u32x4*)(Gb + o);
                bsv[rr][ps] = BS[(size_t)row * 16 + 8 * ps + hl]; } }
#pragma unroll
        for (int ps = 0; ps < 2; ++ps) {
            const int c = (8 * ps + hl) * 64 + c8; float mv[8], lw[8], lb[8];
            ld8f(mu_v + c, mv); ld8f(ln_w + c, lw); ld8f(ln_b + c, lb);
#pragma unroll
            for (int rr = 0; rr < 2; ++rr) {
                float y[8] = {ya[rr][ps][0], ya[rr][ps][1], ya[rr][ps][2], ya[rr][ps][3], yb[rr][ps][0], yb[rr][ps][1], yb[rr][ps][2], yb[rr][ps][3]}, zv[8], qv[8], gg[8], out[8];
                unpack8(wv_[rr][ps], zv); unpack8(wp_[rr][ps], qv); unpack8(wg_[rr][ps], gg);
                const float bs = bsv[rr][ps];
                float s = 0.f;
#pragma unroll
                for (int i = 0; i < 8; ++i) s += y[i];
                const float mean = sum8(s) * (1.0f / 64.0f);
                float q = 0.f;
#pragma unroll
                for (int i = 0; i < 8; ++i) { y[i] -= mean; q += y[i] * y[i]; }
                const float rstd = rsqrtf(sum8(q) * (1.0f / 64.0f) + GN_EPS);
#pragma unroll
                for (int i = 0; i < 8; ++i) { const float vv = zv[i] + (qv[i] * hpf[rr] - zv[i]) * mv[i]; out[i] = (y[i] * rstd * lw[i] + lb[i] + bs * vv) * gg[i]; }
                if (live[rr]) *(u32x4*)(YA + (size_t)rows[rr] * 1024 + c) = pack8(out);
            }
        }
    }
}

#define MFMA_DRAIN(acc) asm volatile("s_nop 15\n\ts_nop 4" : "+v"(acc))
__device__ __forceinline__ void ph_rwkvpre(const Ctx& C, int l) {
    constexpr int WSC = 10240;
    LAS unsigned char* sc = C.lds + C.wave * WSC;
    LAS float* Gm = (LAS float*)sc;
    LAS float* TM = (LAS float*)(sc + 4608);
    LAS float* TMT = TM + 256; LAS float* FT = TM + 512; LAS float* W2 = TM + 768; LAS float* YBT = TM + 1024;
    unsigned char* rw = C.ws + WS_RW;
    const float* WD = (const float*)(rw + RW_WDEC); const bf16_t* Ag = (const bf16_t*)(rw + RW_A); const bf16_t* P = WSP(bf16_t, WS_P);
    float* BS = (float*)(rw + RW_A + 2 * RW_ARR);
    const float* mu = inp(C, IN_MU) + (size_t)l * RW_COLS; const float* k_k = inp(C, IN_K_K) + l * 1024; const float* k_a = inp(C, IN_K_A) + l * 1024; const float* r_k = inp(C, IN_R_K) + l * 1024;
    unsigned char* RCH = C.ws + WS_RCH;
    const int lane = C.lane, ql = lane & 31, hh = lane >> 5, t = lane & 15, q4 = (lane >> 4) * 4;
    for (int u = C.wg * 8 + C.wave; u < NB * 16 * NCHUNK; u += C.G * 8) {
        const int bh = u / NCHUNK, c = u - bh * NCHUNK;
        const int hd = bh & 15, chn = hd * 64 + lane; const size_t row0 = (size_t)(bh >> 4) * LSEQ + 16 * c;
        unsigned char* rec = RCH + (size_t)u * RC_STRIDE;
        float Kb[16], Rb[16], Kh[16], Bh[16]; unsigned vpk[8]; float gC;
        {
            unsigned short zr[17], zk[17], zv[17], za[16]; float wv[16];
#pragma unroll
            for (int i = 0; i < 17; ++i) { const size_t pr = (row0 + (size_t)((i == 0 && c == 0) ? 0 : i - 1)) * PN + chn; zr[i] = P[pr]; zk[i] = P[pr + 1024]; zv[i] = P[pr + 2048]; }
#pragma unroll
            for (int i = 0; i < 16; ++i) { const size_t o = (row0 + i) * 1024 + chn; za[i] = Ag[o]; wv[i] = WD[o]; }
            const float mur = mu[chn], muk = mu[1024 + chn], muv = mu[2048 + chn], kkc = k_k[chn], kac = k_a[chn], rkc = r_k[chn];
            float g = 1.0f; float vxs[16]; int bsv = 0;
#pragma unroll
            for (int i = 0; i < 16; ++i) {
                const float hp = (i == 0 && c == 0) ? 0.0f : 1.0f;
                const float cr = bf2f(zr[i + 1]), ck = bf2f(zk[i + 1]), cv = bf2f(zv[i + 1]);
                const float rr = cr + (bf2f(zr[i]) * hp - cr) * mur, kx = ck + (bf2f(zk[i]) * hp - ck) * muk, vx = cv + (bf2f(zv[i]) * hp - cv) * muv;
                const float av = bf2f(za[i]);
                float kkx = kx * kkc; const float n2 = wsum64_dpp(kkx * kkx); kkx *= __builtin_amdgcn_rsqf(fmaxf(n2, 1e-24f));
                const float kpx = kx * (1.0f + (av - 1.0f) * kac), bbx = kkx * av;
                const float bs = wsum64_dpp(rr * kpx * rkc); bsv = (lane == i) ? __float_as_int(bs) : bsv;
                const float gp = g; g *= wv[i]; const float ig = __builtin_amdgcn_rcpf(g);
                Kb[i] = kkx * gp; Rb[i] = rr * g; Kh[i] = kpx * ig; Bh[i] = bbx * ig;
                vxs[i] = vx;
                *(LAS bf16_t*)(sc + i * 144 + lane * 2) = f2bf(Kh[i]); *(LAS bf16_t*)(sc + (16 + i) * 144 + lane * 2) = f2bf(Bh[i]);
                *(LAS bf16_t*)(sc + 4608 + i * 144 + lane * 2) = f2bf(Kb[i]); *(LAS bf16_t*)(sc + 4608 + (16 + i) * 144 + lane * 2) = f2bf(Rb[i]); }
#pragma unroll
            for (int i = 0; i < 16; ++i) { Kh[i] *= g; Bh[i] *= g; }
            gC = g;
#pragma unroll
            for (int i = 0; i < 8; ++i) vpk[i] = cvt_pk_bf16(vxs[2 * i], vxs[2 * i + 1]);
            if (lane < 16) BS[(row0 + lane) * 16 + hd] = __int_as_float(bsv);
        }
        __builtin_amdgcn_wave_barrier();
        {
            f32x16 acc;
#pragma unroll
            for (int r = 0; r < 16; ++r) acc[r] = 0.f;
#pragma unroll
            for (int s = 0; s < 4; ++s) { const bf16x8 a = *(const LAS bf16x8*)(sc + ql * 144 + 32 * s + 16 * hh); const bf16x8 bq = *(const LAS bf16x8*)(sc + 4608 + ql * 144 + 32 * s + 16 * hh);
                acc = __builtin_amdgcn_mfma_f32_32x32x16_bf16(a, bq, acc, 0, 0, 0); }
            __builtin_amdgcn_wave_barrier();
#pragma unroll
            for (int r = 0; r < 16; ++r) { const int row = (r & 3) + 8 * (r >> 2) + 4 * hh, i = row & 15; const bool keep = (ql >= 16) ? (i <= (ql & 15)) : (i < ql); Gm[row * 36 + ql] = keep ? acc[r] : 0.f; }
        }
        __builtin_amdgcn_wave_barrier();
        {
            float X[16];
#pragma unroll
            for (int i = 15; i >= 0; --i) { float x = (t == i) ? 1.0f : 0.0f; const LAS float* er = Gm + (16 + i) * 36;
#pragma unroll
                for (int j = i + 1; j < 16; ++j) x -= er[j] * X[j];
                X[i] = x; }
#pragma unroll
            for (int i = 0; i < 16; ++i) TM[i * 16 + t] = X[i];
#pragma unroll
            for (int i = 0; i < 4; ++i) *(LAS f32x4*)(TMT + t * 16 + 4 * i) = (f32x4){X[4 * i], X[4 * i + 1], X[4 * i + 2], X[4 * i + 3]};
            float E2c[16];
#pragma unroll
            for (int j = 0; j < 16; ++j) E2c[j] = Gm[(16 + j) * 36 + 16 + t];
#pragma unroll
            for (int e = 0; e < 4; ++e) { const LAS float* ar = Gm + (q4 + e) * 36; float s = 0.f;
#pragma unroll
                for (int i = 0; i < 16; ++i) s += ar[i] * X[i];
                W2[(q4 + e) * 16 + t] = s; }
            __builtin_amdgcn_wave_barrier();
            f32x4 fv, yv;
#pragma unroll
            for (int e = 0; e < 4; ++e) { const LAS float* tr = TM + (q4 + e) * 16; const LAS float* wr = W2 + (q4 + e) * 16; float s = 0.f, y = Gm[(q4 + e) * 36 + 16 + t];
#pragma unroll
                for (int j = 0; j < 16; ++j) { s += tr[j] * E2c[j]; y -= wr[j] * E2c[j]; }
                fv[e] = s; yv[e] = y; }
            *(LAS f32x4*)(FT + t * 16 + q4) = fv; *(LAS f32x4*)(YBT + t * 16 + q4) = yv;
        }
        __builtin_amdgcn_wave_barrier();
        {
            { unsigned char* b2 = rec + RC_B2 + lane * 80;
              *(u32x4*)(b2) = (u32x4){cvt_pk_bf16(-Bh[0], -Bh[1]), cvt_pk_bf16(-Bh[2], -Bh[3]), cvt_pk_bf16(-Bh[4], -Bh[5]), cvt_pk_bf16(-Bh[6], -Bh[7])};
              *(u32x4*)(b2 + 16) = (u32x4){cvt_pk_bf16(-Bh[8], -Bh[9]), cvt_pk_bf16(-Bh[10], -Bh[11]), cvt_pk_bf16(-Bh[12], -Bh[13]), cvt_pk_bf16(-Bh[14], -Bh[15])}; }
            u32x4 kb0, kb1, rb0, rb1, bh0, bh1, kh0, kh1;
#define RC_BOP(src_, t0_, t1_) do { _Pragma("unroll") for (int e = 0; e < 4; ++e) { const unsigned x_ = cvt_pk_bf16(src_[2 * e], src_[2 * e + 1]), y_ = cvt_pk_bf16(src_[8 + 2 * e], src_[9 + 2 * e]); \
                const auto sw_ = __builtin_amdgcn_permlane32_swap(x_, y_, false, false); t0_[e] = sw_[0]; t1_[e] = sw_[1]; } } while (0)
            RC_BOP(Kb, kb0, kb1); RC_BOP(Rb, rb0, rb1); RC_BOP(Bh, bh0, bh1); RC_BOP(Kh, kh0, kh1);
#undef RC_BOP
            const bool lo16 = ql < 16; const int m16 = ql & 15;
            u32x4 aPA, aPB, aIlo, aIhi;
            { const LAS float* ap = (lo16 ? TMT : FT) + m16 * 16 + 8 * hh; const f32x4 a0 = *(const LAS f32x4*)ap, a1 = *(const LAS f32x4*)(ap + 4); const float sg = lo16 ? 1.0f : -1.0f;
              aPA = (u32x4){cvt_pk_bf16(a0[0] * sg, a0[1] * sg), cvt_pk_bf16(a0[2] * sg, a0[3] * sg), cvt_pk_bf16(a1[0] * sg, a1[1] * sg), cvt_pk_bf16(a1[2] * sg, a1[3] * sg)};
              const LAS float* wp = W2 + m16 * 16 + 8 * hh; const f32x4 w0 = *(const LAS f32x4*)wp, w1 = *(const LAS f32x4*)(wp + 4); const float sw = lo16 ? -1.0f : 0.0f;
              aPB = (u32x4){cvt_pk_bf16(w0[0] * sw, w0[1] * sw), cvt_pk_bf16(w0[2] * sw, w0[3] * sw), cvt_pk_bf16(w1[0] * sw, w1[1] * sw), cvt_pk_bf16(w1[2] * sw, w1[3] * sw)};
#pragma unroll
              for (int e = 0; e < 4; ++e) { const unsigned idv = (m16 == 8 * hh + 2 * e ? 0x3F80u : 0u) | (m16 == 8 * hh + 2 * e + 1 ? 0x3F800000u : 0u); aIlo[e] = lo16 ? idv : 0u; aIhi[e] = lo16 ? 0u : idv; } }
            bf16x8 fa, fb, fc, fi;
            bf16_t* b1 = (bf16_t*)rec + ql + (4 * hh) * 88;
            unsigned char* q0 = rec + RC_B2 + ql * 80 + 32 + 8 * hh;
            __builtin_memcpy(&fa, &aPA, 16); __builtin_memcpy(&fi, &aIhi, 16);
#pragma unroll
            for (int T = 0; T < 2; ++T) {
                f32x16 pa;
#pragma unroll
                for (int r = 0; r < 16; ++r) pa[r] = 0.f;
                __builtin_memcpy(&fb, T ? &kb1 : &kb0, 16); __builtin_memcpy(&fc, T ? &rb1 : &rb0, 16);
                pa = __builtin_amdgcn_mfma_f32_32x32x16_bf16(fa, fb, pa, 0, 0, 0); pa = __builtin_amdgcn_mfma_f32_32x32x16_bf16(fi, fc, pa, 0, 0, 0);
                MFMA_DRAIN(pa);
#pragma unroll
                for (int r = 0; r < 16; ++r) b1[((r & 3) + 8 * (r >> 2)) * 88 + 32 * T] = f2bf(pa[r]);
            }
            __builtin_memcpy(&fa, &aPB, 16); __builtin_memcpy(&fi, &aIlo, 16);
#pragma unroll
            for (int T = 0; T < 2; ++T) {
                f32x16 pb;
#pragma unroll
                for (int r = 0; r < 16; ++r) pb[r] = 0.f;
                __builtin_memcpy(&fb, T ? &bh1 : &bh0, 16); __builtin_memcpy(&fc, T ? &kh1 : &kh0, 16);
                pb = __builtin_amdgcn_mfma_f32_32x32x16_bf16(fa, fb, pb, 0, 0, 0); pb = __builtin_amdgcn_mfma_f32_32x32x16_bf16(fi, fc, pb, 0, 0, 0);
                MFMA_DRAIN(pb);
                *(u32x2*)(q0 + T * 32 * 80) = (u32x2){cvt_pk_bf16(pb[0], pb[1]), cvt_pk_bf16(pb[2], pb[3])}; *(u32x2*)(q0 + T * 32 * 80 + 16) = (u32x2){cvt_pk_bf16(pb[4], pb[5]), cvt_pk_bf16(pb[6], pb[7])};
            }
            { const int tr_ = lane >> 2, part = lane & 3; const f32x4 y4 = *(const LAS f32x4*)(YBT + tr_ * 16 + 4 * part);
              unsigned zz; asm volatile("v_mov_b32 %0, 0" : "=v"(zz));
              *(u32x2*)(rec + tr_ * 176 + 128 + 8 * part) = (u32x2){zz, zz};
              *(u32x2*)(rec + (16 + tr_) * 176 + 128 + 8 * part) = (u32x2){cvt_pk_bf16(y4[0], y4[1]), cvt_pk_bf16(y4[2], y4[3])}; }
            unsigned char* vt = rec + RC_VT + lane * 48;
            *(u32x4*)(vt) = (u32x4){vpk[0], vpk[1], vpk[2], vpk[3]}; *(u32x4*)(vt + 16) = (u32x4){vpk[4], vpk[5], vpk[6], vpk[7]};
            *(float*)(rec + RC_G + 4 * lane) = gC;
        }
        __builtin_amdgcn_wave_barrier();
    }
    __syncthreads();
}

#define SEQ_BAR() asm volatile("s_waitcnt lgkmcnt(0)\n\ts_barrier" ::: "memory")
__device__ __forceinline__ void rwkv_seq_unit(const Ctx& C, int b, int hd) {
    constexpr int NR = 8, PF = 6;
    LAS unsigned char* ring = C.lds; LAS unsigned char* Zi = C.lds + NR * RC_STRIDE; LAS unsigned char* Ui = Zi + 64 * 144;
    const unsigned char* recs = C.ws + WS_RCH + (size_t)(b * 16 + hd) * NCHUNK * RC_STRIDE;
    float* YR = (float*)(C.ws + WS_RW + RW_YRAW) + (size_t)b * LSEQ * 1024 + hd * 64;
    const int tid = C.tid, w = C.wave, lane = C.lane, ql = lane & 31, hh = lane >> 5;
    const int lw = w - 4;
    for (int i = tid; i < 576; i += 512) *(LAS u32x4*)(Zi + 16 * i) = zero4u();
    auto issue = [&](int c) {
        const unsigned char* src = recs + (size_t)c * RC_STRIDE + lane * 16; LAS unsigned char* dst = ring + (c & (NR - 1)) * RC_STRIDE;
#pragma unroll
        for (int k = 0; k < 4; ++k) { const int q = lw + 4 * k; if (q < 14) __builtin_amdgcn_global_load_lds((const unsigned*)(src + q * 1024), (LAS unsigned*)(dst + q * 1024), 16, 0, 0); }
    };
    if (w >= 4) {
#pragma unroll
        for (int c = 0; c < PF; ++c) issue(c);
        if (lw < 2) asm volatile("s_waitcnt vmcnt(20)" ::: "memory"); else asm volatile("s_waitcnt vmcnt(15)" ::: "memory");
    }
    f32x16 Zt;
    { float zf; asm volatile("v_mov_b32 %0, 0" : "=v"(zf));
#pragma unroll
      for (int r = 0; r < 16; ++r) Zt[r] = zf; }
    __syncthreads();
    for (int c = 0; c < NCHUNK; ++c) {
        const LAS unsigned char* rec = ring + (c & (NR - 1)) * RC_STRIDE;
        if (w < 2) {
            f32x16 p;
#pragma unroll
            for (int r = 0; r < 16; ++r) p[r] = 0.f;
            const LAS unsigned char* ap = rec + RC_B1 + ql * 176 + hh * 16; const LAS unsigned char* bp = Zi + (32 * w + ql) * 144 + hh * 16;
#pragma unroll
            for (int s = 0; s < 4; ++s) { const bf16x8 a = *(const LAS bf16x8*)(ap + 32 * s); const bf16x8 bq = *(const LAS bf16x8*)(bp + 32 * s); p = __builtin_amdgcn_mfma_f32_32x32x16_bf16(a, bq, p, 0, 0, 0); }
            { const bf16x8 a = *(const LAS bf16x8*)(ap + 128); const bf16x8 bq = *(const LAS bf16x8*)(rec + RC_VT + (32 * w + ql) * 48 + hh * 16); p = __builtin_amdgcn_mfma_f32_32x32x16_bf16(a, bq, p, 0, 0, 0); }
            MFMA_DRAIN(p);
            LAS unsigned char* up = Ui + (32 * w + ql) * 48 + hh * 8;
            *(LAS u32x2*)up = (u32x2){cvt_pk_bf16(p[0], p[1]), cvt_pk_bf16(p[2], p[3])}; *(LAS u32x2*)(up + 16) = (u32x2){cvt_pk_bf16(p[4], p[5]), cvt_pk_bf16(p[6], p[7])};
            float* yp = YR + (size_t)(16 * c + 4 * hh) * 1024 + 32 * w + ql;
#pragma unroll
            for (int r = 8; r < 16; ++r) yp[((r & 3) + 8 * ((r - 8) >> 2)) * 1024] = p[r];
        } else if (w >= 4) {
            if (c + PF < NCHUNK) issue(c + PF);
        }
        SEQ_BAR();
        if (w < 4) {
            const int ti = w >> 1, tj = w & 1;
            const LAS float* gp = (const LAS float*)(rec + RC_G) + 32 * ti + 4 * hh;
#pragma unroll
            for (int q = 0; q < 4; ++q) { const f32x4 g4 = *(const LAS f32x4*)(gp + 8 * q); Zt[4 * q] *= g4[0]; Zt[4 * q + 1] *= g4[1]; Zt[4 * q + 2] *= g4[2]; Zt[4 * q + 3] *= g4[3]; }
            const LAS unsigned char* ap = rec + RC_B2 + (32 * ti + ql) * 80 + hh * 16;
            const bf16x8 a0 = *(const LAS bf16x8*)ap, a1 = *(const LAS bf16x8*)(ap + 32);
            const bf16x8 b0 = *(const LAS bf16x8*)(Ui + (32 * tj + ql) * 48 + hh * 16), b1 = *(const LAS bf16x8*)(rec + RC_VT + (32 * tj + ql) * 48 + hh * 16);
            Zt = __builtin_amdgcn_mfma_f32_32x32x16_bf16(a0, b0, Zt, 0, 0, 0);
            Zt = __builtin_amdgcn_mfma_f32_32x32x16_bf16(a1, b1, Zt, 0, 0, 0);
            MFMA_DRAIN(Zt);
            LAS unsigned char* zp = Zi + (32 * tj + ql) * 144 + (32 * ti + 4 * hh) * 2;
#pragma unroll
            for (int q = 0; q < 4; ++q) *(LAS u32x2*)(zp + 16 * q) = (u32x2){cvt_pk_bf16(Zt[4 * q], Zt[4 * q + 1]), cvt_pk_bf16(Zt[4 * q + 2], Zt[4 * q + 3])};
        } else {
            if (c + PF < NCHUNK) { if (lw < 2) asm volatile("s_waitcnt vmcnt(20)" ::: "memory"); else asm volatile("s_waitcnt vmcnt(15)" ::: "memory"); }
            else asm volatile("s_waitcnt vmcnt(0)" ::: "memory");
        }
        SEQ_BAR();
    }
}

template <int MODE>
__device__ __forceinline__ void attn_unit(const Ctx& C, int b, int hd, int qblk) {
    constexpr int DQ = MODE == 0 ? 192 : 128, NS = DQ / 16, KP = DQ * 2 + 16, VP = 136;
    constexpr int KB_BYTES = 64 * KP, VB_BYTES = 128 * VP, NKPC = 64 * (DQ / 8) / 512;
    LAS unsigned char* Kb = C.lds; LAS unsigned char* Vbuf = C.lds + 2 * KB_BYTES;
    const bf16_t* P = WSP(bf16_t, WS_P); const bf16_t* Qm = WSP(bf16_t, WS_Q); const bf16_t* KN = WSP(bf16_t, WS_KNOPE); const bf16_t* KRp = WSP(bf16_t, WS_KR);
    const bf16_t* VT = MODE == 0 ? WSP(bf16_t, WS_VTMLA) : WSP(bf16_t, WS_VTRET);
    bf16_t* Y = WSP(bf16_t, WS_YBR) + (MODE == 0 ? 2 : 1) * (size_t)MP * 1024;
    const int tid = C.tid, w = C.wave, lane = C.lane, ql = lane & 31, hh = lane >> 5;
    const size_t rb = (size_t)b * LSEQ;
    const int qpos = 256 * qblk + 32 * w + ql; const bool qvalid = qpos < LSEQ; const int qposc = qvalid ? qpos : LSEQ - 1;
    const int wqmin = 256 * qblk + 32 * w; const bool wactive = wqmin < LSEQ; const int wqmax = (wqmin + 31 < LSEQ - 1) ? wqmin + 31 : LSEQ - 1;
    const int nkt = (4 * qblk + 4 < 65) ? 4 * qblk + 4 : 65;
    const int j0 = MODE == 1 ? 4 * qblk : 0;
    bf16x8 Qf[NS];
    { const bf16_t* qrow = MODE == 0 ? Qm + (rb + qposc) * 1536 + hd * 192 : P + (rb + qposc) * PN + P_QRET + hd * 128;
#pragma unroll
      for (int s = 0; s < NS; ++s) Qf[s] = *(const bf16x8*)(qrow + 16 * s + 8 * hh); }
    if (MODE == 1) {
        const float* rt = WSP(float, WS_ROPE);
        constexpr int NP = MODE == 0 ? 2 : 4, S0 = MODE == 0 ? 8 : 0, DS = MODE == 0 ? 2 : 4;
        const float* cp = MODE == 0 ? rt + (size_t)qposc * 32 + 8 * hh : rt + (size_t)LSEQ * 64 + (size_t)qposc * 64 + 8 * hh;
        const float* sp = MODE == 0 ? rt + (size_t)LSEQ * 32 + (size_t)qposc * 32 + 8 * hh : rt + (size_t)LSEQ * 128 + (size_t)qposc * 64 + 8 * hh;
#pragma unroll
        for (int s = 0; s < NP; ++s) { u32x4 w1, w2; __builtin_memcpy(&w1, &Qf[S0 + s], 16); __builtin_memcpy(&w2, &Qf[S0 + s + DS], 16);
            float x1[8], x2[8], cc[8], ss[8], o1[8], o2[8]; unpack8(w1, x1); unpack8(w2, x2); ld8f(cp + 16 * s, cc); ld8f(sp + 16 * s, ss);
#pragma unroll
            for (int e = 0; e < 8; ++e) { o1[e] = x1[e] * cc[e] - x2[e] * ss[e]; o2[e] = x2[e] * cc[e] + x1[e] * ss[e]; }
            w1 = pack8(o1); w2 = pack8(o2); __builtin_memcpy(&Qf[S0 + s], &w1, 16); __builtin_memcpy(&Qf[S0 + s + DS], &w2, 16); }
    }
    f32x16 O[4];
#pragma unroll
    for (int d = 0; d < 4; ++d)
#pragma unroll
        for (int r = 0; r < 16; ++r) O[d][r] = 0.f;
    float m_run = -INFINITY, lsum = 0.f;
    const float csm = 0.07216878364870322f * 1.4426950408889634f;
    const float lg2g = MODE == 1 ? log1pf(-exp2f(-5.0f - (float)hd)) * 1.4426950408889634f : 0.f;
    u32x4 kreg[NKPC], vreg[2];
    auto gload = [&](int j) {
#pragma unroll
        for (int i = 0; i < NKPC; ++i) { const int pi = tid + i * 512, r = pi / (DQ / 8), c = pi % (DQ / 8); const size_t krow = rb + 64 * j + r;
            const bf16_t* sp;
            if (MODE == 0) sp = (c < 16) ? KN + krow * 1024 + hd * 128 + 8 * c : KRp + krow * 64 + 8 * (c - 16);
            else sp = P + krow * PN + P_KRET + hd * 128 + 8 * c;
            kreg[i] = *(const u32x4*)sp; }
#pragma unroll
        for (int i = 0; i < 2; ++i) { const int pi = tid + i * 512, dv = pi >> 3, c = pi & 7; vreg[i] = *(const u32x4*)(VT + (size_t)(hd * 128 + dv) * MP + rb + 64 * j + 8 * c); }
    };
    auto lstore = [&](int buf) {
#pragma unroll
        for (int i = 0; i < NKPC; ++i) { const int pi = tid + i * 512, r = pi / (DQ / 8), c = pi % (DQ / 8); *(LAS u32x4*)(Kb + buf * KB_BYTES + r * KP + 16 * c) = kreg[i]; }
#pragma unroll
        for (int i = 0; i < 2; ++i) { const int pi = tid + i * 512, dv = pi >> 3, c = pi & 7; LAS unsigned char* dp = Vbuf + buf * VB_BYTES + dv * VP + 16 * c;
            *(LAS u32x2*)dp = (u32x2){vreg[i].x, vreg[i].y}; *(LAS u32x2*)(dp + 8) = (u32x2){vreg[i].z, vreg[i].w}; }
    };
    gload(j0);
    if (MODE == 1 && qblk > 0) {
        constexpr int RP = 272; LAS unsigned char* RT = C.lds + 2 * KB_BYTES + 2 * VB_BYTES;
        const float* KVT = WSP(float, WS_KVT) + (size_t)((b * 8 + hd) * 16) * 16384;
        const int dvr = tid >> 2, d0 = (tid & 3) * 32;
        f32x4 acc8[8];
#pragma unroll
        for (int i = 0; i < 8; ++i) acc8[i] = (f32x4){0.f, 0.f, 0.f, 0.f};
#pragma unroll 2
        for (int kp = 0; kp < qblk; ++kp) { const float f = __builtin_amdgcn_exp2f(lg2g * 256.0f * (float)(qblk - 1 - kp)); const float* sp = KVT + (size_t)kp * 16384 + dvr * 128 + d0;
#pragma unroll
            for (int i = 0; i < 8; ++i) acc8[i] = acc8[i] + *(const f32x4*)(sp + 4 * i) * f; }
#pragma unroll
        for (int i = 0; i < 4; ++i) { u32x4 wv; wv.x = cvt_pk_bf16(acc8[2 * i][0], acc8[2 * i][1]); wv.y = cvt_pk_bf16(acc8[2 * i][2], acc8[2 * i][3]); wv.z = cvt_pk_bf16(acc8[2 * i + 1][0], acc8[2 * i + 1][1]); wv.w = cvt_pk_bf16(acc8[2 * i + 1][2], acc8[2 * i + 1][3]);
            *(LAS u32x4*)(RT + dvr * RP + (d0 + 8 * i) * 2) = wv; }
        __syncthreads();
        if (wactive) {
#pragma unroll
            for (int d = 0; d < 4; ++d)
#pragma unroll
                for (int s = 0; s < NS; ++s) { const bf16x8 a = *(const LAS bf16x8*)(RT + (32 * d + ql) * RP + (16 * s + 8 * hh) * 2); O[d] = __builtin_amdgcn_mfma_f32_32x32x16_bf16(a, Qf[s], O[d], 0, 0, 0); }
            const float fq = __builtin_amdgcn_exp2f(lg2g * (float)(qposc - 256 * qblk + 1));
#pragma unroll
            for (int d = 0; d < 4; ++d)
#pragma unroll
                for (int r = 0; r < 16; ++r) O[d][r] *= fq;
        }
    }
    lstore(0);
    __syncthreads();
    for (int j = j0; j < nkt; ++j) {
        if (j + 1 < nkt) gload(j + 1);
        if (wactive && 64 * j <= wqmax) {
            const LAS unsigned char* kb = Kb + ((j - j0) & 1) * KB_BYTES; const LAS unsigned char* vb = Vbuf + ((j - j0) & 1) * VB_BYTES;
            f32x16 st[2];
#pragma unroll
            for (int kt = 0; kt < 2; ++kt) {
#pragma unroll
                for (int r = 0; r < 16; ++r) st[kt][r] = 0.f;
#pragma unroll
                for (int s = 0; s < NS; ++s) { const bf16x8 a = *(const LAS bf16x8*)(kb + (32 * kt + ql) * KP + (16 * s + 8 * hh) * 2); st[kt] = __builtin_amdgcn_mfma_f32_32x32x16_bf16(a, Qf[s], st[kt], 0, 0, 0); }
            }
            const int kbase = 64 * j + 4 * hh;
            if (MODE == 0) {
                if (64 * j + 63 > wqmin) {
#pragma unroll
                    for (int kt = 0; kt < 2; ++kt)
#pragma unroll
                        for (int r = 0; r < 16; ++r) { const int kpos = kbase + 32 * kt + (r & 3) + 8 * (r >> 2); if (kpos > qposc) st[kt][r] = -INFINITY; }
                }
                float tm0 = fmaxf(st[0][0], st[1][0]), tm1 = fmaxf(st[0][1], st[1][1]);
#pragma unroll
                for (int r = 2; r < 16; r += 2) { tm0 = fmaxf(tm0, fmaxf(st[0][r], st[1][r])); tm1 = fmaxf(tm1, fmaxf(st[0][r + 1], st[1][r + 1])); }
                const float tmax = hmax32(fmaxf(tm0, tm1));
                if (__builtin_amdgcn_ballot_w64(tmax > m_run) != 0ull) {
                    const float m_new = fmaxf(m_run, tmax);
                    const float alpha = __builtin_amdgcn_exp2f((m_run - m_new) * csm);
                    m_run = m_new; lsum *= alpha;
#pragma unroll
                    for (int d = 0; d < 4; ++d)
#pragma unroll
                        for (int r = 0; r < 16; ++r) O[d][r] *= alpha;
                }
                const float mb = m_run * csm;
                float ps = 0.f;
#pragma unroll
                for (int kt = 0; kt < 2; ++kt)
#pragma unroll
                    for (int r = 0; r < 16; ++r) { const float p = __builtin_amdgcn_exp2f(st[kt][r] * csm - mb); st[kt][r] = p; ps += p; }
                lsum += ps;
            } else {
#pragma unroll
                for (int kt = 0; kt < 2; ++kt)
#pragma unroll
                    for (int r = 0; r < 16; ++r) { const int kpos = kbase + 32 * kt + (r & 3) + 8 * (r >> 2); const int dd = qposc - kpos;
                        st[kt][r] = dd >= 0 ? st[kt][r] * __builtin_amdgcn_exp2f(lg2g * (float)dd) : 0.f; }
            }
#pragma unroll
            for (int kt = 0; kt < 2; ++kt)
#pragma unroll
                for (int s2 = 0; s2 < 2; ++s2) {
                    u32x4 pw; pw.x = cvt_pk_bf16(st[kt][8 * s2 + 0], st[kt][8 * s2 + 1]); pw.y = cvt_pk_bf16(st[kt][8 * s2 + 2], st[kt][8 * s2 + 3]);
                    pw.z = cvt_pk_bf16(st[kt][8 * s2 + 4], st[kt][8 * s2 + 5]); pw.w = cvt_pk_bf16(st[kt][8 * s2 + 6], st[kt][8 * s2 + 7]);
                    bf16x8 pf; __builtin_memcpy(&pf, &pw, 16);
#pragma unroll
                    for (int d = 0; d < 4; ++d) { const LAS unsigned char* ap = vb + (32 * d + ql) * VP + (32 * kt + 16 * s2 + 4 * hh) * 2;
                        const u32x2 lo = *(const LAS u32x2*)ap, hi = *(const LAS u32x2*)(ap + 16); u32x4 aw = (u32x4){lo.x, lo.y, hi.x, hi.y}; bf16x8 af; __builtin_memcpy(&af, &aw, 16);
                        O[d] = __builtin_amdgcn_mfma_f32_32x32x16_bf16(af, pf, O[d], 0, 0, 0); }
                }
        }
        if (j + 1 < nkt) lstore((j + 1 - j0) & 1);
        __syncthreads();
    }
    if (MODE == 0) {
        const float lt = hsum32(lsum); const float inv = 1.0f / lt;
        if (qvalid) { bf16_t* yp = Y + (rb + qpos) * 1024 + hd * 128;
#pragma unroll
            for (int d = 0; d < 4; ++d)
#pragma unroll
                for (int rg = 0; rg < 4; ++rg) { const int dv0 = 32 * d + 8 * rg + 4 * hh;
                    *(u32x2*)(yp + dv0) = (u32x2){cvt_pk_bf16(O[d][4 * rg] * inv, O[d][4 * rg + 1] * inv), cvt_pk_bf16(O[d][4 * rg + 2] * inv, O[d][4 * rg + 3] * inv)}; } }
    } else {
        u32x2 gws[4][4];
        { const bf16_t* gp = P + (rb + qposc) * PN + P_GRET + hd * 128 + 4 * hh;
#pragma unroll
          for (int d = 0; d < 4; ++d)
#pragma unroll
              for (int rg = 0; rg < 4; ++rg) gws[d][rg] = *(const u32x2*)(gp + 32 * d + 8 * rg); }
        float ss = 0.f;
#pragma unroll
        for (int d = 0; d < 4; ++d)
#pragma unroll
            for (int r = 0; r < 16; ++r) ss += O[d][r] * O[d][r];
        ss = hsum32(ss); const float rstd = rsqrtf(ss * (1.0f / 128.0f) + NORM_EPS);
        if (qvalid) { bf16_t* yp = Y + (rb + qpos) * 1024 + hd * 128;
#pragma unroll
            for (int d = 0; d < 4; ++d)
#pragma unroll
                for (int rg = 0; rg < 4; ++rg) { const int dv0 = 32 * d + 8 * rg + 4 * hh; const u32x2 gw = gws[d][rg];
                    const float g0 = bflo(gw.x), g1 = bfhi(gw.x), g2 = bflo(gw.y), g3 = bfhi(gw.y);
                    const float o0 = O[d][4 * rg] * rstd * g0 * sigmoidf_(g0), o1 = O[d][4 * rg + 1] * rstd * g1 * sigmoidf_(g1), o2 = O[d][4 * rg + 2] * rstd * g2 * sigmoidf_(g2), o3 = O[d][4 * rg + 3] * rstd * g3 * sigmoidf_(g3);
                    *(u32x2*)(yp + dv0) = (u32x2){cvt_pk_bf16(o0, o1), cvt_pk_bf16(o2, o3)}; } }
    }
}

__device__ __forceinline__ void ph_retkv(const Ctx& C) {
    constexpr int VP = 136, TB = 128 * VP;
    LAS unsigned char* Vb = C.lds; LAS unsigned char* Kt = C.lds + TB;
    const bf16_t* P = WSP(bf16_t, WS_P); const bf16_t* VT = WSP(bf16_t, WS_VTRET); float* KVT = WSP(float, WS_KVT);
    const int tid = C.tid, w = C.wave, lane = C.lane, ql = lane & 31, hh = lane >> 5;
    for (int u = C.wg; u < NB * 8 * 16; u += C.G) {
        const int b = u >> 7, hd = (u >> 4) & 7, kb = u & 15; const size_t rb = (size_t)b * LSEQ + 256 * kb;
        const float lg2g = log1pf(-exp2f(-5.0f - (float)hd)) * 1.4426950408889634f;
        f32x16 acc[2];
#pragma unroll
        for (int r = 0; r < 16; ++r) { acc[0][r] = 0.f; acc[1][r] = 0.f; }
        for (int j = 0; j < 4; ++j) {
            __syncthreads();
#pragma unroll
            for (int i = 0; i < 2; ++i) { const int pi = tid + i * 512;
                { const int dv = pi >> 3, c = pi & 7; const u32x4 v = *(const u32x4*)(VT + (size_t)(hd * 128 + dv) * MP + rb + 64 * j + 8 * c); LAS unsigned char* dp = Vb + dv * VP + 16 * c;
                  *(LAS u32x2*)dp = (u32x2){v.x, v.y}; *(LAS u32x2*)(dp + 8) = (u32x2){v.z, v.w}; }
                { const int key = pi >> 4, c = pi & 15; float x[8]; unpack8(*(const u32x4*)(P + (rb + 64 * j + key) * PN + P_KRET + hd * 128 + 8 * c), x);
                  const float f = __builtin_amdgcn_exp2f(lg2g * (float)(255 - 64 * j - key));
#pragma unroll
                  for (int e = 0; e < 8; ++e) *(LAS bf16_t*)(Kt + (8 * c + e) * VP + key * 2) = f2bf(x[e] * f); } }
            __syncthreads();
#pragma unroll
            for (int s = 0; s < 4; ++s) {
                const LAS unsigned char* ap = Vb + (32 * (w >> 1) + ql) * VP + (16 * s + 8 * hh) * 2; const u32x2 alo = *(const LAS u32x2*)ap, ahi = *(const LAS u32x2*)(ap + 8);
                u32x4 aw = (u32x4){alo.x, alo.y, ahi.x, ahi.y}; bf16x8 af; __builtin_memcpy(&af, &aw, 16);
#pragma unroll
                for (int t = 0; t < 2; ++t) { const LAS unsigned char* bp = Kt + (32 * (2 * (w & 1) + t) + ql) * VP + (16 * s + 8 * hh) * 2; const u32x2 blo = *(const LAS u32x2*)bp, bhi = *(const LAS u32x2*)(bp + 8);
                    u32x4 bw = (u32x4){blo.x, blo.y, bhi.x, bhi.y}; bf16x8 bf; __builtin_memcpy(&bf, &bw, 16);
                    acc[t] = __builtin_amdgcn_mfma_f32_32x32x16_bf16(af, bf, acc[t], 0, 0, 0); }
            }
        }
        float* op = KVT + (size_t)u * 16384;
#pragma unroll
        for (int t = 0; t < 2; ++t)
#pragma unroll
            for (int r = 0; r < 16; ++r) { const int dv = 32 * (w >> 1) + (r & 3) + 8 * (r >> 2) + 4 * hh; op[dv * 128 + 32 * (2 * (w & 1) + t) + ql] = acc[t][r]; }
    }
    __syncthreads();
}

__device__ __forceinline__ int q_pop(const Ctx& C, unsigned* head) {
    volatile LAS int* item = (volatile LAS int*)(C.lds + LDS_MISC + 64);
    __syncthreads();
    if (C.tid == 0) *item = (int)__hip_atomic_fetch_add(head, 1u, __ATOMIC_RELAXED, __HIP_MEMORY_SCOPE_AGENT);
    __syncthreads();
    return *item;
}
__device__ __forceinline__ void ph_mix(const Ctx& C, int l) {
    unsigned* head = C.ctl + CW_QUEUE + 256 * l;
    for (;;) { const int it = q_pop(C, head); if (it >= 64) break; rwkv_seq_unit(C, it >> 4, it & 15); }
    for (;;) { const int it = q_pop(C, head + 128); if (it >= 17 * 32) break; attn_unit<1>(C, (it & 31) >> 3, it & 7, 16 - (it >> 5)); }
    for (;;) { const int it = q_pop(C, head + 64); if (it >= 17 * 32) break; attn_unit<0>(C, (it & 31) >> 3, it & 7, 16 - (it >> 5)); }
}

constexpr int MMAIN = 16384;
template <int KIND>
__device__ __forceinline__ void tail_units(const Ctx& C, const bf16_t* A, const bf16_t* Bt, const int K, const int nunits, bf16_t* Hb, bf16_t* Ob, const bf16_t* P) {
    constexpr int NB = KIND == 1 ? 2 : 1, NBR = KIND == 2 ? 3 : 1;
    const int ql = C.lane & 31, hh = C.lane >> 5, w = C.wave; const int KS = K / 8;
    LAS float* red = (LAS float*)C.lds;
    for (int t = C.wg; t < nunits; t += C.G) {
        float tot[4] = {0.f, 0.f, 0.f, 0.f};
        for (int br = 0; br < NBR; ++br) {
        f32x16 acc[NB][2];
#pragma unroll
        for (int q = 0; q < NB; ++q)
#pragma unroll
            for (int r = 0; r < 16; ++r) { acc[q][0][r] = 0.f; acc[q][1][r] = 0.f; }
        const bf16_t* Au = (KIND == 2) ? A + (size_t)br * MP * 1024 : A;
        const bf16_t* a0 = Au + (size_t)(MMAIN + ql) * K + w * KS + 8 * hh;
        const bf16_t* bp[NB];
        if (KIND == 1) { const int j = 32 * t + ql; const int grow = 8 * (j >> 2) + (j & 3); bp[0] = Bt + (size_t)grow * K + w * KS + 8 * hh; bp[NB - 1] = Bt + (size_t)(grow + 4) * K + w * KS + 8 * hh; }
        else bp[0] = Bt + (size_t)(br * 2048 + 32 * t + ql) * K + w * KS + 8 * hh;
        for (int k = 0; k < KS; k += 64) { bf16x8 af0[4], af1[4], bfr[NB][4];
#pragma unroll
            for (int u = 0; u < 4; ++u) { af0[u] = *(const bf16x8*)(a0 + k + 16 * u); af1[u] = *(const bf16x8*)(a0 + (size_t)32 * K + k + 16 * u);
#pragma unroll
                for (int q = 0; q < NB; ++q) bfr[q][u] = *(const bf16x8*)(bp[q] + k + 16 * u); }
#pragma unroll
            for (int u = 0; u < 4; ++u)
#pragma unroll
                for (int q = 0; q < NB; ++q) { acc[q][0] = __builtin_amdgcn_mfma_f32_32x32x16_bf16(af0[u], bfr[q][u], acc[q][0], 0, 0, 0); acc[q][1] = __builtin_amdgcn_mfma_f32_32x32x16_bf16(af1[u], bfr[q][u], acc[q][1], 0, 0, 0); } }
        __syncthreads();
#pragma unroll
        for (int q = 0; q < NB; ++q)
#pragma unroll
            for (int hf = 0; hf < 2; ++hf)
#pragma unroll
                for (int r = 0; r < 16; ++r) red[((q * 8 + w) * 32 + hf * 16 + r) * 64 + C.lane] = acc[q][hf][r];
        __syncthreads();
#pragma unroll
        for (int i = 0; i < 4; ++i) { const int hr = 4 * w + i, hf = hr >> 4, r = hr & 15; float s0 = 0.f, s1 = 0.f;
#pragma unroll
            for (int ww = 0; ww < 8; ++ww) { s0 += red[(ww * 32 + hr) * 64 + C.lane]; if (NB == 2) s1 += red[((8 + ww) * 32 + hr) * 64 + C.lane]; }
            const int row = MMAIN + 32 * hf + (r & 3) + 8 * (r >> 2) + 4 * hh; const int c = 32 * t + ql;
            if (KIND == 0) { bf16_t* p = Hb + (size_t)row * DM + c; *p = f2bf(bf2f(*p) + s0); }
            else if (KIND == 1) Ob[(size_t)row * FFN + c] = f2bf(s0 * sigmoidf_(s0) * s1);
            else { tot[i] += s0 * sigmoidf_(bf2f(P[(size_t)row * PN + P_GATES + br * 2048 + c])); if (br == NBR - 1) Ob[(size_t)row * DM + c] = f2bf(tot[i]); } }
        }
    }
    __syncthreads();
}
#define T16_STEP(NS, k) do { bf16x8 a_[NS], b0_[NS], b1_[NS]; \
        _Pragma("unroll") for (int s_ = 0; s_ < NS; ++s_) { a_[s_] = *(const bf16x8*)(ap + (k) + 32 * s_); b0_[s_] = *(const bf16x8*)(bp + (k) + 32 * s_); b1_[s_] = *(const bf16x8*)(bp + (size_t)16 * K + (k) + 32 * s_); } \
        _Pragma("unroll") for (int s_ = 0; s_ < NS; ++s_) { acc0 = __builtin_amdgcn_mfma_f32_16x16x32_bf16(a_[s_], b0_[s_], acc0, 0, 0, 0); acc1 = __builtin_amdgcn_mfma_f32_16x16x32_bf16(a_[s_], b1_[s_], acc1, 0, 0, 0); } } while (0)
template <int KIND>
__device__ __forceinline__ void tail16(const Ctx& C, const bf16_t* A, const bf16_t* Bt, const int K, bf16_t* Hb, bf16_t* Ob, const bf16_t* P) {
    constexpr int NBR = KIND == 2 ? 3 : 1;
    const int r = C.lane & 15, kq = C.lane >> 4, w = C.wave; const int KS = K / 8;
    LAS float* red = (LAS float*)C.lds;
    for (int un = C.wg; un < 256; un += C.G) {
        const int rg = (un >> 3) & 3, t = (un & 7) + 8 * (un >> 5);
        float tot = 0.f;
        for (int br = 0; br < NBR; ++br) {
            f32x4 acc0 = {0.f, 0.f, 0.f, 0.f}, acc1 = {0.f, 0.f, 0.f, 0.f};
            const bf16_t* Au = (KIND == 2) ? A + (size_t)br * MP * 1024 : A;
            const bf16_t* ap = Au + (size_t)(MMAIN + 16 * rg + r) * K + w * KS + 8 * kq;
            const bf16_t* bp = Bt + (size_t)(br * 2048 + 32 * t + r) * K + w * KS + 8 * kq;
            int k = 0;
            for (; k + 128 <= KS; k += 128) T16_STEP(4, k);
            for (; k < KS; k += 64) T16_STEP(2, k);
            __syncthreads();
#pragma unroll
            for (int j = 0; j < 4; ++j) { red[(w * 8 + j) * 64 + C.lane] = acc0[j]; red[(w * 8 + 4 + j) * 64 + C.lane] = acc1[j]; }
            __syncthreads();
            float s = 0.f;
#pragma unroll
            for (int ww = 0; ww < 8; ++ww) s += red[(ww * 8 + w) * 64 + C.lane];
            const int row = MMAIN + 16 * rg + 4 * kq + (w & 3), c = 32 * t + 16 * (w >> 2) + r;
            if (KIND == 0) { bf16_t* p = Hb + (size_t)row * DM + c; *p = f2bf(bf2f(*p) + s); }
            else { tot += s * sigmoidf_(bf2f(P[(size_t)row * PN + P_GATES + br * 2048 + c])); if (br == NBR - 1) Ob[(size_t)row * DM + c] = f2bf(tot); }
        }
    }
    __syncthreads();
}
#undef T16_STEP
__device__ __forceinline__ void ph_sum3(const Ctx& C) {
    const bf16_t* GT = WSP(bf16_t, WS_RW); bf16_t* MG = WSP(bf16_t, WS_U);
    for (int row = C.wg * 8 + C.wave; row < M; row += C.G * 8) {
        const bf16_t* gp = GT + (size_t)row * 6144;
#pragma unroll
        for (int i = 0; i < 4; ++i) { const int c = (i * 64 + C.lane) * 8; float a[8], b[8], d[8];
            unpack8(*(const u32x4*)(gp + c), a); unpack8(*(const u32x4*)(gp + 2048 + c), b); unpack8(*(const u32x4*)(gp + 4096 + c), d);
#pragma unroll
            for (int e = 0; e < 8; ++e) a[e] = a[e] + b[e] + d[e];
            *(u32x4*)(MG + (size_t)row * DM + c) = pack8(a); }
    }
}

constexpr int NSTEP_LAYER = 13, STEP_FINAL = 1 + DEPTH * NSTEP_LAYER, NSTEPS = STEP_FINAL + 1;
__device__ __forceinline__ Ctx mkctx(const Args& args, LAS unsigned char* lds, int wave_s) {
    Ctx C; GAS unsigned char* wsg = (GAS unsigned char*)args.ws; asm volatile("" : "+s"(wsg)); unsigned char* ws = (unsigned char*)wsg; int wv = wave_s; asm volatile("" : "+s"(wv));
    int lane; asm volatile("v_mbcnt_lo_u32_b32 %0, -1, 0\n\tv_mbcnt_hi_u32_b32 %0, -1, %0" : "=v"(lane));
    C.out = (float*)(GAS float*)args.out; C.ws = ws; C.lds = lds; C.ctl = (unsigned*)(ws + WS_CTL);
    C.tid = wv * 64 + lane; C.lane = lane; C.wave = wv; C.G = gridDim.x; C.wg = blockIdx.x;
    return C;
}
__global__ void __launch_bounds__(512, 2) trunk_fwd(Args args) {
    extern __shared__ __attribute__((aligned(16))) unsigned char lds_raw[];
    LAS unsigned char* lds = (LAS unsigned char*)lds_raw;
    volatile LAS unsigned* misc = (volatile LAS unsigned*)(lds + LDS_MISC);
    if (threadIdx.x < 32) misc[threadIdx.x] = 0u;
    if (threadIdx.x == 0) { volatile LAS unsigned long long* tb = (volatile LAS unsigned long long*)(lds + LDS_INTBL);
#pragma unroll
        for (int i = 0; i < 27; ++i) tb[i] = (unsigned long long)args.in[i]; }
    __syncthreads();
    const int s_lo = args.s_lo, s_hi = args.s_hi;
    const int wave_s = __builtin_amdgcn_readfirstlane(threadIdx.x >> 6);
    unsigned* const barw = (unsigned*)(args.ws + WS_CTL) + CW_BAR + args.bar_idx * XCD_BAR_WORDS;
    XcdBarrier bar; bar.bar = barw; bar.x = 0; bar.st = misc;
    if (s_hi - s_lo > 1) bar = xcd_barrier_post(barw, misc);
#ifndef PMASK
#define PMASK 0xFFFFF
#endif
#define RUN(k, s) (((PMASK >> (k)) & 1) && (s) >= s_lo && (s) < s_hi)
#define SEAM(s) do { if ((s) >= s_lo && (s) + 1 < s_hi) { GAS unsigned* bw_ = (GAS unsigned*)barw; asm volatile("" : "+s"(bw_)); bar.bar = (unsigned*)bw_; int ln_; asm volatile("v_mbcnt_lo_u32_b32 %0, -1, 0\n\tv_mbcnt_hi_u32_b32 %0, -1, %0" : "=v"(ln_)); xcd_barrier(bar, wave_s == 0 && ln_ == 0); } } while (0)
    using namespace pg8;
    if (RUN(14, 0)) { const Ctx C = mkctx(args, lds, wave_s); ph_rope_tables(C); } SEAM(0);
    for (int l = 0; l < DEPTH; ++l) {
        const int sb = 1 + l * NSTEP_LAYER;
        if (RUN(0, sb + 0)) { const Ctx C = mkctx(args, lds, wave_s); ph_conv(C, l); if (l == 0) ph_norm<true>(C); else ph_norm<false>(C); } SEAM(sb + 0);
        if (RUN(1, sb + 1)) { const Ctx C = mkctx(args, lds, wave_s); Gemm g{WSP(bf16_t, WS_U), WSP(bf16_t, WS_WIN), MP, PN, DM, 0, 0}; StaticOrder S; S.init(MP, PN, C.G, C.wg);
            EpiBf16Plain E{WSP(bf16_t, WS_P), PN}; gemm_phase<EpiBf16Plain, StaticOrder, true, true>(lds, g, S, E, C.tid); }
        if (RUN(1, sb + 1)) { const Ctx C = mkctx(args, lds, wave_s); Gemm g{WSP(bf16_t, WS_WVRET), WSP(bf16_t, WS_U), 1024, MP, DM, 0, 0}; StaticOrder S; S.init(1024, MP, C.G, (C.wg + 121) % C.G);
            EpiBf16Plain E{WSP(bf16_t, WS_VTRET), MP}; gemm_phase<EpiBf16Plain, StaticOrder, true, true>(lds, g, S, E, C.tid); }
        if (RUN(1, sb + 1)) { Ctx C = mkctx(args, lds, wave_s);
            int idx = C.wg, cnt = C.G;
            if (C.G == 256) { const bool idle = C.wg >= 117 && !(C.wg >= 135 && C.wg <= 138); idx = idle ? C.wg - 117 - (C.wg > 138 ? 4 : 0) : -1; cnt = 135; }
            if (idx >= 0) { C.wg = idx; C.G = cnt; __syncthreads(); ph_convB(C, l); } }
        SEAM(sb + 1);
        if (RUN(2, sb + 2)) { const Ctx C = mkctx(args, lds, wave_s); ph_prepA(C, l); } SEAM(sb + 2);
        if (RUN(3, sb + 3)) { const Ctx C = mkctx(args, lds, wave_s);
            unsigned char* rw = C.ws + WS_RW;
            { Gemm g{WSP(bf16_t, WS_XL), WSP(bf16_t, WS_WLORA), MP, LORA_N, LORA_K, 0, 0}; StaticOrder S; S.init(MP, LORA_N, C.G, C.wg);
              EpiLora E{(float*)(rw + RW_WDEC), (bf16_t*)(rw + RW_A), (bf16_t*)(rw + RW_A + RW_ARR), inp(C, IN_W0) + l * 1024, inp(C, IN_A0) + l * 1024}; gemm_phase<EpiLora, StaticOrder, true, true>(lds, g, S, E, C.tid); }
        }
        if (RUN(3, sb + 3)) { const Ctx C = mkctx(args, lds, wave_s); Gemm g{WSP(bf16_t, WS_QN), WSP(bf16_t, WS_WUQ), MP, 1536, 512, 0, 0}; StaticOrder S; S.init(MP, 1536, C.G, (C.wg + 140) % C.G);
            EpiBf16Plain E{WSP(bf16_t, WS_Q), 1536}; gemm_phase<EpiBf16Plain, StaticOrder, true, true>(lds, g, S, E, C.tid); }
        if (RUN(3, sb + 3)) { const Ctx C = mkctx(args, lds, wave_s); Gemm g{WSP(bf16_t, WS_KVN), WSP(bf16_t, WS_WUK), MP, 1024, 256, 0, 0}; StaticOrder S; S.init(MP, 1024, C.G, (C.wg + 236) % C.G);
            EpiBf16Plain E{WSP(bf16_t, WS_KNOPE), 1024}; gemm_phase<EpiBf16Plain, StaticOrder, true, true>(lds, g, S, E, C.tid); }
        if (RUN(3, sb + 3)) { const Ctx C = mkctx(args, lds, wave_s); Gemm g{WSP(bf16_t, WS_WUV), WSP(bf16_t, WS_KVN), 1024, MP, 256, 0, 0}; StaticOrder S; S.init(1024, MP, C.G, (C.wg + 232) % C.G);
            EpiBf16Plain E{WSP(bf16_t, WS_VTMLA), MP}; gemm_phase<EpiBf16Plain, StaticOrder, true, true>(lds, g, S, E, C.tid); }
        SEAM(sb + 3);
        if (RUN(5, sb + 5)) { const Ctx C = mkctx(args, lds, wave_s); ph_qrope(C); }
        if (RUN(5, sb + 5)) { const Ctx C = mkctx(args, lds, wave_s); ph_retkv(C); }
        if (RUN(5, sb + 5)) { const Ctx C = mkctx(args, lds, wave_s); ph_rwkvpre(C, l); } SEAM(sb + 5);
        if (RUN(6, sb + 6)) { const Ctx C = mkctx(args, lds, wave_s); ph_mix(C, l); } SEAM(sb + 6);
        if (RUN(7, sb + 7)) { const Ctx C = mkctx(args, lds, wave_s); ph_post(C, l); } SEAM(sb + 7);
        if (RUN(8, sb + 8)) { const Ctx C = mkctx(args, lds, wave_s); Gemm g{WSP(bf16_t, WS_YBR), WSP(bf16_t, WS_WBR), MMAIN, 6144, 1024, 8, (size_t)MP * 1024 * 2}; BranchOrder S; S.base.init(MMAIN, DM, C.G, C.wg);
            EpiGate E{WSP(bf16_t, WS_U), WSP(bf16_t, WS_P)}; gemm_phase<EpiGate, BranchOrder, true, true>(lds, g, S, E, C.tid); }
        if (RUN(8, sb + 8)) { const Ctx C = mkctx(args, lds, wave_s); tail16<2>(C, WSP(bf16_t, WS_YBR), WSP(bf16_t, WS_WBR), 1024, nullptr, WSP(bf16_t, WS_U), WSP(bf16_t, WS_P)); }
        SEAM(sb + 8);
        if (RUN(9, sb + 9)) { const Ctx C = mkctx(args, lds, wave_s); Gemm g{WSP(bf16_t, WS_U), WSP(bf16_t, WS_WOUT), MMAIN, DM, DM, 0, 0}; StaticOrder S; S.init(MMAIN, DM, C.G, C.wg);
            EpiResid E{WSP(bf16_t, WS_H)}; gemm_phase<EpiResid, StaticOrder, true, true>(lds, g, S, E, C.tid); }
        if (RUN(9, sb + 9)) { const Ctx C = mkctx(args, lds, wave_s); tail16<0>(C, WSP(bf16_t, WS_U), WSP(bf16_t, WS_WOUT), DM, WSP(bf16_t, WS_H), nullptr, nullptr); }
        SEAM(sb + 9);
        if (RUN(10, sb + 10)) { const Ctx C = mkctx(args, lds, wave_s); ph_norm<false>(C); } SEAM(sb + 10);
        if (RUN(11, sb + 11)) { const Ctx C = mkctx(args, lds, wave_s); Gemm g{WSP(bf16_t, WS_U), WSP(bf16_t, WS_WGU), MMAIN, 2 * FFN, DM, 0, 0}; StaticOrder S; S.init(MMAIN, 2 * FFN, C.G, C.wg);
            EpiSwiglu E{WSP(bf16_t, WS_P)}; gemm_phase<EpiSwiglu, StaticOrder, true, true>(lds, g, S, E, C.tid); }
        if (RUN(11, sb + 11)) { const Ctx C = mkctx(args, lds, wave_s); tail_units<1>(C, WSP(bf16_t, WS_U), WSP(bf16_t, WS_WGU), DM, FFN / 32, nullptr, WSP(bf16_t, WS_P), nullptr); }
        SEAM(sb + 11);
        if (RUN(12, sb + 12)) { const Ctx C = mkctx(args, lds, wave_s); Gemm g{WSP(bf16_t, WS_P), WSP(bf16_t, WS_WD), MMAIN, DM, FFN, 0, 0}; StaticOrder S; S.init(MMAIN, DM, C.G, C.wg);
            EpiResid E{WSP(bf16_t, WS_H)}; gemm_phase<EpiResid, StaticOrder, true, true>(lds, g, S, E, C.tid); }
        if (RUN(12, sb + 12)) { const Ctx C = mkctx(args, lds, wave_s); tail16<0>(C, WSP(bf16_t, WS_P), WSP(bf16_t, WS_WD), FFN, WSP(bf16_t, WS_H), nullptr, nullptr); }
        SEAM(sb + 12);
    }
    if (RUN(15, STEP_FINAL)) { const Ctx C = mkctx(args, lds, wave_s); ph_final(C); }
#undef RUN
#undef SEAM
}

extern "C" void kernel_launch(void* const* d_in, const int* in_sizes, int n_in, void* d_out, int out_size, void* d_ws, size_t ws_size, hipStream_t stream) {
    static int grid = 0;
    if (grid == 0) {
        if (n_in != 27 || ws_size < WS_END) { fprintf(stderr, "kernel_launch: unexpected n_in %d or ws_size %zu (< %zu)\n", n_in, ws_size, (size_t)WS_END); grid = -1; return; }
        int dev = 0, cus = 0, per_cu = 0;
        if (hipGetDevice(&dev) != hipSuccess || hipDeviceGetAttribute(&cus, hipDeviceAttributeMultiprocessorCount, dev) != hipSuccess) { grid = -1; return; }
        if (hipFuncSetAttribute((const void*)trunk_fwd, hipFuncAttributeMaxDynamicSharedMemorySize, LDS_BYTES) != hipSuccess) { fprintf(stderr, "kernel_launch: hipFuncSetAttribute failed\n"); grid = -1; return; }
        if (hipOccupancyMaxActiveBlocksPerMultiprocessor(&per_cu, (const void*)trunk_fwd, 512, LDS_BYTES) != hipSuccess || per_cu < 1) { fprintf(stderr, "kernel_launch: occupancy query says %d\n", per_cu); }
        (void)hipGetLastError();
        grid = cus;
    }
    if (grid < 0) return;
    (void)hipMemsetAsync((char*)d_ws + WS_CTL, 0, CTL_ZERO_BYTES, stream);
    Args a{};
    for (int i = 0; i < 27; ++i) a.in[i] = (const float*)d_in[i];
    a.out = (float*)d_out; a.ws = (unsigned char*)d_ws; a.pad = 0;
#if N_LAUNCH_MODE == 1
    a.s_lo = 0; a.s_hi = NSTEPS; a.bar_idx = 0;
    hipLaunchKernelGGL(trunk_fwd, dim3(grid), dim3(512), LDS_BYTES, stream, a);
#else
    for (int s = 0; s < NSTEPS; ++s) { a.s_lo = s; a.s_hi = s + 1; a.bar_idx = 0; hipLaunchKernelGGL(trunk_fwd, dim3(grid), dim3(512), LDS_BYTES, stream, a); }
#endif
}
```

```cpp
#include <hip/hip_runtime.h>
#include <cstdio>
#include <cstdint>

#define LAS __attribute__((address_space(3)))
#define GAS __attribute__((address_space(1)))
typedef unsigned short bf16_t;
typedef short bf16x8 __attribute__((ext_vector_type(8)));
typedef float f32x4 __attribute__((ext_vector_type(4)));
typedef float f32x2 __attribute__((ext_vector_type(2)));
typedef float f32x16 __attribute__((ext_vector_type(16)));
typedef unsigned u32x4 __attribute__((ext_vector_type(4)));
typedef unsigned u32x2 __attribute__((ext_vector_type(2)));

constexpr int DM = 2048, NB = 4, SEQ = 4096, NMETA = 16, LSEQ = 4112, M = NB * LSEQ  , MP = 16640  , DEPTH = 4;
constexpr int RWW = 1024, RW_COLS = 3520, IN_COLS = 14592, PN = 13568  ;
constexpr int P_QRET = 3520, P_KRET = 4544, P_GRET = 5568, P_QD = 6592, P_KVD = 7104, P_KRD = 7360, P_GATES = 7424;
constexpr int FFN = 5632, LORA_K = 512, LORA_N = 3072;
constexpr float NORM_EPS = 1e-6f, GN_EPS = 64.0f * 1e-5f;

constexpr size_t MiB = 1u << 20;
constexpr size_t al(size_t x) { return (x + MiB - 1) / MiB * MiB; }
constexpr size_t WS_CTL = 0, CTL_BYTES = 2 * MiB;
constexpr size_t WS_WIN = WS_CTL + CTL_BYTES;
constexpr size_t WS_WVRET = WS_WIN + al((size_t)PN * DM * 2);
constexpr size_t WS_WLORA = WS_WVRET + al((size_t)1024 * DM * 2);
constexpr size_t WS_WUQ = WS_WLORA + al((size_t)LORA_N * LORA_K * 2);
constexpr size_t WS_WUK = WS_WUQ + al((size_t)1536 * 512 * 2);
constexpr size_t WS_WUV = WS_WUK + al((size_t)1024 * 256 * 2);
constexpr size_t WS_WBR = WS_WUV + al((size_t)1024 * 256 * 2);
constexpr size_t WS_WOUT = WS_WBR + al((size_t)6144 * 1024 * 2);
constexpr size_t WS_WGU = WS_WOUT + al((size_t)2048 * 6144 * 2);
constexpr size_t WS_WD = WS_WGU + al((size_t)11264 * 2048 * 2);
constexpr size_t WS_ROPE = WS_WD + al((size_t)2048 * FFN * 2);
constexpr size_t WS_H = WS_ROPE + al((size_t)LSEQ * 192 * 4);
constexpr size_t WS_U = WS_H + al((size_t)MP * DM * 4);
constexpr size_t WS_P = WS_U + al((size_t)MP * DM * 2);
constexpr size_t WS_VTRET = WS_P + al((size_t)MP * PN * 2);
constexpr size_t WS_XL = WS_VTRET + al((size_t)1024 * MP * 2);
constexpr size_t WS_RW = WS_XL + al((size_t)MP * 512 * 2);
constexpr size_t RW_WDEC = 0;
constexpr size_t RW_A = RW_WDEC + (size_t)MP * 1024 * 4;
constexpr size_t RW_ARR = (size_t)MP * 1024 * 2;
constexpr size_t RW_YRAW = RW_A + 7 * RW_ARR;
constexpr size_t RW_BYTES = RW_YRAW + (size_t)MP * 1024 * 4;
static_assert(RW_BYTES >= (size_t)MP * 6144 * 2, "GT overlay");
constexpr size_t WS_YBR = WS_RW + al(RW_BYTES);
constexpr size_t WS_QN = WS_YBR + al(3 * RW_ARR);
constexpr size_t WS_KVN = WS_QN + al((size_t)MP * 512 * 2);
constexpr size_t WS_KR = WS_KVN + al((size_t)MP * 256 * 2);
constexpr size_t WS_Q = WS_KR + al((size_t)MP * 64 * 2);
constexpr size_t WS_KNOPE = WS_Q + al((size_t)MP * 1536 * 2);
constexpr size_t WS_VTMLA = WS_KNOPE + al((size_t)MP * 1024 * 2);
constexpr size_t WS_KVT = WS_VTMLA + al((size_t)1024 * MP * 2);
constexpr int NCHUNK = LSEQ / 16;
constexpr int RC_B1 = 0, RC_B2 = 5632, RC_VT = 10752, RC_G = 13824, RC_STRIDE = 14336;
constexpr size_t WS_RCH = WS_KVT + al((size_t)NB * 8 * 16 * 128 * 128 * 4);
constexpr size_t WS_END = WS_RCH + al((size_t)NB * 16 * NCHUNK * RC_STRIDE);
static_assert((size_t)MP * FFN * 2 <= (size_t)MP * PN * 2, "ACT overlay");

constexpr int CW_QUEUE = 1024;
constexpr int CW_BAR = 4096;
constexpr int XCD_BAR_WORDS_C = 3456;
constexpr int MAX_BAR_REGIONS = 64;
#ifndef N_LAUNCH_MODE
#define N_LAUNCH_MODE 1
#endif
constexpr size_t CTL_ZERO_BYTES = (N_LAUNCH_MODE == 1) ? (size_t)(CW_BAR + XCD_BAR_WORDS_C) * 4 : CTL_BYTES;

constexpr int LDS_BYTES = 147456;
constexpr int LDS_MISC = 131072;

__device__ __forceinline__ float bf2f(unsigned short v) { return __uint_as_float(((unsigned)v) << 16); }
__device__ __forceinline__ float bflo(unsigned v) { return __uint_as_float(v << 16); }
__device__ __forceinline__ float bfhi(unsigned v) { return __uint_as_float(v & 0xffff0000u); }
__device__ __forceinline__ unsigned cvt_pk_bf16(float lo, float hi) { unsigned r; asm volatile("v_cvt_pk_bf16_f32 %0, %1, %2" : "=v"(r) : "v"(lo), "v"(hi)); return r; }
__device__ __forceinline__ unsigned short f2bf(float x) { return (unsigned short)(cvt_pk_bf16(x, 0.f) & 0xffffu); }
template <int X> __device__ __forceinline__ float sw_xor(float x) { return __int_as_float(__builtin_amdgcn_ds_swizzle(__float_as_int(x), 0x1f | (X << 10))); }
__device__ __forceinline__ float hsum32(float x) { const int v = __float_as_int(x); auto r = __builtin_amdgcn_permlane32_swap(v, v, false, false); return __int_as_float(r[0]) + __int_as_float(r[1]); }
__device__ __forceinline__ float hmax32(float x) { const int v = __float_as_int(x); auto r = __builtin_amdgcn_permlane32_swap(v, v, false, false); return fmaxf(__int_as_float(r[0]), __int_as_float(r[1])); }
__device__ __forceinline__ float wsum32(float x) { x += sw_xor<16>(x); x += sw_xor<8>(x); x += sw_xor<4>(x); x += sw_xor<2>(x); x += sw_xor<1>(x); return x; }
__device__ __forceinline__ float wsum64(float x) { x = wsum32(x); return hsum32(x); }
__device__ __forceinline__ float dpp_xor1(float x) { return __int_as_float(__builtin_amdgcn_update_dpp(0, __float_as_int(x), 0xB1, 0xF, 0xF, true)); }
__device__ __forceinline__ float dpp_xor2(float x) { return __int_as_float(__builtin_amdgcn_update_dpp(0, __float_as_int(x), 0x4E, 0xF, 0xF, true)); }
__device__ __forceinline__ float dpp_mirror(float x) { return __int_as_float(__builtin_amdgcn_update_dpp(0, __float_as_int(x), 0x140, 0xF, 0xF, true)); }
__device__ __forceinline__ float dpp_hmirror(float x) { return __int_as_float(__builtin_amdgcn_update_dpp(0, __float_as_int(x), 0x141, 0xF, 0xF, true)); }
__device__ __forceinline__ float wsum64_dpp(float x) {
    x += dpp_xor1(x); x += dpp_xor2(x); x += dpp_hmirror(x); x += dpp_mirror(x);
    x += __int_as_float(__builtin_amdgcn_update_dpp(0, __float_as_int(x), 0x142, 0xA, 0xF, false));
    x += __int_as_float(__builtin_amdgcn_update_dpp(0, __float_as_int(x), 0x143, 0xC, 0xF, false));
    return __int_as_float(__builtin_amdgcn_readlane(__float_as_int(x), 63));
}
__device__ __forceinline__ float sigmoidf_(float x) { return __builtin_amdgcn_rcpf(1.0f + __expf(-x)); }
__device__ __forceinline__ u32x4 zero4u() { unsigned z; asm volatile("v_mov_b32 %0, 0" : "=v"(z)); return (u32x4){z, z, z, z}; }

#define XB_TMO      128
#define XB_XCNT(j)  (256  + 64 * (j))
#define XB_XSUB(j)  (1280 + 64 * (j))
#define XB_XGEN(j)  (2304 + 64 * (j))
#define XB_TOP      3328
#define XB_TOPGEN   3392
#define XCD_BAR_WORDS 3456
#define XB_SPIN_CAP (1u << 18)

__device__ __forceinline__ unsigned xb_ld(unsigned* p)              { return __hip_atomic_load(p, __ATOMIC_RELAXED, __HIP_MEMORY_SCOPE_AGENT); }
__device__ __forceinline__ unsigned xb_add(unsigned* p, unsigned v) { return __hip_atomic_fetch_add(p, v, __ATOMIC_RELAXED, __HIP_MEMORY_SCOPE_AGENT); }
__device__ __forceinline__ unsigned xb_xcc_id() { return (unsigned)__builtin_amdgcn_s_getreg((3 << 11) | 20) & 0xFu; }
#define XB_SPIN(cond, bar) do { unsigned _sp = 0; while (cond) { __builtin_amdgcn_s_sleep(1); \
    if ((++_sp & 255u) == 0u) { if (xb_ld(&(bar)[XB_TMO])) break; if (_sp > XB_SPIN_CAP) { atomicAdd(&(bar)[XB_TMO], 1u); break; } } } } while (0)

struct XcdBarrier { unsigned* bar; unsigned x; volatile LAS unsigned* st; };

__device__ __forceinline__ XcdBarrier xcd_barrier_post(unsigned* bar, volatile LAS unsigned* st) {
    XcdBarrier b; b.bar = bar; b.x = xb_xcc_id(); b.st = st;
    if (threadIdx.x == 0) (void)xb_add(&bar[XB_XCNT(b.x)], 1u);
    return b;
}
__device__ __forceinline__ void xcd_barrier_complete(unsigned* bar, unsigned x, unsigned& nloc, unsigned& nx) {
    const unsigned G = gridDim.x * gridDim.y * gridDim.z;
    unsigned sum, cnt, mine, sp = 0u;
    for (;;) {
        sum = 0u; cnt = 0u; mine = 0u;
#pragma unroll
        for (unsigned j = 0; j < 16; ++j) { const unsigned c = xb_ld(&bar[XB_XCNT(j)]); sum += c; cnt += (c > 0u) ? 1u : 0u; mine = (j == x) ? c : mine; }
        if (sum == G) break;
        __builtin_amdgcn_s_sleep(1);
        if ((++sp & 255u) == 0u) { if (xb_ld(&bar[XB_TMO])) break; if (sp > XB_SPIN_CAP) { atomicAdd(&bar[XB_TMO], 1u); break; } }
    }
    nloc = mine > 0u ? mine : 1u; nx = cnt > 0u ? cnt : 1u;
}
__device__ __forceinline__ void xcd_barrier(const XcdBarrier& b, const bool leader) {
    asm volatile("s_waitcnt vmcnt(0)" ::: "memory");
    __syncthreads();
    if (leader) {
        unsigned* bar = b.bar;
        __builtin_amdgcn_s_waitcnt(0);
        unsigned nloc = b.st[0], nx = b.st[1];
        if (nloc == 0u) { xcd_barrier_complete(bar, b.x, nloc, nx); b.st[0] = nloc; b.st[1] = nx; }
        const unsigned old = xb_add(&bar[XB_XSUB(b.x)], 1u);
        const unsigned gen = old / nloc;
        if (old + 1u == (gen + 1u) * nloc) {
            __builtin_amdgcn_fence(__ATOMIC_RELEASE, "agent");
            asm volatile("s_waitcnt vmcnt(0)" ::: "memory");
            const unsigned og = xb_add(&bar[XB_TOP], 1u);
            const unsigned tg = og / nx;
            if (og + 1u == (tg + 1u) * nx) xb_add(&bar[XB_TOPGEN], 1u);
            else XB_SPIN(xb_ld(&bar[XB_TOPGEN]) == tg, bar);
            __builtin_amdgcn_fence(__ATOMIC_ACQUIRE, "agent");
            xb_add(&bar[XB_XGEN(b.x)], 1u);
            asm volatile("s_waitcnt vmcnt(0)" ::: "memory");
        } else {
            XB_SPIN(xb_ld(&bar[XB_XGEN(b.x)]) == gen, bar);
            __builtin_amdgcn_fence(__ATOMIC_ACQUIRE, "agent");
            asm volatile("s_waitcnt vmcnt(0)" ::: "memory");
        }
    }
    __syncthreads();
}

__device__ __forceinline__ void unpack8(const u32x4 w, float (&x)[8]);
__device__ __forceinline__ u32x4 pack8(const float (&x)[8]);
__device__ __forceinline__ void ld8f(const float* p, float (&x)[8]);
namespace pg8 {
constexpr int BM = 256, BK = 64, HALF = 128, HTB = HALF * BK * 2, STAGE_BYTES = 8 * HTB, NXCD = 8, WGM = 8;
__host__ __device__ __forceinline__ int lds_byte(int r, int c) { const int st = (r >> 4) * 2 + (c >> 5), rr = r & 15, cc = c & 31, ob = rr * 64 + cc * 2; return st * 1024 + (ob ^ (((ob >> 9) & 1) << 5)); }
__host__ __device__ __forceinline__ void stage_rc(int b, int& R, int& C) { const int st = b / 1024, sb = b % 1024, swz = sb ^ (((sb >> 9) & 1) << 5); R = (st >> 1) * 16 + swz / 64; C = (st & 1) * 32 + (swz % 64) / 2; }
__host__ __device__ __forceinline__ int perm32(int rho) { const int n = rho >> 4, i = rho & 15; return 8 * (i >> 2) + 4 * n + (i & 3); }

struct Unit { int pm, pn; };
struct Gemm { const bf16_t* A; const bf16_t* Bt; int M, N, K; int asel_tiles; size_t asel_stride; };

struct StaticOrder {
    int nM, nN, nwg, G, c;
    __host__ __device__ void init(int M_, int N_, int G_, int c_) { nM = M_ / BM; nN = N_ / BM; nwg = nM * nN; G = G_; c = c_; }
    __host__ __device__ bool next(int i, Unit& u) const {
        const long L = (long)i * G + c; if (L >= nwg) return false;
        int wgid = (int)L; { const int q = nwg / NXCD, r = nwg % NXCD, xcd = wgid % NXCD, off = wgid / NXCD; wgid = (xcd < r ? xcd * (q + 1) : r * (q + 1) + (xcd - r) * q) + off; }
        const int nig = WGM * nN, gid = wgid / nig, fm = gid * WGM, gsz = (nM - fm) < WGM ? (nM - fm) : WGM;
        u.pm = fm + ((wgid % nig) % gsz); u.pn = (wgid % nig) / gsz; return true;
    }
    __device__ __forceinline__ void a_ready(const Unit&) const {}
    __device__ __forceinline__ void done(const Unit&) const {}
};

template <class Epi, class Sched, bool ALIGN_EPI = false, bool SP2 = false>
__device__ __forceinline__ void gemm_phase(LAS unsigned char* lds, const Gemm g, const Sched& S, const Epi& E, const int tid) {
    const int wid = __builtin_amdgcn_readfirstlane(tid >> 6), lane = tid & 63, wr = wid >> 2, wc = wid & 3, fr = lane & 15, fq = lane >> 4;
    const int K = g.K, nt = K / BK;
    unsigned voffA[2], voffB[2];
#pragma unroll
    for (int i = 0; i < 2; ++i) { int R, C; stage_rc(tid * 16 + i * 8192, R, C); const int Rb = Epi::PERM ? ((R & ~31) + perm32(R & 31)) : R;
        voffA[i] = (unsigned)(R * K + C) * 2u; voffB[i] = (unsigned)(Rb * K + C) * 2u; }
    const size_t kstep = (size_t)(BK * 2);
    const size_t hstep = (size_t)HALF * K * 2;
    const size_t tstep = 2 * hstep;
    const unsigned ldsw = (unsigned)wid * 1024u;
    const int aoff = lds_byte(wr * 64 + fr, fq * 8), boff = lds_byte(wc * 32 + fr, fq * 8);
#define PG8_SA(b, h) (((b) * 2 + (h)) * HTB)
#define PG8_SB(b, h) ((4 + (b) * 2 + (h)) * HTB)
#define PG8_STAGE(bufoff, gbase, voff) do { _Pragma("unroll") for (int _i = 0; _i < 2; ++_i) \
        __builtin_amdgcn_global_load_lds((const unsigned*)((const char*)(gbase) + (voff)[_i]), (LAS unsigned*)(lds + (bufoff) + ldsw + _i * 8192), 16, 0, 0); } while (0)
#define PG8_LDA(dst, b, h) do { _Pragma("unroll") for (int m = 0; m < 4; ++m) _Pragma("unroll") for (int k = 0; k < 2; ++k) dst[m][k] = *(const LAS bf16x8*)(lds + PG8_SA(b, h) + aoff + m * 2048 + k * 1024); } while (0)
#define PG8_LDB(dst, b, h) do { _Pragma("unroll") for (int n = 0; n < 2; ++n) _Pragma("unroll") for (int k = 0; k < 2; ++k) dst[n][k] = *(const LAS bf16x8*)(lds + PG8_SB(b, h) + boff + n * 2048 + k * 1024); } while (0)
#define PG8_MMA(ai, bj, At, Bt) do { __builtin_amdgcn_s_setprio(1); _Pragma("unroll") for (int m = 0; m < 4; ++m) _Pragma("unroll") for (int n = 0; n < 2; ++n) _Pragma("unroll") for (int k = 0; k < 2; ++k) \
        acc[ai][bj][m][n] = __builtin_amdgcn_mfma_f32_16x16x32_bf16(Bt[n][k], At[m][k], acc[ai][bj][m][n], 0, 0, 0); __builtin_amdgcn_s_setprio(0); } while (0)
#define PG8_WAIT_V(n) asm volatile("s_waitcnt vmcnt(" #n ")" ::: "memory")
#define PG8_WAIT_L(n) asm volatile("s_waitcnt lgkmcnt(" #n ")" ::: "memory")
#define PG8_BAR __builtin_amdgcn_s_barrier()
#define PG8_SCHED __builtin_amdgcn_sched_barrier(0)
#define PG8_ABASE(u) ((const char*)g.A + (g.asel_tiles ? (size_t)((u).pn / g.asel_tiles) * g.asel_stride : (size_t)0) + (size_t)(u).pm * tstep)
    Unit cur, nxt; int ui = 0;
    if (!S.next(0, cur)) return;
    f32x4 acc[2][2][4][2];
    { float zf; asm volatile("v_mov_b32 %0, 0" : "=v"(zf)); const f32x4 Z = {zf, zf, zf, zf};
#pragma unroll
    for (int a = 0; a < 2; ++a)
#pragma unroll
        for (int b = 0; b < 2; ++b)
#pragma unroll
            for (int m = 0; m < 4; ++m)
#pragma unroll
                for (int n = 0; n < 2; ++n) acc[a][b][m][n] = Z; }
    bf16x8 At[4][2], B0[2][2], B1[2][2];
    const char* cA = PG8_ABASE(cur); const char* cB = (const char*)g.Bt + (size_t)cur.pn * tstep;
    S.a_ready(cur);
    if constexpr (SP2) {
        PG8_STAGE(PG8_SB(0, 0), cB, voffB); PG8_STAGE(PG8_SB(0, 1), cB + hstep, voffB); PG8_STAGE(PG8_SA(0, 0), cA, voffA); PG8_STAGE(PG8_SA(0, 1), cA + hstep, voffA);
        if (wr == 1) PG8_BAR;
        PG8_WAIT_V(2); PG8_BAR;
        PG8_STAGE(PG8_SB(1, 0), cB + kstep, voffB); PG8_STAGE(PG8_SA(1, 0), cA + kstep, voffA); PG8_STAGE(PG8_SB(1, 1), cB + hstep + kstep, voffB);
        PG8_WAIT_V(6); PG8_BAR;
    } else {
        PG8_STAGE(PG8_SB(0, 0), cB, voffB); PG8_STAGE(PG8_SA(0, 0), cA, voffA); PG8_STAGE(PG8_SB(0, 1), cB + hstep, voffB); PG8_STAGE(PG8_SA(0, 1), cA + hstep, voffA);
        if (wr == 1) PG8_BAR;
        PG8_WAIT_V(4); PG8_BAR;
        PG8_STAGE(PG8_SB(1, 0), cB + kstep, voffB); PG8_STAGE(PG8_SA(1, 0), cA + kstep, voffA); PG8_STAGE(PG8_SB(1, 1), cB + hstep + kstep, voffB);
        PG8_WAIT_V(6); PG8_BAR;
    }
    for (;;) {
        const bool has_next = S.next(ui + 1, nxt);
        const char* nA = has_next ? PG8_ABASE(nxt) : cA; const char* nB = has_next ? (const char*)g.Bt + (size_t)nxt.pn * tstep : cB;
        for (int t = 0; t < nt; t += 2) {
            const bool last = (t == nt - 2);
            const char* a1 = cA + (size_t)(t + 1) * kstep;
            const char* a2 = last ? nA : cA + (size_t)(t + 2) * kstep; const char* b2 = last ? nB : cB + (size_t)(t + 2) * kstep;
            const char* a3 = a2 + kstep; const char* b3 = b2 + kstep;
            if (last && has_next) S.a_ready(nxt);
            if constexpr (SP2) {
            PG8_LDB(B0, 0, 0); PG8_LDB(B1, 0, 1); PG8_SCHED; PG8_LDA(At, 0, 0); PG8_STAGE(PG8_SA(1, 1), a1 + hstep, voffA);
            PG8_WAIT_V(8); PG8_WAIT_L(0); PG8_BAR; PG8_MMA(0, 0, At, B0); PG8_MMA(0, 1, At, B1); PG8_BAR; PG8_SCHED;
            PG8_LDA(At, 0, 1); PG8_STAGE(PG8_SB(0, 0), b2, voffB); PG8_STAGE(PG8_SB(0, 1), b2 + hstep, voffB); PG8_STAGE(PG8_SA(0, 0), a2, voffA);
            PG8_WAIT_V(8); PG8_WAIT_L(0); PG8_BAR; PG8_MMA(1, 0, At, B0); PG8_MMA(1, 1, At, B1); PG8_BAR; PG8_SCHED;
            PG8_LDB(B0, 1, 0); PG8_LDB(B1, 1, 1); PG8_SCHED; PG8_LDA(At, 1, 0); PG8_STAGE(PG8_SA(0, 1), a2 + hstep, voffA);
            PG8_WAIT_V(8); PG8_WAIT_L(0); PG8_BAR; PG8_MMA(0, 0, At, B0); PG8_MMA(0, 1, At, B1); PG8_BAR; PG8_SCHED;
            PG8_LDA(At, 1, 1); PG8_STAGE(PG8_SB(1, 0), b3, voffB); PG8_STAGE(PG8_SB(1, 1), b3 + hstep, voffB); PG8_STAGE(PG8_SA(1, 0), a3, voffA);
            PG8_WAIT_V(8); PG8_WAIT_L(0); PG8_BAR; PG8_MMA(1, 0, At, B0); PG8_MMA(1, 1, At, B1); PG8_BAR; PG8_SCHED;
            } else {
            PG8_LDB(B0, 0, 0); PG8_SCHED; PG8_LDA(At, 0, 0); PG8_STAGE(PG8_SA(1, 1), a1 + hstep, voffA);
            PG8_WAIT_L(8); PG8_BAR; PG8_WAIT_L(0); PG8_MMA(0, 0, At, B0); PG8_BAR; PG8_SCHED;
            PG8_LDB(B1, 0, 1); PG8_STAGE(PG8_SB(0, 0), b2, voffB);
            PG8_BAR; PG8_WAIT_L(0); PG8_MMA(0, 1, At, B1); PG8_BAR;
            PG8_LDA(At, 0, 1); PG8_STAGE(PG8_SA(0, 0), a2, voffA);
            PG8_BAR; PG8_WAIT_L(0); PG8_MMA(1, 0, At, B0); PG8_BAR; PG8_SCHED;
            PG8_STAGE(PG8_SB(0, 1), b2 + hstep, voffB);
            PG8_WAIT_V(6); PG8_BAR; PG8_MMA(1, 1, At, B1); PG8_BAR;
            PG8_LDB(B0, 1, 0); PG8_SCHED; PG8_LDA(At, 1, 0); PG8_STAGE(PG8_SA(0, 1), a2 + hstep, voffA);
            PG8_WAIT_L(8); PG8_BAR; PG8_WAIT_L(0); PG8_MMA(0, 0, At, B0); PG8_BAR; PG8_SCHED;
            PG8_LDB(B1, 1, 1); PG8_STAGE(PG8_SB(1, 0), b3, voffB);
            PG8_BAR; PG8_WAIT_L(0); PG8_MMA(0, 1, At, B1); PG8_BAR;
            PG8_LDA(At, 1, 1); PG8_STAGE(PG8_SA(1, 0), a3, voffA);
            PG8_BAR; PG8_WAIT_L(0); PG8_MMA(1, 0, At, B0); PG8_BAR; PG8_SCHED;
            PG8_STAGE(PG8_SB(1, 1), b3 + hstep, voffB);
            PG8_WAIT_V(6); PG8_BAR; PG8_MMA(1, 1, At, B1); PG8_BAR;
            }
        }
        if constexpr (ALIGN_EPI) { if (wr == 0) PG8_BAR; }
        E(acc, cur, wr, wc, fr, fq); S.done(cur);
        if (!has_next) break;
        { float zf; asm volatile("v_mov_b32 %0, 0" : "=v"(zf)); const f32x4 Z = {zf, zf, zf, zf};
#pragma unroll
        for (int a = 0; a < 2; ++a)
#pragma unroll
            for (int b = 0; b < 2; ++b)
#pragma unroll
                for (int m = 0; m < 4; ++m)
#pragma unroll
                    for (int n = 0; n < 2; ++n) acc[a][b][m][n] = Z; }
        cur = nxt; cA = nA; cB = nB; ++ui;
        if constexpr (ALIGN_EPI) { if (wr == 1) PG8_BAR; }
    }
    PG8_WAIT_V(0);
    if constexpr (!ALIGN_EPI) { if (wr == 0) PG8_BAR; }
    PG8_BAR;
#undef PG8_SA
#undef PG8_SB
#undef PG8_STAGE
#undef PG8_LDA
#undef PG8_LDB
#undef PG8_MMA
#undef PG8_WAIT_V
#undef PG8_WAIT_L
#undef PG8_BAR
#undef PG8_SCHED
#undef PG8_ABASE
}

struct EpiBf16Plain {
    static constexpr bool PERM = true;
    bf16_t* O; int ldc;
    __device__ __forceinline__ void operator()(const f32x4 (&acc)[2][2][4][2], const Unit& u, int wr, int wc, int fr, int fq) const {
        const int row0 = u.pm * BM + wr * 64 + fr; const int col0 = u.pn * BM + wc * 32 + 8 * fq;
#pragma unroll
        for (int ai = 0; ai < 2; ++ai)
#pragma unroll
            for (int m = 0; m < 4; ++m) { bf16_t* rowp = O + (size_t)(row0 + ai * HALF + m * 16) * ldc + col0;
#pragma unroll
                for (int bj = 0; bj < 2; ++bj) { const f32x4 v0 = acc[ai][bj][m][0], v1 = acc[ai][bj][m][1];
                    u32x4 w; w.x = cvt_pk_bf16(v0[0], v0[1]); w.y = cvt_pk_bf16(v0[2], v0[3]); w.z = cvt_pk_bf16(v1[0], v1[1]); w.w = cvt_pk_bf16(v1[2], v1[3]);
                    *(u32x4*)(rowp + bj * HALF) = w; } }
    }
};
struct EpiResid {
    static constexpr bool PERM = true;
    bf16_t* Hb;
    __device__ __forceinline__ void operator()(const f32x4 (&acc)[2][2][4][2], const Unit& u, int wr, int wc, int fr, int fq) const {
        const int row0 = u.pm * BM + wr * 64 + fr, col0 = u.pn * BM + wc * 32 + 8 * fq;
        bf16_t* base = Hb + (size_t)row0 * DM + col0;
        u32x4 hv[2][4][2];
#pragma unroll
        for (int ai = 0; ai < 2; ++ai)
#pragma unroll
            for (int m = 0; m < 4; ++m)
#pragma unroll
                for (int bj = 0; bj < 2; ++bj) hv[ai][m][bj] = *(const u32x4*)(base + (size_t)(ai * HALF + m * 16) * DM + bj * HALF);
#pragma unroll
        for (int ai = 0; ai < 2; ++ai)
#pragma unroll
            for (int m = 0; m < 4; ++m)
#pragma unroll
                for (int bj = 0; bj < 2; ++bj) { const f32x4 v0 = acc[ai][bj][m][0], v1 = acc[ai][bj][m][1]; float p[8]; unpack8(hv[ai][m][bj], p);
                    const float o[8] = {p[0] + v0[0], p[1] + v0[1], p[2] + v0[2], p[3] + v0[3], p[4] + v1[0], p[5] + v1[1], p[6] + v1[2], p[7] + v1[3]};
                    *(u32x4*)(base + (size_t)(ai * HALF + m * 16) * DM + bj * HALF) = pack8(o); }
    }
};
struct EpiLora {
    static constexpr bool PERM = true;
    float* wdec; bf16_t* abuf; bf16_t* gbuf; const float* w0; const float* a0;
    __device__ __forceinline__ void operator()(const f32x4 (&acc)[2][2][4][2], const Unit& u, int wr, int wc, int fr, int fq) const {
        const int row0 = u.pm * BM + wr * 64 + fr; const int type = u.pn >> 2; const int col0 = (u.pn & 3) * BM + wc * 32 + 8 * fq;
        if (type == 0) {
            f32x4 bv[2][2];
#pragma unroll
            for (int bj = 0; bj < 2; ++bj) { bv[bj][0] = *(const f32x4*)(w0 + col0 + bj * HALF); bv[bj][1] = *(const f32x4*)(w0 + col0 + bj * HALF + 4); }
#pragma unroll
            for (int ai = 0; ai < 2; ++ai)
#pragma unroll
                for (int m = 0; m < 4; ++m) { float* rowp = wdec + (size_t)(row0 + ai * HALF + m * 16) * 1024 + col0;
#pragma unroll
                    for (int bj = 0; bj < 2; ++bj)
#pragma unroll
                        for (int n = 0; n < 2; ++n) { f32x4 x = acc[ai][bj][m][n] + bv[bj][n]; f32x4 o;
#pragma unroll
                            for (int i = 0; i < 4; ++i) { const float y = -x[i]; const float sp = fmaxf(y, 0.f) + __logf(1.0f + __expf(-fabsf(y))); o[i] = __expf(-__expf(-sp - 0.5f)); }
                            *(f32x4*)(rowp + bj * HALF + 4 * n) = o; } }
        } else {
            bf16_t* ob = (type == 1) ? abuf : gbuf;
            f32x4 bv[2][2];
#pragma unroll
            for (int bj = 0; bj < 2; ++bj) { bv[bj][0] = *(const f32x4*)(a0 + col0 + bj * HALF); bv[bj][1] = *(const f32x4*)(a0 + col0 + bj * HALF + 4); }
#pragma unroll
            for (int ai = 0; ai < 2; ++ai)
#pragma unroll
                for (int m = 0; m < 4; ++m) { bf16_t* rowp = ob + (size_t)(row0 + ai * HALF + m * 16) * 1024 + col0;
#pragma unroll
                    for (int bj = 0; bj < 2; ++bj) { f32x4 v0 = acc[ai][bj][m][0], v1 = acc[ai][bj][m][1];
                        if (type == 1) { v0 = v0 + bv[bj][0]; v1 = v1 + bv[bj][1];
#pragma unroll
                            for (int i = 0; i < 4; ++i) { v0[i] = sigmoidf_(v0[i]); v1[i] = sigmoidf_(v1[i]); } }
                        u32x4 w; w.x = cvt_pk_bf16(v0[0], v0[1]); w.y = cvt_pk_bf16(v0[2], v0[3]); w.z = cvt_pk_bf16(v1[0], v1[1]); w.w = cvt_pk_bf16(v1[2], v1[3]);
                        *(u32x4*)(rowp + bj * HALF) = w; } }
        }
    }
};
struct EpiGate {
    static constexpr bool PERM = true;
    bf16_t* MG; const bf16_t* P;
    __device__ __forceinline__ void operator()(const f32x4 (&acc)[2][2][4][2], const Unit& u, int wr, int wc, int fr, int fq) const {
        const int br = u.pn >> 3; const int row0 = u.pm * BM + wr * 64 + fr; const int col0 = (u.pn & 7) * BM + wc * 32 + 8 * fq;
        const bf16_t* gbase = P + (size_t)row0 * PN + P_GATES + br * 2048 + col0; bf16_t* mbase = MG + (size_t)row0 * DM + col0;
#pragma unroll
        for (int ai = 0; ai < 2; ++ai) {
            u32x4 gv[4][2], mv[4][2];
#pragma unroll
            for (int m = 0; m < 4; ++m)
#pragma unroll
                for (int bj = 0; bj < 2; ++bj) { gv[m][bj] = *(const u32x4*)(gbase + (size_t)(ai * HALF + m * 16) * PN + bj * HALF);
                    if (br > 0) mv[m][bj] = *(const u32x4*)(mbase + (size_t)(ai * HALF + m * 16) * DM + bj * HALF); }
#pragma unroll
            for (int m = 0; m < 4; ++m)
#pragma unroll
                for (int bj = 0; bj < 2; ++bj) { const f32x4 v0 = acc[ai][bj][m][0], v1 = acc[ai][bj][m][1]; const u32x4 gt = gv[m][bj];
                    float o[8] = { v0[0] * sigmoidf_(bflo(gt.x)), v0[1] * sigmoidf_(bfhi(gt.x)), v0[2] * sigmoidf_(bflo(gt.y)), v0[3] * sigmoidf_(bfhi(gt.y)),
                                   v1[0] * sigmoidf_(bflo(gt.z)), v1[1] * sigmoidf_(bfhi(gt.z)), v1[2] * sigmoidf_(bflo(gt.w)), v1[3] * sigmoidf_(bfhi(gt.w)) };
                    if (br > 0) { float p[8]; unpack8(mv[m][bj], p);
#pragma unroll
                        for (int i = 0; i < 8; ++i) o[i] += p[i]; }
                    *(u32x4*)(mbase + (size_t)(ai * HALF + m * 16) * DM + bj * HALF) = pack8(o); }
        }
    }
};
struct BranchOrder {
    StaticOrder base;
    __device__ bool next(int i, Unit& u) const { Unit t; if (!base.next(i / 3, t)) return false; u.pm = t.pm; u.pn = (i % 3) * 8 + t.pn; return true; }
    __device__ __forceinline__ void a_ready(const Unit&) const {}
    __device__ __forceinline__ void done(const Unit&) const {}
};
struct EpiSwiglu {
    static constexpr bool PERM = true;
    bf16_t* ACT;
    __device__ __forceinline__ void operator()(const f32x4 (&acc)[2][2][4][2], const Unit& u, int wr, int wc, int fr, int fq) const {
        const int row0 = u.pm * BM + wr * 64 + fr; const int col0 = u.pn * BM + wc * 32 + 8 * fq;
#pragma unroll
        for (int ai = 0; ai < 2; ++ai)
#pragma unroll
            for (int m = 0; m < 4; ++m) { const size_t row = (size_t)(row0 + ai * HALF + m * 16);
#pragma unroll
                for (int bj = 0; bj < 2; ++bj) { const int hc = (col0 + bj * HALF) >> 1; const f32x4 g = acc[ai][bj][m][0], up = acc[ai][bj][m][1];
                    float o[4];
#pragma unroll
                    for (int i = 0; i < 4; ++i) o[i] = g[i] * sigmoidf_(g[i]) * up[i];
                    u32x2 w; w.x = cvt_pk_bf16(o[0], o[1]); w.y = cvt_pk_bf16(o[2], o[3]);
                    *(u32x2*)(ACT + row * FFN + hc) = w; } }
    }
};
}

struct Args {
    const float* in[27];
    float* out; unsigned char* ws;
    int s_lo, s_hi, bar_idx, pad;
};
struct Ctx {
    float* out; unsigned char* ws; LAS unsigned char* lds; unsigned* ctl;
    int tid, lane, wave, G, wg;
};
enum { IN_X = 0, IN_META, IN_NORM_MIX, IN_W_IN, IN_MU, IN_W0, IN_W_UP, IN_A0, IN_A_UP, IN_G_UP, IN_K_K, IN_K_A, IN_R_K, IN_LN_W, IN_LN_B, IN_NORM_Q, IN_NORM_KV, IN_W_UQ, IN_W_UKV,
       IN_BR_RWKV, IN_BR_RET, IN_BR_MLA, IN_W_OUT, IN_NORM_FFN, IN_W_GU, IN_W_DOWN, IN_FINAL_NORM };

#define WSP(T, off) ((T*)(C.ws + (off)))
constexpr int LDS_INTBL = LDS_MISC + 256;
__device__ __forceinline__ const float* inp(const Ctx& C, int i) {
    const unsigned long long v = ((volatile LAS unsigned long long*)(C.lds + LDS_INTBL))[i];
    const unsigned lo = __builtin_amdgcn_readfirstlane((unsigned)v), hi = __builtin_amdgcn_readfirstlane((unsigned)(v >> 32));
    return (const float*)(GAS const float*)(((unsigned long long)hi << 32) | lo);
}

__device__ __forceinline__ void ph_rope_tables(const Ctx& C) {
    float* rt = WSP(float, WS_ROPE);
    float* cm = rt; float* sm = rt + LSEQ * 32; float* cr = rt + LSEQ * 64; float* sr = rt + LSEQ * 128;
    for (int i = C.wg * 512 + C.tid; i < LSEQ * 96; i += C.G * 512) {
        const int pos = i / 96, j = i % 96;
        if (j < 32) { const float inv = powf(10000.0f, -((float)(2 * j) / 64.0f)); const float ang = (float)pos * inv; cm[pos * 32 + j] = cosf(ang); sm[pos * 32 + j] = sinf(ang); }
        else { const int jj = j - 32; const float inv = powf(10000.0f, -((float)(2 * jj) / 128.0f)); const float ang = (float)pos * inv; cr[pos * 64 + jj] = cosf(ang); sr[pos * 64 + jj] = sinf(ang); }
    }
}

template <class RowPtr>
__device__ __forceinline__ void conv_T(const Ctx& C, const float* __restrict__ src, int ld, int K, int c0, int ncols, const float* __restrict__ gain, const RowPtr& rowptr, int& tbase) {
    LAS float* tile = (LAS float*)C.lds;
    const int nkt = K / 64, ntile = nkt * (ncols / 64);
    const int t = C.tid, kk = t >> 3, n8 = (t & 7) * 8;
    int ti = (C.wg - (tbase % C.G) + C.G) % C.G;
    tbase += ntile;
    if (ti >= ntile) return;
    f32x4 a, b; float gn;
    { const int k0 = (ti % nkt) * 64, n0 = c0 + (ti / nkt) * 64; const float* sp = src + (size_t)(k0 + kk) * ld + n0 + n8; a = *(const f32x4*)sp; b = *(const f32x4*)(sp + 4); gn = gain ? gain[k0 + kk] : 1.0f; }
    for (; ti < ntile; ti += C.G) {
        const int k0 = (ti % nkt) * 64, n0 = c0 + (ti / nkt) * 64;
        { LAS float* tp = tile + kk * 65 + n8;
          tp[0] = a[0] * gn; tp[1] = a[1] * gn; tp[2] = a[2] * gn; tp[3] = a[3] * gn; tp[4] = b[0] * gn; tp[5] = b[1] * gn; tp[6] = b[2] * gn; tp[7] = b[3] * gn; }
        { const int tn = ti + C.G; if (tn < ntile) { const int k1 = (tn % nkt) * 64, n1 = c0 + (tn / nkt) * 64; const float* sp = src + (size_t)(k1 + kk) * ld + n1 + n8; a = *(const f32x4*)sp; b = *(const f32x4*)(sp + 4); gn = gain ? gain[k1 + kk] : 1.0f; } }
        __syncthreads();
        { const int n = t >> 3, k8 = (t & 7) * 8; bf16_t* dp = rowptr(n0 + n);
          if (dp) { float v[8];
#pragma unroll
              for (int i = 0; i < 8; ++i) v[i] = tile[(k8 + i) * 65 + n];
              u32x4 w; w.x = cvt_pk_bf16(v[0], v[1]); w.y = cvt_pk_bf16(v[2], v[3]); w.z = cvt_pk_bf16(v[4], v[5]); w.w = cvt_pk_bf16(v[6], v[7]);
              *(u32x4*)(dp + k0 + k8) = w; } }
        __syncthreads();
    }
}
struct RpLinear { bf16_t* base; int ldk; int coff; int roff; __device__ __forceinline__ bf16_t* operator()(int n) const { return base + (size_t)(n - coff + roff) * ldk; } };
struct RpWin { bf16_t* win; bf16_t* wvret; __device__ __forceinline__ bf16_t* operator()(int n) const {
    if (n < 5568) return win + (size_t)n * DM; if (n < 6592) return wvret + (size_t)(n - 5568) * DM; return win + (size_t)(n - 1024) * DM; } };
struct RpUkv { bf16_t* wuk; bf16_t* wuv; __device__ __forceinline__ bf16_t* operator()(int n) const { const int h = n >> 8, j = n & 255; return (j < 128 ? wuk + (size_t)(h * 128 + j) * 256 : wuv + (size_t)(h * 128 + j - 128) * 256); } };
struct RpOut3 { bf16_t* base; int seg; __device__ __forceinline__ bf16_t* operator()(int n) const { return base + (size_t)n * 6144 + seg * 2048; } };
struct RpGu { bf16_t* base; __device__ __forceinline__ bf16_t* operator()(int n) const { const int which = n >= FFN ? 1 : 0; const int j = n - which * FFN; return base + (size_t)(8 * (j >> 2) + 4 * which + (j & 3)) * DM; } };

__device__ __forceinline__ void ph_convB(const Ctx& C, int l) {
    int tb = 0;
    conv_T(C, inp(C, IN_W_DOWN) + (size_t)l * FFN * DM, DM, FFN, 0, DM, nullptr, RpLinear{WSP(bf16_t, WS_WD), FFN, 0, 0}, tb);
    conv_T(C, inp(C, IN_W_OUT) + (size_t)l * DM * DM, DM, DM, 0, DM, nullptr, RpLinear{WSP(bf16_t, WS_WOUT), DM, 0, 0}, tb);
    conv_T(C, inp(C, IN_BR_RWKV) + (size_t)l * 1024 * DM, DM, 1024, 0, DM, nullptr, RpLinear{WSP(bf16_t, WS_WBR), 1024, 0, 0}, tb);
    conv_T(C, inp(C, IN_BR_RET) + (size_t)l * 1024 * DM, DM, 1024, 0, DM, nullptr, RpLinear{WSP(bf16_t, WS_WBR), 1024, 0, 2048}, tb);
    conv_T(C, inp(C, IN_BR_MLA) + (size_t)l * 1024 * DM, DM, 1024, 0, DM, nullptr, RpLinear{WSP(bf16_t, WS_WBR), 1024, 0, 4096}, tb);
}

__device__ __forceinline__ void ph_conv(const Ctx& C, int l) {
    int tb = 0;
    conv_T(C, inp(C, IN_W_IN) + (size_t)l * DM * IN_COLS, IN_COLS, DM, 0, IN_COLS, inp(C, IN_NORM_MIX) + l * DM, RpWin{WSP(bf16_t, WS_WIN), WSP(bf16_t, WS_WVRET)}, tb);
    conv_T(C, inp(C, IN_W_GU) + (size_t)l * DM * 2 * FFN, 2 * FFN, DM, 0, 2 * FFN, inp(C, IN_NORM_FFN) + l * DM, RpGu{WSP(bf16_t, WS_WGU)}, tb);
    conv_T(C, inp(C, IN_W_UQ) + (size_t)l * 512 * 1536, 1536, 512, 0, 1536, inp(C, IN_NORM_Q) + l * 512, RpLinear{WSP(bf16_t, WS_WUQ), 512, 0, 0}, tb);
    conv_T(C, inp(C, IN_W_UKV) + (size_t)l * 256 * 2048, 2048, 256, 0, 2048, inp(C, IN_NORM_KV) + l * 256, RpUkv{WSP(bf16_t, WS_WUK), WSP(bf16_t, WS_WUV)}, tb);
    { bf16_t* wl = WSP(bf16_t, WS_WLORA); const float* wup = inp(C, IN_W_UP) + (size_t)l * 96 * 1024; const float* aup = inp(C, IN_A_UP) + (size_t)l * 96 * 1024; const float* gup = inp(C, IN_G_UP) + (size_t)l * 256 * 1024;
      static_assert((LORA_N * LORA_K) % 4 == 0, "lora conversion");
      for (int i0 = (C.wg * 512 + C.tid) * 4; i0 < LORA_N * LORA_K; i0 += C.G * 512 * 4) { float v[4];
#pragma unroll
          for (int e = 0; e < 4; ++e) { const int i = i0 + e, n = i / LORA_K, k = i % LORA_K; v[e] = 0.f;
              if (n < 1024) { if (k < 96) v[e] = wup[k * 1024 + n]; } else if (n < 2048) { if (k >= 96 && k < 192) v[e] = aup[(k - 96) * 1024 + (n - 1024)]; } else { if (k >= 192 && k < 448) v[e] = gup[(k - 192) * 1024 + (n - 2048)]; } }
          *(u32x2*)(wl + i0) = (u32x2){cvt_pk_bf16(v[0], v[1]), cvt_pk_bf16(v[2], v[3])}; } }
}

template <bool FIRST>
__device__ __forceinline__ void ph_norm(const Ctx& C) {
    bf16_t* H = WSP(bf16_t, WS_H); bf16_t* U = WSP(bf16_t, WS_U);
    for (int r0 = C.wg * 8 + C.wave; r0 < MP; r0 += C.G * 16) {
        int rows[2]; rows[0] = r0; rows[1] = r0 + C.G * 8;
        float v[2][4][8]; u32x4 raw[2][4];
#pragma unroll
        for (int rr = 0; rr < 2; ++rr)
#pragma unroll
            for (int i = 0; i < 4; ++i) raw[rr][i] = zero4u();
#pragma unroll
        for (int rr = 0; rr < 2; ++rr) { const int row = rows[rr]; if (row >= M) continue;
            if (FIRST) { const int b = row / LSEQ, pos = row % LSEQ; const float* sp = pos < NMETA ? inp(C, IN_META) + (size_t)pos * DM : inp(C, IN_X) + ((size_t)b * SEQ + (pos - NMETA)) * DM;
#pragma unroll
                for (int i = 0; i < 4; ++i) ld8f(sp + (i * 64 + C.lane) * 8, v[rr][i]); }
            else { const bf16_t* hp = H + (size_t)row * DM;
#pragma unroll
                for (int i = 0; i < 4; ++i) raw[rr][i] = *(const u32x4*)(hp + (i * 64 + C.lane) * 8); } }
        __builtin_amdgcn_sched_barrier(0);
        if (!FIRST) {
#pragma unroll
            for (int rr = 0; rr < 2; ++rr)
#pragma unroll
                for (int i = 0; i < 4; ++i) unpack8(raw[rr][i], v[rr][i]); }
#pragma unroll
        for (int rr = 0; rr < 2; ++rr) { const int row = rows[rr]; if (row >= MP) continue;
            bf16_t* up = U + (size_t)row * DM;
            if (row >= M) { const u32x4 z = zero4u(); for (int i = 0; i < 4; ++i) *(u32x4*)(up + (i * 64 + C.lane) * 8) = z; continue; }
            bf16_t* hp = H + (size_t)row * DM; float ss = 0.f;
#pragma unroll
            for (int i = 0; i < 4; ++i)
#pragma unroll
                for (int j = 0; j < 8; ++j) ss += v[rr][i][j] * v[rr][i][j];
            ss = wsum64(ss); const float rstd = rsqrtf(ss * (1.0f / DM) + NORM_EPS);
#pragma unroll
            for (int i = 0; i < 4; ++i) { if (FIRST) *(u32x4*)(hp + (i * 64 + C.lane) * 8) = pack8(v[rr][i]);
                float o[8];
#pragma unroll
                for (int j = 0; j < 8; ++j) o[j] = v[rr][i][j] * rstd;
                *(u32x4*)(up + (i * 64 + C.lane) * 8) = pack8(o); } }
    }
}
__device__ __forceinline__ void ph_final(const Ctx& C) {
    const bf16_t* H = WSP(bf16_t, WS_H); const float* fn = inp(C, IN_FINAL_NORM);
    f32x4 gn[4][2];
#pragma unroll
    for (int i = 0; i < 4; ++i) { gn[i][0] = *(const f32x4*)(fn + (i * 64 + C.lane) * 8); gn[i][1] = *(const f32x4*)(fn + (i * 64 + C.lane) * 8 + 4); }
    for (int r = C.wg * 8 + C.wave; r < NB * SEQ; r += C.G * 8) {
        const int b = r / SEQ, t = r % SEQ; const bf16_t* sp = H + ((size_t)b * LSEQ + NMETA + t) * DM; float* op = C.out + (size_t)r * DM;
        float v[4][8]; float ss = 0.f; u32x4 raw[4];
#pragma unroll
        for (int i = 0; i < 4; ++i) raw[i] = *(const u32x4*)(sp + (i * 64 + C.lane) * 8);
        __builtin_amdgcn_sched_barrier(0);
#pragma unroll
        for (int i = 0; i < 4; ++i) { unpack8(raw[i], v[i]);
#pragma unroll
            for (int j = 0; j < 8; ++j) ss += v[i][j] * v[i][j]; }
        ss = wsum64(ss); const float rstd = rsqrtf(ss * (1.0f / DM) + NORM_EPS);
#pragma unroll
        for (int i = 0; i < 4; ++i) { const int c = (i * 64 + C.lane) * 8; const f32x4 g0 = gn[i][0], g1 = gn[i][1];
            *(f32x4*)(op + c) = (f32x4){v[i][0] * rstd * g0[0], v[i][1] * rstd * g0[1], v[i][2] * rstd * g0[2], v[i][3] * rstd * g0[3]};
            *(f32x4*)(op + c + 4) = (f32x4){v[i][4] * rstd * g1[0], v[i][5] * rstd * g1[1], v[i][6] * rstd * g1[2], v[i][7] * rstd * g1[3]}; }
    }
}
__device__ __forceinline__ void unpack8(const u32x4 w, float (&x)[8]) { x[0] = bflo(w.x); x[1] = bfhi(w.x); x[2] = bflo(w.y); x[3] = bfhi(w.y); x[4] = bflo(w.z); x[5] = bfhi(w.z); x[6] = bflo(w.w); x[7] = bfhi(w.w); }
__device__ __forceinline__ u32x4 pack8(const float (&x)[8]) { u32x4 w; w.x = cvt_pk_bf16(x[0], x[1]); w.y = cvt_pk_bf16(x[2], x[3]); w.z = cvt_pk_bf16(x[4], x[5]); w.w = cvt_pk_bf16(x[6], x[7]); return w; }

__device__ __forceinline__ void ph_prepA(const Ctx& C, int l) {
    const bf16_t* P = WSP(bf16_t, WS_P); bf16_t* XL = WSP(bf16_t, WS_XL); bf16_t* QN = WSP(bf16_t, WS_QN); bf16_t* KVN = WSP(bf16_t, WS_KVN); bf16_t* KR = WSP(bf16_t, WS_KR);
    const float* mu = inp(C, IN_MU) + (size_t)l * RW_COLS; const float* rt = WSP(float, WS_ROPE); const float* cm = rt; const float* sm = rt + LSEQ * 32;
    const int lane = C.lane;
    for (int row = C.wg * 8 + C.wave; row < MP; row += C.G * 8) {
        if (row >= M) { const u32x4 z = zero4u(); *(u32x4*)(XL + (size_t)row * 512 + 8 * lane) = z; *(u32x4*)(QN + (size_t)row * 512 + 8 * lane) = z;
            if (lane < 32) *(u32x4*)(KVN + (size_t)row * 256 + 8 * lane) = z; KR[(size_t)row * 64 + lane] = (bf16_t)z.x; continue; }
        const int pos = row % LSEQ; const bf16_t* pr = P + (size_t)row * PN;
        const int khl = lane >> 3, kc8 = (lane & 7) * 8; bf16_t* kbase = WSP(bf16_t, WS_P) + (size_t)row * PN + P_KRET + khl * 128 + kc8;
        const u32x4 kx1 = *(const u32x4*)kbase, kx2 = *(const u32x4*)(kbase + 64);
        float kcc[8], kss[8]; ld8f(rt + LSEQ * 64 + pos * 64 + kc8, kcc); ld8f(rt + LSEQ * 128 + pos * 64 + kc8, kss);
        const bool lact = lane < 56; const int lc = 3072 + 8 * (lact ? lane : 0);
        const u32x4 lz = *(const u32x4*)(pr + lc), lpz = *(const u32x4*)((pos > 0 ? pr - PN : pr) + lc); const f32x4 lm0 = *(const f32x4*)(mu + lc), lm1 = *(const f32x4*)(mu + lc + 4);
        const u32x4 qdw = *(const u32x4*)(pr + P_QD + 8 * lane), kvw = *(const u32x4*)(pr + P_KVD + 8 * (lane & 31));
        const bf16_t kr1 = pr[P_KRD + (lane & 31)], kr2 = pr[P_KRD + 32 + (lane & 31)]; const float krc = cm[pos * 32 + (lane & 31)], krs = sm[pos * 32 + (lane & 31)];
        { u32x4 o = zero4u();
          if (lact) { float z[8], pz[8];
              unpack8(lz, z);
              if (pos > 0) unpack8(lpz, pz); else { for (int i = 0; i < 8; ++i) pz[i] = 0.f; }
              const float mm[8] = {lm0[0], lm0[1], lm0[2], lm0[3], lm1[0], lm1[1], lm1[2], lm1[3]};
              float x[8];
#pragma unroll
              for (int i = 0; i < 8; ++i) { const float zs = z[i] + (pz[i] - z[i]) * mm[i]; x[i] = (lane < 12) ? tanhf(zs) : (lane < 24 ? zs : sigmoidf_(zs)); }
              o = pack8(x); }
          *(u32x4*)(XL + (size_t)row * 512 + 8 * lane) = o; }
        { float x[8]; unpack8(qdw, x); float ss = 0.f;
#pragma unroll
          for (int i = 0; i < 8; ++i) ss += x[i] * x[i];
          ss = wsum64(ss); const float rstd = rsqrtf(ss * (1.0f / 512.0f) + NORM_EPS);
#pragma unroll
          for (int i = 0; i < 8; ++i) x[i] *= rstd;
          *(u32x4*)(QN + (size_t)row * 512 + 8 * lane) = pack8(x); }
        { float x[8]; if (lane < 32) unpack8(kvw, x); else { for (int i = 0; i < 8; ++i) x[i] = 0.f; }
          float ss = 0.f;
#pragma unroll
          for (int i = 0; i < 8; ++i) ss += x[i] * x[i];
          ss = wsum64(ss); const float rstd = rsqrtf(ss * (1.0f / 256.0f) + NORM_EPS);
#pragma unroll
          for (int i = 0; i < 8; ++i) x[i] *= rstd;
          if (lane < 32) *(u32x4*)(KVN + (size_t)row * 256 + 8 * lane) = pack8(x); }
        { float x1[8], x2[8], o1[8], o2[8]; unpack8(kx1, x1); unpack8(kx2, x2);
#pragma unroll
          for (int i = 0; i < 8; ++i) { o1[i] = (x1[i] * kcc[i] - x2[i] * kss[i]) * 0.08838834764831845f; o2[i] = (x2[i] * kcc[i] + x1[i] * kss[i]) * 0.08838834764831845f; }
          *(u32x4*)kbase = pack8(o1); *(u32x4*)(kbase + 64) = pack8(o2); }
        if (lane < 32) { const float x1 = bf2f(kr1), x2 = bf2f(kr2); const float c = krc, s = krs;
            KR[(size_t)row * 64 + lane] = f2bf(x1 * c - x2 * s); KR[(size_t)row * 64 + 32 + lane] = f2bf(x2 * c + x1 * s); }
    }
}
__device__ __forceinline__ float sum8(float x) { x += dpp_xor1(x); x += dpp_xor2(x); x += dpp_hmirror(x); return x; }
__device__ __forceinline__ void ld8f(const float* p, float (&x)[8]) { const f32x4 a = *(const f32x4*)p, b = *(const f32x4*)(p + 4); x[0] = a[0]; x[1] = a[1]; x[2] = a[2]; x[3] = a[3]; x[4] = b[0]; x[5] = b[1]; x[6] = b[2]; x[7] = b[3]; }
__device__ __forceinline__ void ph_qrope(const Ctx& C) {
    bf16_t* Q = WSP(bf16_t, WS_Q); const float* rt = WSP(float, WS_ROPE); const float* cm = rt; const float* sm = rt + LSEQ * 32;
    const int lane = C.lane, hl = lane >> 3;
    for (int r0 = C.wg * 8 + C.wave; r0 < M; r0 += C.G * 16) {
        int rows[2]; bool ok[2]; rows[0] = r0; ok[0] = true; rows[1] = r0 + C.G * 8; ok[1] = rows[1] < M; if (!ok[1]) rows[1] = r0;
        u32x2 m1w[2], m2w[2];
#pragma unroll
        for (int rr = 0; rr < 2; ++rr) { const bf16_t* mb = Q + (size_t)rows[rr] * 1536 + hl * 192 + 128 + (lane & 7) * 4; m1w[rr] = *(const u32x2*)mb; m2w[rr] = *(const u32x2*)(mb + 32); }
#pragma unroll
        for (int rr = 0; rr < 2; ++rr) { if (!ok[rr]) continue;
            const int pos = rows[rr] % LSEQ; bf16_t* base = Q + (size_t)rows[rr] * 1536 + hl * 192 + 128 + (lane & 7) * 4; const u32x2 w1 = m1w[rr], w2 = m2w[rr];
            const f32x4 c4 = *(const f32x4*)(cm + pos * 32 + (lane & 7) * 4), s4 = *(const f32x4*)(sm + pos * 32 + (lane & 7) * 4);
            const float x1[4] = {bflo(w1.x), bfhi(w1.x), bflo(w1.y), bfhi(w1.y)}, x2[4] = {bflo(w2.x), bfhi(w2.x), bflo(w2.y), bfhi(w2.y)};
            float o1[4], o2[4];
#pragma unroll
            for (int i = 0; i < 4; ++i) { o1[i] = x1[i] * c4[i] - x2[i] * s4[i]; o2[i] = x2[i] * c4[i] + x1[i] * s4[i]; }
            *(u32x2*)base = (u32x2){cvt_pk_bf16(o1[0], o1[1]), cvt_pk_bf16(o1[2], o1[3])}; *(u32x2*)(base + 32) = (u32x2){cvt_pk_bf16(o2[0], o2[1]), cvt_pk_bf16(o2[2], o2[3])}; }
    }
}
__device__ __forceinline__ void ph_post(const Ctx& C, int l) {
    unsigned char* rw = C.ws + WS_RW; const float* YR = (const float*)(rw + RW_YRAW);
    const bf16_t* Gb = (const bf16_t*)(rw + RW_A + 1 * RW_ARR); const float* BS = (const float*)(rw + RW_A + 2 * RW_ARR); const bf16_t* P = WSP(bf16_t, WS_P);
    bf16_t* YA = WSP(bf16_t, WS_YBR);
    const float* mu_v = inp(C, IN_MU) + (size_t)l * RW_COLS + 2048; const float* ln_w = inp(C, IN_LN_W) + l * 1024; const float* ln_b = inp(C, IN_LN_B) + l * 1024;
    const int lane = C.lane, hl = lane >> 3, c8 = (lane & 7) * 8;
    for (int r0 = C.wg * 8 + C.wave; r0 < MP; r0 += C.G * 16) {
        int rows[2]; bool live[2]; rows[0] = r0; rows[1] = r0 + C.G * 8; live[0] = rows[0] < M; live[1] = rows[1] < M;
#pragma unroll
        for (int rr = 0; rr < 2; ++rr) if (rows[rr] < MP && !live[rr]) { const u32x4 z = zero4u(); *(u32x4*)(YA + (size_t)rows[rr] * 1024 + 16 * lane) = z; *(u32x4*)(YA + (size_t)rows[rr] * 1024 + 16 * lane + 8) = z; }
        u32x4 wv_[2][2], wp_[2][2], wg_[2][2]; f32x4 ya[2][2], yb[2][2]; float bsv[2][2], hpf[2];
#pragma unroll
        for (int rr = 0; rr < 2; ++rr) { const int row = live[rr] ? rows[rr] : 0; const bool hp = (row % LSEQ) > 0; hpf[rr] = hp ? 1.0f : 0.0f;
            const bf16_t* pr = P + (size_t)row * PN + 2048; const bf16_t* pp = hp ? pr - PN : pr;
#pragma unroll
            for (int ps = 0; ps < 2; ++ps) { const int c = (8 * ps + hl) * 64 + c8; const size_t o = (size_t)row * 1024 + c;
                ya[rr][ps] = *(const f32x4*)(YR + o); yb[rr][ps] = *(const f32x4*)(YR + o + 4); wv_[rr][ps] = *(const u32x4*)(pr + c); wp_[rr][ps] = *(const u32x4*)(pp + c); wg_[rr][ps] = *(const u32x4*)(Gb + o);
                bsv[rr][ps] = BS[(size_t)row * 16 + 8 * ps + hl]; } }
#pragma unroll
        for (int ps = 0; ps < 2; ++ps) {
            const int c = (8 * ps + hl) * 64 + c8; float mv[8], lw[8], lb[8];
            ld8f(mu_v + c, mv); ld8f(ln_w + c, lw); ld8f(ln_b + c, lb);
#pragma unroll
            for (int rr = 0; rr < 2; ++rr) {
                float y[8] = {ya[rr][ps][0], ya[rr][ps][1], ya[rr][ps][2], ya[rr][ps][3], yb[rr][ps][0], yb[rr][ps][1], yb[rr][ps][2], yb[rr][ps][3]}, zv[8], qv[8], gg[8], out[8];
                unpack8(wv_[rr][ps], zv); unpack8(wp_[rr][ps], qv); unpack8(wg_[rr][ps], gg);
                const float bs = bsv[rr][ps];
                float s = 0.f;
#pragma unroll
                for (int i = 0; i < 8; ++i) s += y[i];
                const float mean = sum8(s) * (1.0f / 64.0f);
                float q = 0.f;
#pragma unroll
                for (int i = 0; i < 8; ++i) { y[i] -= mean; q += y[i] * y[i]; }
                const float rstd = rsqrtf(sum8(q) * (1.0f / 64.0f) + GN_EPS);
#pragma unroll
                for (int i = 0; i < 8; ++i) { const float vv = zv[i] + (qv[i] * hpf[rr] - zv[i]) * mv[i]; out[i] = (y[i] * rstd * lw[i] + lb[i] + bs * vv) * gg[i]; }
                if (live[rr]) *(u32x4*)(YA + (size_t)rows[rr] * 1024 + c) = pack8(out);
            }
        }
    }
}

#define MFMA_DRAIN(acc) asm volatile("s_nop 15\n\ts_nop 4" : "+v"(acc))
__device__ __forceinline__ void ph_rwkvpre(const Ctx& C, int l) {
    constexpr int WSC = 10240;
    LAS unsigned char* sc = C.lds + C.wave * WSC;
    LAS float* Gm = (LAS float*)sc;
    LAS float* TM = (LAS float*)(sc + 4608);
    LAS float* TMT = TM + 256; LAS float* FT = TM + 512; LAS float* W2 = TM + 768; LAS float* YBT = TM + 1024;
    unsigned char* rw = C.ws + WS_RW;
    const float* WD = (const float*)(rw + RW_WDEC); const bf16_t* Ag = (const bf16_t*)(rw + RW_A); const bf16_t* P = WSP(bf16_t, WS_P);
    float* BS = (float*)(rw + RW_A + 2 * RW_ARR);
    const float* mu = inp(C, IN_MU) + (size_t)l * RW_COLS; const float* k_k = inp(C, IN_K_K) + l * 1024; const float* k_a = inp(C, IN_K_A) + l * 1024; const float* r_k = inp(C, IN_R_K) + l * 1024;
    unsigned char* RCH = C.ws + WS_RCH;
    const int lane = C.lane, ql = lane & 31, hh = lane >> 5, t = lane & 15, q4 = (lane >> 4) * 4;
    for (int u = C.wg * 8 + C.wave; u < NB * 16 * NCHUNK; u += C.G * 8) {
        const int bh = u / NCHUNK, c = u - bh * NCHUNK;
        const int hd = bh & 15, chn = hd * 64 + lane; const size_t row0 = (size_t)(bh >> 4) * LSEQ + 16 * c;
        unsigned char* rec = RCH + (size_t)u * RC_STRIDE;
        float Kb[16], Rb[16], Kh[16], Bh[16]; unsigned vpk[8]; float gC;
        {
            unsigned short zr[17], zk[17], zv[17], za[16]; float wv[16];
#pragma unroll
            for (int i = 0; i < 17; ++i) { const size_t pr = (row0 + (size_t)((i == 0 && c == 0) ? 0 : i - 1)) * PN + chn; zr[i] = P[pr]; zk[i] = P[pr + 1024]; zv[i] = P[pr + 2048]; }
#pragma unroll
            for (int i = 0; i < 16; ++i) { const size_t o = (row0 + i) * 1024 + chn; za[i] = Ag[o]; wv[i] = WD[o]; }
            const float mur = mu[chn], muk = mu[1024 + chn], muv = mu[2048 + chn], kkc = k_k[chn], kac = k_a[chn], rkc = r_k[chn];
            float g = 1.0f; float vxs[16]; int bsv = 0;
#pragma unroll
            for (int i = 0; i < 16; ++i) {
                const float hp = (i == 0 && c == 0) ? 0.0f : 1.0f;
                const float cr = bf2f(zr[i + 1]), ck = bf2f(zk[i + 1]), cv = bf2f(zv[i + 1]);
                const float rr = cr + (bf2f(zr[i]) * hp - cr) * mur, kx = ck + (bf2f(zk[i]) * hp - ck) * muk, vx = cv + (bf2f(zv[i]) * hp - cv) * muv;
                const float av = bf2f(za[i]);
                float kkx = kx * kkc; const float n2 = wsum64_dpp(kkx * kkx); kkx *= __builtin_amdgcn_rsqf(fmaxf(n2, 1e-24f));
                const float kpx = kx * (1.0f + (av - 1.0f) * kac), bbx = kkx * av;
                const float bs = wsum64_dpp(rr * kpx * rkc); bsv = (lane == i) ? __float_as_int(bs) : bsv;
                const float gp = g; g *= wv[i]; const float ig = __builtin_amdgcn_rcpf(g);
                Kb[i] = kkx * gp; Rb[i] = rr * g; Kh[i] = kpx * ig; Bh[i] = bbx * ig;
                vxs[i] = vx;
                *(LAS bf16_t*)(sc + i * 144 + lane * 2) = f2bf(Kh[i]); *(LAS bf16_t*)(sc + (16 + i) * 144 + lane * 2) = f2bf(Bh[i]);
                *(LAS bf16_t*)(sc + 4608 + i * 144 + lane * 2) = f2bf(Kb[i]); *(LAS bf16_t*)(sc + 4608 + (16 + i) * 144 + lane * 2) = f2bf(Rb[i]); }
#pragma unroll
            for (int i = 0; i < 16; ++i) { Kh[i] *= g; Bh[i] *= g; }
            gC = g;
#pragma unroll
            for (int i = 0; i < 8; ++i) vpk[i] = cvt_pk_bf16(vxs[2 * i], vxs[2 * i + 1]);
            if (lane < 16) BS[(row0 + lane) * 16 + hd] = __int_as_float(bsv);
        }
        __builtin_amdgcn_wave_barrier();
        {
            f32x16 acc;
#pragma unroll
            for (int r = 0; r < 16; ++r) acc[r] = 0.f;
#pragma unroll
            for (int s = 0; s < 4; ++s) { const bf16x8 a = *(const LAS bf16x8*)(sc + ql * 144 + 32 * s + 16 * hh); const bf16x8 bq = *(const LAS bf16x8*)(sc + 4608 + ql * 144 + 32 * s + 16 * hh);
                acc = __builtin_amdgcn_mfma_f32_32x32x16_bf16(a, bq, acc, 0, 0, 0); }
            __builtin_amdgcn_wave_barrier();
#pragma unroll
            for (int r = 0; r < 16; ++r) { const int row = (r & 3) + 8 * (r >> 2) + 4 * hh, i = row & 15; const bool keep = (ql >= 16) ? (i <= (ql & 15)) : (i < ql); Gm[row * 36 + ql] = keep ? acc[r] : 0.f; }
        }
        __builtin_amdgcn_wave_barrier();
        {
            float X[16];
#pragma unroll
            for (int i = 15; i >= 0; --i) { float x = (t == i) ? 1.0f : 0.0f; const LAS float* er = Gm + (16 + i) * 36;
#pragma unroll
                for (int j = i + 1; j < 16; ++j) x -= er[j] * X[j];
                X[i] = x; }
#pragma unroll
            for (int i = 0; i < 16; ++i) TM[i * 16 + t] = X[i];
#pragma unroll
            for (int i = 0; i < 4; ++i) *(LAS f32x4*)(TMT + t * 16 + 4 * i) = (f32x4){X[4 * i], X[4 * i + 1], X[4 * i + 2], X[4 * i + 3]};
            float E2c[16];
#pragma unroll
            for (int j = 0; j < 16; ++j) E2c[j] = Gm[(16 + j) * 36 + 16 + t];
#pragma unroll
            for (int e = 0; e < 4; ++e) { const LAS float* ar = Gm + (q4 + e) * 36; float s = 0.f;
#pragma unroll
                for (int i = 0; i < 16; ++i) s += ar[i] * X[i];
                W2[(q4 + e) * 16 + t] = s; }
            __builtin_amdgcn_wave_barrier();
            f32x4 fv, yv;
#pragma unroll
            for (int e = 0; e < 4; ++e) { const LAS float* tr = TM + (q4 + e) * 16; const LAS float* wr = W2 + (q4 + e) * 16; float s = 0.f, y = Gm[(q4 + e) * 36 + 16 + t];
#pragma unroll
                for (int j = 0; j < 16; ++j) { s += tr[j] * E2c[j]; y -= wr[j] * E2c[j]; }
                fv[e] = s; yv[e] = y; }
            *(LAS f32x4*)(FT + t * 16 + q4) = fv; *(LAS f32x4*)(YBT + t * 16 + q4) = yv;
        }
        __builtin_amdgcn_wave_barrier();
        {
            { unsigned char* b2 = rec + RC_B2 + lane * 80;
              *(u32x4*)(b2) = (u32x4){cvt_pk_bf16(-Bh[0], -Bh[1]), cvt_pk_bf16(-Bh[2], -Bh[3]), cvt_pk_bf16(-Bh[4], -Bh[5]), cvt_pk_bf16(-Bh[6], -Bh[7])};
              *(u32x4*)(b2 + 16) = (u32x4){cvt_pk_bf16(-Bh[8], -Bh[9]), cvt_pk_bf16(-Bh[10], -Bh[11]), cvt_pk_bf16(-Bh[12], -Bh[13]), cvt_pk_bf16(-Bh[14], -Bh[15])}; }
            u32x4 kb0, kb1, rb0, rb1, bh0, bh1, kh0, kh1;
#define RC_BOP(src_, t0_, t1_) do { _Pragma("unroll") for (int e = 0; e < 4; ++e) { const unsigned x_ = cvt_pk_bf16(src_[2 * e], src_[2 * e + 1]), y_ = cvt_pk_bf16(src_[8 + 2 * e], src_[9 + 2 * e]); \
                const auto sw_ = __builtin_amdgcn_permlane32_swap(x_, y_, false, false); t0_[e] = sw_[0]; t1_[e] = sw_[1]; } } while (0)
            RC_BOP(Kb, kb0, kb1); RC_BOP(Rb, rb0, rb1); RC_BOP(Bh, bh0, bh1); RC_BOP(Kh, kh0, kh1);
#undef RC_BOP
            const bool lo16 = ql < 16; const int m16 = ql & 15;
            u32x4 aPA, aPB, aIlo, aIhi;
            { const LAS float* ap = (lo16 ? TMT : FT) + m16 * 16 + 8 * hh; const f32x4 a0 = *(const LAS f32x4*)ap, a1 = *(const LAS f32x4*)(ap + 4); const float sg = lo16 ? 1.0f : -1.0f;
              aPA = (u32x4){cvt_pk_bf16(a0[0] * sg, a0[1] * sg), cvt_pk_bf16(a0[2] * sg, a0[3] * sg), cvt_pk_bf16(a1[0] * sg, a1[1] * sg), cvt_pk_bf16(a1[2] * sg, a1[3] * sg)};
              const LAS float* wp = W2 + m16 * 16 + 8 * hh; const f32x4 w0 = *(const LAS f32x4*)wp, w1 = *(const LAS f32x4*)(wp + 4); const float sw = lo16 ? -1.0f : 0.0f;
              aPB = (u32x4){cvt_pk_bf16(w0[0] * sw, w0[1] * sw), cvt_pk_bf16(w0[2] * sw, w0[3] * sw), cvt_pk_bf16(w1[0] * sw, w1[1] * sw), cvt_pk_bf16(w1[2] * sw, w1[3] * sw)};
#pragma unroll
              for (int e = 0; e < 4; ++e) { const unsigned idv = (m16 == 8 * hh + 2 * e ? 0x3F80u : 0u) | (m16 == 8 * hh + 2 * e + 1 ? 0x3F800000u : 0u); aIlo[e] = lo16 ? idv : 0u; aIhi[e] = lo16 ? 0u : idv; } }
            bf16x8 fa, fb, fc, fi;
            bf16_t* b1 = (bf16_t*)rec + ql + (4 * hh) * 88;
            unsigned char* q0 = rec + RC_B2 + ql * 80 + 32 + 8 * hh;
            __builtin_memcpy(&fa, &aPA, 16); __builtin_memcpy(&fi, &aIhi, 16);
#pragma unroll
            for (int T = 0; T < 2; ++T) {
                f32x16 pa;
#pragma unroll
                for (int r = 0; r < 16; ++r) pa[r] = 0.f;
                __builtin_memcpy(&fb, T ? &kb1 : &kb0, 16); __builtin_memcpy(&fc, T ? &rb1 : &rb0, 16);
                pa = __builtin_amdgcn_mfma_f32_32x32x16_bf16(fa, fb, pa, 0, 0, 0); pa = __builtin_amdgcn_mfma_f32_32x32x16_bf16(fi, fc, pa, 0, 0, 0);
                MFMA_DRAIN(pa);
#pragma unroll
                for (int r = 0; r < 16; ++r) b1[((r & 3) + 8 * (r >> 2)) * 88 + 32 * T] = f2bf(pa[r]);
            }
            __builtin_memcpy(&fa, &aPB, 16); __builtin_memcpy(&fi, &aIlo, 16);
#pragma unroll
            for (int T = 0; T < 2; ++T) {
                f32x16 pb;
#pragma unroll
                for (int r = 0; r < 16; ++r) pb[r] = 0.f;
                __builtin_memcpy(&fb, T ? &bh1 : &bh0, 16); __builtin_memcpy(&fc, T ? &kh1 : &kh0, 16);
                pb = __builtin_amdgcn_mfma_f32_32x32x16_bf16(fa, fb, pb, 0, 0, 0); pb = __builtin_amdgcn_mfma_f32_32x32x16_bf16(fi, fc, pb, 0, 0, 0);
                MFMA_DRAIN(pb);
                *(u32x2*)(q0 + T * 32 * 80) = (u32x2){cvt_pk_bf16(pb[0], pb[1]), cvt_pk_bf16(pb[2], pb[3])}; *(u32x2*)(q0 + T * 32 * 80 + 16) = (u32x2){cvt_pk_bf16(pb[4], pb[5]), cvt_pk_bf16(pb[6], pb[7])};
            }
            { const int tr_ = lane >> 2, part = lane & 3; const f32x4 y4 = *(const LAS f32x4*)(YBT + tr_ * 16 + 4 * part);
              unsigned zz; asm volatile("v_mov_b32 %0, 0" : "=v"(zz));
              *(u32x2*)(rec + tr_ * 176 + 128 + 8 * part) = (u32x2){zz, zz};
              *(u32x2*)(rec + (16 + tr_) * 176 + 128 + 8 * part) = (u32x2){cvt_pk_bf16(y4[0], y4[1]), cvt_pk_bf16(y4[2], y4[3])}; }
            unsigned char* vt = rec + RC_VT + lane * 48;
            *(u32x4*)(vt) = (u32x4){vpk[0], vpk[1], vpk[2], vpk[3]}; *(u32x4*)(vt + 16) = (u32x4){vpk[4], vpk[5], vpk[6], vpk[7]};
            *(float*)(rec + RC_G + 4 * lane) = gC;
        }
        __builtin_amdgcn_wave_barrier();
    }
    __syncthreads();
}

#define SEQ_BAR() asm volatile("s_waitcnt lgkmcnt(0)\n\ts_barrier" ::: "memory")
__device__ __forceinline__ void rwkv_seq_unit(const Ctx& C, int b, int hd) {
    constexpr int NR = 8, PF = 6;
    LAS unsigned char* ring = C.lds; LAS unsigned char* Zi = C.lds + NR * RC_STRIDE; LAS unsigned char* Ui = Zi + 64 * 144;
    const unsigned char* recs = C.ws + WS_RCH + (size_t)(b * 16 + hd) * NCHUNK * RC_STRIDE;
    float* YR = (float*)(C.ws + WS_RW + RW_YRAW) + (size_t)b * LSEQ * 1024 + hd * 64;
    const int tid = C.tid, w = C.wave, lane = C.lane, ql = lane & 31, hh = lane >> 5;
    const int lw = w - 4;
    for (int i = tid; i < 576; i += 512) *(LAS u32x4*)(Zi + 16 * i) = zero4u();
    auto issue = [&](int c) {
        const unsigned char* src = recs + (size_t)c * RC_STRIDE + lane * 16; LAS unsigned char* dst = ring + (c & (NR - 1)) * RC_STRIDE;
#pragma unroll
        for (int k = 0; k < 4; ++k) { const int q = lw + 4 * k; if (q < 14) __builtin_amdgcn_global_load_lds((const unsigned*)(src + q * 1024), (LAS unsigned*)(dst + q * 1024), 16, 0, 0); }
    };
    if (w >= 4) {
#pragma unroll
        for (int c = 0; c < PF; ++c) issue(c);
        if (lw < 2) asm volatile("s_waitcnt vmcnt(20)" ::: "memory"); else asm volatile("s_waitcnt vmcnt(15)" ::: "memory");
    }
    f32x16 Zt;
    { float zf; asm volatile("v_mov_b32 %0, 0" : "=v"(zf));
#pragma unroll
      for (int r = 0; r < 16; ++r) Zt[r] = zf; }
    __syncthreads();
    for (int c = 0; c < NCHUNK; ++c) {
        const LAS unsigned char* rec = ring + (c & (NR - 1)) * RC_STRIDE;
        if (w < 2) {
            f32x16 p;
#pragma unroll
            for (int r = 0; r < 16; ++r) p[r] = 0.f;
            const LAS unsigned char* ap = rec + RC_B1 + ql * 176 + hh * 16; const LAS unsigned char* bp = Zi + (32 * w + ql) * 144 + hh * 16;
#pragma unroll
            for (int s = 0; s < 4; ++s) { const bf16x8 a = *(const LAS bf16x8*)(ap + 32 * s); const bf16x8 bq = *(const LAS bf16x8*)(bp + 32 * s); p = __builtin_amdgcn_mfma_f32_32x32x16_bf16(a, bq, p, 0, 0, 0); }
            { const bf16x8 a = *(const LAS bf16x8*)(ap + 128); const bf16x8 bq = *(const LAS bf16x8*)(rec + RC_VT + (32 * w + ql) * 48 + hh * 16); p = __builtin_amdgcn_mfma_f32_32x32x16_bf16(a, bq, p, 0, 0, 0); }
            MFMA_DRAIN(p);
            LAS unsigned char* up = Ui + (32 * w + ql) * 48 + hh * 8;
            *(LAS u32x2*)up = (u32x2){cvt_pk_bf16(p[0], p[1]), cvt_pk_bf16(p[2], p[3])}; *(LAS u32x2*)(up + 16) = (u32x2){cvt_pk_bf16(p[4], p[5]), cvt_pk_bf16(p[6], p[7])};
            float* yp = YR + (size_t)(16 * c + 4 * hh) * 1024 + 32 * w + ql;
#pragma unroll
            for (int r = 8; r < 16; ++r) yp[((r & 3) + 8 * ((r - 8) >> 2)) * 1024] = p[r];
        } else if (w >= 4) {
            if (c + PF < NCHUNK) issue(c + PF);
        }
        SEQ_BAR();
        if (w < 4) {
            const int ti = w >> 1, tj = w & 1;
            const LAS float* gp = (const LAS float*)(rec + RC_G) + 32 * ti + 4 * hh;
#pragma unroll
            for (int q = 0; q < 4; ++q) { const f32x4 g4 = *(const LAS f32x4*)(gp + 8 * q); Zt[4 * q] *= g4[0]; Zt[4 * q + 1] *= g4[1]; Zt[4 * q + 2] *= g4[2]; Zt[4 * q + 3] *= g4[3]; }
            const LAS unsigned char* ap = rec + RC_B2 + (32 * ti + ql) * 80 + hh * 16;
            const bf16x8 a0 = *(const LAS bf16x8*)ap, a1 = *(const LAS bf16x8*)(ap + 32);
            const bf16x8 b0 = *(const LAS bf16x8*)(Ui + (32 * tj + ql) * 48 + hh * 16), b1 = *(const LAS bf16x8*)(rec + RC_VT + (32 * tj + ql) * 48 + hh * 16);
            Zt = __builtin_amdgcn_mfma_f32_32x32x16_bf16(a0, b0, Zt, 0, 0, 0);
            Zt = __builtin_amdgcn_mfma_f32_32x32x16_bf16(a1, b1, Zt, 0, 0, 0);
            MFMA_DRAIN(Zt);
            LAS unsigned char* zp = Zi + (32 * tj + ql) * 144 + (32 * ti + 4 * hh) * 2;
#pragma unroll
            for (int q = 0; q < 4; ++q) *(LAS u32x2*)(zp + 16 * q) = (u32x2){cvt_pk_bf16(Zt[4 * q], Zt[4 * q + 1]), cvt_pk_bf16(Zt[4 * q + 2], Zt[4 * q + 3])};
        } else {
            if (c + PF < NCHUNK) { if (lw < 2) asm volatile("s_waitcnt vmcnt(20)" ::: "memory"); else asm volatile("s_waitcnt vmcnt(15)" ::: "memory"); }
            else asm volatile("s_waitcnt vmcnt(0)" ::: "memory");
        }
        SEQ_BAR();
    }
}

template <int MODE>
__device__ __forceinline__ void attn_unit(const Ctx& C, int b, int hd, int qblk) {
    constexpr int DQ = MODE == 0 ? 192 : 128, NS = DQ / 16, KP = DQ * 2 + 16, VP = 136;
    constexpr int KB_BYTES = 64 * KP, VB_BYTES = 128 * VP, NKPC = 64 * (DQ / 8) / 512;
    LAS unsigned char* Kb = C.lds; LAS unsigned char* Vbuf = C.lds + 2 * KB_BYTES;
    const bf16_t* P = WSP(bf16_t, WS_P); const bf16_t* Qm = WSP(bf16_t, WS_Q); const bf16_t* KN = WSP(bf16_t, WS_KNOPE); const bf16_t* KRp = WSP(bf16_t, WS_KR);
    const bf16_t* VT = MODE == 0 ? WSP(bf16_t, WS_VTMLA) : WSP(bf16_t, WS_VTRET);
    bf16_t* Y = WSP(bf16_t, WS_YBR) + (MODE == 0 ? 2 : 1) * (size_t)MP * 1024;
    const int tid = C.tid, w = C.wave, lane = C.lane, ql = lane & 31, hh = lane >> 5;
    const size_t rb = (size_t)b * LSEQ;
    const int qpos = 256 * qblk + 32 * w + ql; const bool qvalid = qpos < LSEQ; const int qposc = qvalid ? qpos : LSEQ - 1;
    const int wqmin = 256 * qblk + 32 * w; const bool wactive = wqmin < LSEQ; const int wqmax = (wqmin + 31 < LSEQ - 1) ? wqmin + 31 : LSEQ - 1;
    const int nkt = (4 * qblk + 4 < 65) ? 4 * qblk + 4 : 65;
    const int j0 = MODE == 1 ? 4 * qblk : 0;
    bf16x8 Qf[NS];
    { const bf16_t* qrow = MODE == 0 ? Qm + (rb + qposc) * 1536 + hd * 192 : P + (rb + qposc) * PN + P_QRET + hd * 128;
#pragma unroll
      for (int s = 0; s < NS; ++s) Qf[s] = *(const bf16x8*)(qrow + 16 * s + 8 * hh); }
    if (MODE == 1) {
        const float* rt = WSP(float, WS_ROPE);
        constexpr int NP = MODE == 0 ? 2 : 4, S0 = MODE == 0 ? 8 : 0, DS = MODE == 0 ? 2 : 4;
        const float* cp = MODE == 0 ? rt + (size_t)qposc * 32 + 8 * hh : rt + (size_t)LSEQ * 64 + (size_t)qposc * 64 + 8 * hh;
        const float* sp = MODE == 0 ? rt + (size_t)LSEQ * 32 + (size_t)qposc * 32 + 8 * hh : rt + (size_t)LSEQ * 128 + (size_t)qposc * 64 + 8 * hh;
#pragma unroll
        for (int s = 0; s < NP; ++s) { u32x4 w1, w2; __builtin_memcpy(&w1, &Qf[S0 + s], 16); __builtin_memcpy(&w2, &Qf[S0 + s + DS], 16);
            float x1[8], x2[8], cc[8], ss[8], o1[8], o2[8]; unpack8(w1, x1); unpack8(w2, x2); ld8f(cp + 16 * s, cc); ld8f(sp + 16 * s, ss);
#pragma unroll
            for (int e = 0; e < 8; ++e) { o1[e] = x1[e] * cc[e] - x2[e] * ss[e]; o2[e] = x2[e] * cc[e] + x1[e] * ss[e]; }
            w1 = pack8(o1); w2 = pack8(o2); __builtin_memcpy(&Qf[S0 + s], &w1, 16); __builtin_memcpy(&Qf[S0 + s + DS], &w2, 16); }
    }
    f32x16 O[4];
#pragma unroll
    for (int d = 0; d < 4; ++d)
#pragma unroll
        for (int r = 0; r < 16; ++r) O[d][r] = 0.f;
    float m_run = -INFINITY, lsum = 0.f;
    const float csm = 0.07216878364870322f * 1.4426950408889634f;
    const float lg2g = MODE == 1 ? log1pf(-exp2f(-5.0f - (float)hd)) * 1.4426950408889634f : 0.f;
    u32x4 kreg[NKPC], vreg[2];
    auto gload = [&](int j) {
#pragma unroll
        for (int i = 0; i < NKPC; ++i) { const int pi = tid + i * 512, r = pi / (DQ / 8), c = pi % (DQ / 8); const size_t krow = rb + 64 * j + r;
            const bf16_t* sp;
            if (MODE == 0) sp = (c < 16) ? KN + krow * 1024 + hd * 128 + 8 * c : KRp + krow * 64 + 8 * (c - 16);
            else sp = P + krow * PN + P_KRET + hd * 128 + 8 * c;
            kreg[i] = *(const u32x4*)sp; }
#pragma unroll
        for (int i = 0; i < 2; ++i) { const int pi = tid + i * 512, dv = pi >> 3, c = pi & 7; vreg[i] = *(const u32x4*)(VT + (size_t)(hd * 128 + dv) * MP + rb + 64 * j + 8 * c); }
    };
    auto lstore = [&](int buf) {
#pragma unroll
        for (int i = 0; i < NKPC; ++i) { const int pi = tid + i * 512, r = pi / (DQ / 8), c = pi % (DQ / 8); *(LAS u32x4*)(Kb + buf * KB_BYTES + r * KP + 16 * c) = kreg[i]; }
#pragma unroll
        for (int i = 0; i < 2; ++i) { const int pi = tid + i * 512, dv = pi >> 3, c = pi & 7; LAS unsigned char* dp = Vbuf + buf * VB_BYTES + dv * VP + 16 * c;
            *(LAS u32x2*)dp = (u32x2){vreg[i].x, vreg[i].y}; *(LAS u32x2*)(dp + 8) = (u32x2){vreg[i].z, vreg[i].w}; }
    };
    gload(j0);
    if (MODE == 1 && qblk > 0) {
        constexpr int RP = 272; LAS unsigned char* RT = C.lds + 2 * KB_BYTES + 2 * VB_BYTES;
        const float* KVT = WSP(float, WS_KVT) + (size_t)((b * 8 + hd) * 16) * 16384;
        const int dvr = tid >> 2, d0 = (tid & 3) * 32;
        f32x4 acc8[8];
#pragma unroll
        for (int i = 0; i < 8; ++i) acc8[i] = (f32x4){0.f, 0.f, 0.f, 0.f};
#pragma unroll 2
        for (int kp = 0; kp < qblk; ++kp) { const float f = __builtin_amdgcn_exp2f(lg2g * 256.0f * (float)(qblk - 1 - kp)); const float* sp = KVT + (size_t)kp * 16384 + dvr * 128 + d0;
#pragma unroll
            for (int i = 0; i < 8; ++i) acc8[i] = acc8[i] + *(const f32x4*)(sp + 4 * i) * f; }
#pragma unroll
        for (int i = 0; i < 4; ++i) { u32x4 wv; wv.x = cvt_pk_bf16(acc8[2 * i][0], acc8[2 * i][1]); wv.y = cvt_pk_bf16(acc8[2 * i][2], acc8[2 * i][3]); wv.z = cvt_pk_bf16(acc8[2 * i + 1][0], acc8[2 * i + 1][1]); wv.w = cvt_pk_bf16(acc8[2 * i + 1][2], acc8[2 * i + 1][3]);
            *(LAS u32x4*)(RT + dvr * RP + (d0 + 8 * i) * 2) = wv; }
        __syncthreads();
        if (wactive) {
#pragma unroll
            for (int d = 0; d < 4; ++d)
#pragma unroll
                for (int s = 0; s < NS; ++s) { const bf16x8 a = *(const LAS bf16x8*)(RT + (32 * d + ql) * RP + (16 * s + 8 * hh) * 2); O[d] = __builtin_amdgcn_mfma_f32_32x32x16_bf16(a, Qf[s], O[d], 0, 0, 0); }
            const float fq = __builtin_amdgcn_exp2f(lg2g * (float)(qposc - 256 * qblk + 1));
#pragma unroll
            for (int d = 0; d < 4; ++d)
#pragma unroll
                for (int r = 0; r < 16; ++r) O[d][r] *= fq;
        }
    }
    lstore(0);
    __syncthreads();
    for (int j = j0; j < nkt; ++j) {
        if (j + 1 < nkt) gload(j + 1);
        if (wactive && 64 * j <= wqmax) {
            const LAS unsigned char* kb = Kb + ((j - j0) & 1) * KB_BYTES; const LAS unsigned char* vb = Vbuf + ((j - j0) & 1) * VB_BYTES;
            f32x16 st[2];
            {
                constexpr int QG = NS / 4;
                bf16x8 kf[1][QG];
#define AT_RK(g) do { _Pragma("unroll") for (int s = 0; s < QG; ++s) { constexpr int kt_ = ((g) * QG) / NS; const int f_ = ((g) * QG) % NS + s; kf[0][s] = *(const LAS bf16x8*)(kb + (32 * kt_ + ql) * KP + (16 * f_ + 8 * hh) * 2); } } while (0)
#define AT_MK(g) do { _Pragma("unroll") for (int s = 0; s < QG; ++s) { constexpr int kt_ = ((g) * QG) / NS; const int f_ = ((g) * QG) % NS + s; st[kt_] = __builtin_amdgcn_mfma_f32_32x32x16_bf16(kf[0][s], Qf[f_], st[kt_], 0, 0, 0); } } while (0)
#define AT_SB() __builtin_amdgcn_sched_barrier(0)
#pragma unroll
                for (int r = 0; r < 16; ++r) { st[0][r] = 0.f; st[1][r] = 0.f; }
                AT_RK(0); AT_SB(); AT_MK(0); AT_SB(); AT_RK(1); AT_SB(); AT_MK(1); AT_SB(); AT_RK(2); AT_SB(); AT_MK(2); AT_SB(); AT_RK(3); AT_SB(); AT_MK(3); AT_SB();
                AT_RK(4); AT_SB(); AT_MK(4); AT_SB(); AT_RK(5); AT_SB(); AT_MK(5); AT_SB(); AT_RK(6); AT_SB(); AT_MK(6); AT_SB(); AT_RK(7); AT_SB(); AT_MK(7); AT_SB();
#undef AT_RK
#undef AT_MK
            }
            const int kbase = 64 * j + 4 * hh;
            if (MODE == 0) {
                if (64 * j + 63 > wqmin) {
#pragma unroll
                    for (int kt = 0; kt < 2; ++kt)
#pragma unroll
                        for (int r = 0; r < 16; ++r) { const int kpos = kbase + 32 * kt + (r & 3) + 8 * (r >> 2); if (kpos > qposc) st[kt][r] = -INFINITY; }
                }
                float tm0 = fmaxf(st[0][0], st[1][0]), tm1 = fmaxf(st[0][1], st[1][1]);
#pragma unroll
                for (int r = 2; r < 16; r += 2) { tm0 = fmaxf(tm0, fmaxf(st[0][r], st[1][r])); tm1 = fmaxf(tm1, fmaxf(st[0][r + 1], st[1][r + 1])); }
                const float tmax = hmax32(fmaxf(tm0, tm1));
                if (__builtin_amdgcn_ballot_w64(tmax > m_run) != 0ull) {
                    const float m_new = fmaxf(m_run, tmax);
                    const float alpha = __builtin_amdgcn_exp2f((m_run - m_new) * csm);
                    m_run = m_new; lsum *= alpha;
#pragma unroll
                    for (int d = 0; d < 4; ++d)
#pragma unroll
                        for (int r = 0; r < 16; ++r) O[d][r] *= alpha;
                }
                const float mb = m_run * csm;
                float ps = 0.f;
#pragma unroll
                for (int kt = 0; kt < 2; ++kt)
#pragma unroll
                    for (int r = 0; r < 16; ++r) { const float p = __builtin_amdgcn_exp2f(st[kt][r] * csm - mb); st[kt][r] = p; ps += p; }
                lsum += ps;
            } else {
#pragma unroll
                for (int kt = 0; kt < 2; ++kt)
#pragma unroll
                    for (int r = 0; r < 16; ++r) { const int kpos = kbase + 32 * kt + (r & 3) + 8 * (r >> 2); const int dd = qposc - kpos;
                        st[kt][r] = dd >= 0 ? st[kt][r] * __builtin_amdgcn_exp2f(lg2g * (float)dd) : 0.f; }
            }
            {
            u32x2 vlo[1][4], vhi[1][4];
#define AT_RV(g, b) do { _Pragma("unroll") for (int d = 0; d < 4; ++d) { const LAS unsigned char* ap = vb + (32 * d + ql) * VP + (32 * ((g) >> 1) + 16 * ((g) & 1) + 4 * hh) * 2; vlo[b][d] = *(const LAS u32x2*)ap; vhi[b][d] = *(const LAS u32x2*)(ap + 16); } } while (0)
#define AT_MV(g, b) do { constexpr int kt_ = (g) >> 1, s2_ = (g) & 1; \
                u32x4 pw; pw.x = cvt_pk_bf16(st[kt_][8 * s2_ + 0], st[kt_][8 * s2_ + 1]); pw.y = cvt_pk_bf16(st[kt_][8 * s2_ + 2], st[kt_][8 * s2_ + 3]); \
                pw.z = cvt_pk_bf16(st[kt_][8 * s2_ + 4], st[kt_][8 * s2_ + 5]); pw.w = cvt_pk_bf16(st[kt_][8 * s2_ + 6], st[kt_][8 * s2_ + 7]); \
                bf16x8 pf; __builtin_memcpy(&pf, &pw, 16); \
                _Pragma("unroll") for (int d = 0; d < 4; ++d) { u32x4 aw = (u32x4){vlo[b][d].x, vlo[b][d].y, vhi[b][d].x, vhi[b][d].y}; bf16x8 af; __builtin_memcpy(&af, &aw, 16); \
                    O[d] = __builtin_amdgcn_mfma_f32_32x32x16_bf16(af, pf, O[d], 0, 0, 0); } } while (0)
            AT_SB(); AT_RV(0, 0); AT_SB();
            AT_MV(0, 0); AT_SB(); AT_RV(1, 0); AT_SB();
            AT_MV(1, 0); AT_SB(); AT_RV(2, 0); AT_SB();
            AT_MV(2, 0); AT_SB(); AT_RV(3, 0); AT_SB();
            AT_MV(3, 0);
#undef AT_MV
#undef AT_RV
#undef AT_SB
            }
        }
        if (j + 1 < nkt) lstore((j + 1 - j0) & 1);
        __syncthreads();
    }
    if (MODE == 0) {
        const float lt = hsum32(lsum); const float inv = 1.0f / lt;
        if (qvalid) { bf16_t* yp = Y + (rb + qpos) * 1024 + hd * 128;
#pragma unroll
            for (int d = 0; d < 4; ++d)
#pragma unroll
                for (int rg = 0; rg < 4; ++rg) { const int dv0 = 32 * d + 8 * rg + 4 * hh;
                    *(u32x2*)(yp + dv0) = (u32x2){cvt_pk_bf16(O[d][4 * rg] * inv, O[d][4 * rg + 1] * inv), cvt_pk_bf16(O[d][4 * rg + 2] * inv, O[d][4 * rg + 3] * inv)}; } }
    } else {
        u32x2 gws[4][4];
        { const bf16_t* gp = P + (rb + qposc) * PN + P_GRET + hd * 128 + 4 * hh;
#pragma unroll
          for (int d = 0; d < 4; ++d)
#pragma unroll
              for (int rg = 0; rg < 4; ++rg) gws[d][rg] = *(const u32x2*)(gp + 32 * d + 8 * rg); }
        float ss = 0.f;
#pragma unroll
        for (int d = 0; d < 4; ++d)
#pragma unroll
            for (int r = 0; r < 16; ++r) ss += O[d][r] * O[d][r];
        ss = hsum32(ss); const float rstd = rsqrtf(ss * (1.0f / 128.0f) + NORM_EPS);
        if (qvalid) { bf16_t* yp = Y + (rb + qpos) * 1024 + hd * 128;
#pragma unroll
            for (int d = 0; d < 4; ++d)
#pragma unroll
                for (int rg = 0; rg < 4; ++rg) { const int dv0 = 32 * d + 8 * rg + 4 * hh; const u32x2 gw = gws[d][rg];
                    const float g0 = bflo(gw.x), g1 = bfhi(gw.x), g2 = bflo(gw.y), g3 = bfhi(gw.y);
                    const float o0 = O[d][4 * rg] * rstd * g0 * sigmoidf_(g0), o1 = O[d][4 * rg + 1] * rstd * g1 * sigmoidf_(g1), o2 = O[d][4 * rg + 2] * rstd * g2 * sigmoidf_(g2), o3 = O[d][4 * rg + 3] * rstd * g3 * sigmoidf_(g3);
                    *(u32x2*)(yp + dv0) = (u32x2){cvt_pk_bf16(o0, o1), cvt_pk_bf16(o2, o3)}; } }
    }
}

__device__ __forceinline__ void ph_retkv(const Ctx& C) {
    constexpr int VP = 136, TB = 128 * VP;
    LAS unsigned char* Vb = C.lds; LAS unsigned char* Kt = C.lds + TB;
    const bf16_t* P = WSP(bf16_t, WS_P); const bf16_t* VT = WSP(bf16_t, WS_VTRET); float* KVT = WSP(float, WS_KVT);
    const int tid = C.tid, w = C.wave, lane = C.lane, ql = lane & 31, hh = lane >> 5;
    for (int u = C.wg; u < NB * 8 * 16; u += C.G) {
        const int b = u >> 7, hd = (u >> 4) & 7, kb = u & 15; const size_t rb = (size_t)b * LSEQ + 256 * kb;
        const float lg2g = log1pf(-exp2f(-5.0f - (float)hd)) * 1.4426950408889634f;
        f32x16 acc[2];
#pragma unroll
        for (int r = 0; r < 16; ++r) { acc[0][r] = 0.f; acc[1][r] = 0.f; }
        for (int j = 0; j < 4; ++j) {
            __syncthreads();
#pragma unroll
            for (int i = 0; i < 2; ++i) { const int pi = tid + i * 512;
                { const int dv = pi >> 3, c = pi & 7; const u32x4 v = *(const u32x4*)(VT + (size_t)(hd * 128 + dv) * MP + rb + 64 * j + 8 * c); LAS unsigned char* dp = Vb + dv * VP + 16 * c;
                  *(LAS u32x2*)dp = (u32x2){v.x, v.y}; *(LAS u32x2*)(dp + 8) = (u32x2){v.z, v.w}; }
                { const int key = pi >> 4, c = pi & 15; float x[8]; unpack8(*(const u32x4*)(P + (rb + 64 * j + key) * PN + P_KRET + hd * 128 + 8 * c), x);
                  const float f = __builtin_amdgcn_exp2f(lg2g * (float)(255 - 64 * j - key));
#pragma unroll
                  for (int e = 0; e < 8; ++e) *(LAS bf16_t*)(Kt + (8 * c + e) * VP + key * 2) = f2bf(x[e] * f); } }
            __syncthreads();
#pragma unroll
            for (int s = 0; s < 4; ++s) {
                const LAS unsigned char* ap = Vb + (32 * (w >> 1) + ql) * VP + (16 * s + 8 * hh) * 2; const u32x2 alo = *(const LAS u32x2*)ap, ahi = *(const LAS u32x2*)(ap + 8);
                u32x4 aw = (u32x4){alo.x, alo.y, ahi.x, ahi.y}; bf16x8 af; __builtin_memcpy(&af, &aw, 16);
#pragma unroll
                for (int t = 0; t < 2; ++t) { const LAS unsigned char* bp = Kt + (32 * (2 * (w & 1) + t) + ql) * VP + (16 * s + 8 * hh) * 2; const u32x2 blo = *(const LAS u32x2*)bp, bhi = *(const LAS u32x2*)(bp + 8);
                    u32x4 bw = (u32x4){blo.x, blo.y, bhi.x, bhi.y}; bf16x8 bf; __builtin_memcpy(&bf, &bw, 16);
                    acc[t] = __builtin_amdgcn_mfma_f32_32x32x16_bf16(af, bf, acc[t], 0, 0, 0); }
            }
        }
        float* op = KVT + (size_t)u * 16384;
#pragma unroll
        for (int t = 0; t < 2; ++t)
#pragma unroll
            for (int r = 0; r < 16; ++r) { const int dv = 32 * (w >> 1) + (r & 3) + 8 * (r >> 2) + 4 * hh; op[dv * 128 + 32 * (2 * (w & 1) + t) + ql] = acc[t][r]; }
    }
    __syncthreads();
}

__device__ __forceinline__ int q_pop(const Ctx& C, unsigned* head) {
    volatile LAS int* item = (volatile LAS int*)(C.lds + LDS_MISC + 64);
    __syncthreads();
    if (C.tid == 0) *item = (int)__hip_atomic_fetch_add(head, 1u, __ATOMIC_RELAXED, __HIP_MEMORY_SCOPE_AGENT);
    __syncthreads();
    return *item;
}
__device__ __forceinline__ void ph_mix(const Ctx& C, int l) {
    unsigned* head = C.ctl + CW_QUEUE + 256 * l;
    for (;;) { const int it = q_pop(C, head); if (it >= 64) break; rwkv_seq_unit(C, it >> 4, it & 15); }
    for (;;) { const int it = q_pop(C, head + 128); if (it >= 17 * 32) break; attn_unit<1>(C, (it & 31) >> 3, it & 7, 16 - (it >> 5)); }
    for (;;) { const int it = q_pop(C, head + 64); if (it >= 17 * 32) break; attn_unit<0>(C, (it & 31) >> 3, it & 7, 16 - (it >> 5)); }
}

constexpr int MMAIN = 16384;
template <int KIND>
__device__ __forceinline__ void tail_units(const Ctx& C, const bf16_t* A, const bf16_t* Bt, const int K, const int nunits, bf16_t* Hb, bf16_t* Ob, const bf16_t* P) {
    constexpr int NB = KIND == 1 ? 2 : 1, NBR = KIND == 2 ? 3 : 1;
    const int ql = C.lane & 31, hh = C.lane >> 5, w = C.wave; const int KS = K / 8;
    LAS float* red = (LAS float*)C.lds;
    for (int t = C.wg; t < nunits; t += C.G) {
        float tot[4] = {0.f, 0.f, 0.f, 0.f};
        for (int br = 0; br < NBR; ++br) {
        f32x16 acc[NB][2];
#pragma unroll
        for (int q = 0; q < NB; ++q)
#pragma unroll
            for (int r = 0; r < 16; ++r) { acc[q][0][r] = 0.f; acc[q][1][r] = 0.f; }
        const bf16_t* Au = (KIND == 2) ? A + (size_t)br * MP * 1024 : A;
        const bf16_t* a0 = Au + (size_t)(MMAIN + ql) * K + w * KS + 8 * hh;
        const bf16_t* bp[NB];
        if (KIND == 1) { const int j = 32 * t + ql; const int grow = 8 * (j >> 2) + (j & 3); bp[0] = Bt + (size_t)grow * K + w * KS + 8 * hh; bp[NB - 1] = Bt + (size_t)(grow + 4) * K + w * KS + 8 * hh; }
        else bp[0] = Bt + (size_t)(br * 2048 + 32 * t + ql) * K + w * KS + 8 * hh;
        for (int k = 0; k < KS; k += 64) { bf16x8 af0[4], af1[4], bfr[NB][4];
#pragma unroll
            for (int u = 0; u < 4; ++u) { af0[u] = *(const bf16x8*)(a0 + k + 16 * u); af1[u] = *(const bf16x8*)(a0 + (size_t)32 * K + k + 16 * u);
#pragma unroll
                for (int q = 0; q < NB; ++q) bfr[q][u] = *(const bf16x8*)(bp[q] + k + 16 * u); }
#pragma unroll
            for (int u = 0; u < 4; ++u)
#pragma unroll
                for (int q = 0; q < NB; ++q) { acc[q][0] = __builtin_amdgcn_mfma_f32_32x32x16_bf16(af0[u], bfr[q][u], acc[q][0], 0, 0, 0); acc[q][1] = __builtin_amdgcn_mfma_f32_32x32x16_bf16(af1[u], bfr[q][u], acc[q][1], 0, 0, 0); } }
        __syncthreads();
#pragma unroll
        for (int q = 0; q < NB; ++q)
#pragma unroll
            for (int hf = 0; hf < 2; ++hf)
#pragma unroll
                for (int r = 0; r < 16; ++r) red[((q * 8 + w) * 32 + hf * 16 + r) * 64 + C.lane] = acc[q][hf][r];
        __syncthreads();
#pragma unroll
        for (int i = 0; i < 4; ++i) { const int hr = 4 * w + i, hf = hr >> 4, r = hr & 15; float s0 = 0.f, s1 = 0.f;
#pragma unroll
            for (int ww = 0; ww < 8; ++ww) { s0 += red[(ww * 32 + hr) * 64 + C.lane]; if (NB == 2) s1 += red[((8 + ww) * 32 + hr) * 64 + C.lane]; }
            const int row = MMAIN + 32 * hf + (r & 3) + 8 * (r >> 2) + 4 * hh; const int c = 32 * t + ql;
            if (KIND == 0) { bf16_t* p = Hb + (size_t)row * DM + c; *p = f2bf(bf2f(*p) + s0); }
            else if (KIND == 1) Ob[(size_t)row * FFN + c] = f2bf(s0 * sigmoidf_(s0) * s1);
            else { tot[i] += s0 * sigmoidf_(bf2f(P[(size_t)row * PN + P_GATES + br * 2048 + c])); if (br == NBR - 1) Ob[(size_t)row * DM + c] = f2bf(tot[i]); } }
        }
    }
    __syncthreads();
}
#define T16_STEP(NS, k) do { bf16x8 a_[NS], b0_[NS], b1_[NS]; \
        _Pragma("unroll") for (int s_ = 0; s_ < NS; ++s_) { a_[s_] = *(const bf16x8*)(ap + (k) + 32 * s_); b0_[s_] = *(const bf16x8*)(bp + (k) + 32 * s_); b1_[s_] = *(const bf16x8*)(bp + (size_t)16 * K + (k) + 32 * s_); } \
        _Pragma("unroll") for (int s_ = 0; s_ < NS; ++s_) { acc0 = __builtin_amdgcn_mfma_f32_16x16x32_bf16(a_[s_], b0_[s_], acc0, 0, 0, 0); acc1 = __builtin_amdgcn_mfma_f32_16x16x32_bf16(a_[s_], b1_[s_], acc1, 0, 0, 0); } } while (0)
template <int KIND>
__device__ __forceinline__ void tail16(const Ctx& C, const bf16_t* A, const bf16_t* Bt, const int K, bf16_t* Hb, bf16_t* Ob, const bf16_t* P) {
    constexpr int NBR = KIND == 2 ? 3 : 1;
    const int r = C.lane & 15, kq = C.lane >> 4, w = C.wave; const int KS = K / 8;
    LAS float* red = (LAS float*)C.lds;
    for (int un = C.wg; un < 256; un += C.G) {
        const int rg = (un >> 3) & 3, t = (un & 7) + 8 * (un >> 5);
        float tot = 0.f;
        for (int br = 0; br < NBR; ++br) {
            f32x4 acc0 = {0.f, 0.f, 0.f, 0.f}, acc1 = {0.f, 0.f, 0.f, 0.f};
            const bf16_t* Au = (KIND == 2) ? A + (size_t)br * MP * 1024 : A;
            const bf16_t* ap = Au + (size_t)(MMAIN + 16 * rg + r) * K + w * KS + 8 * kq;
            const bf16_t* bp = Bt + (size_t)(br * 2048 + 32 * t + r) * K + w * KS + 8 * kq;
            int k = 0;
            for (; k + 128 <= KS; k += 128) T16_STEP(4, k);
            for (; k < KS; k += 64) T16_STEP(2, k);
            __syncthreads();
#pragma unroll
            for (int j = 0; j < 4; ++j) { red[(w * 8 + j) * 64 + C.lane] = acc0[j]; red[(w * 8 + 4 + j) * 64 + C.lane] = acc1[j]; }
            __syncthreads();
            float s = 0.f;
#pragma unroll
            for (int ww = 0; ww < 8; ++ww) s += red[(ww * 8 + w) * 64 + C.lane];
            const int row = MMAIN + 16 * rg + 4 * kq + (w & 3), c = 32 * t + 16 * (w >> 2) + r;
            if (KIND == 0) { bf16_t* p = Hb + (size_t)row * DM + c; *p = f2bf(bf2f(*p) + s); }
            else { tot += s * sigmoidf_(bf2f(P[(size_t)row * PN + P_GATES + br * 2048 + c])); if (br == NBR - 1) Ob[(size_t)row * DM + c] = f2bf(tot); }
        }
    }
    __syncthreads();
}
#undef T16_STEP
__device__ __forceinline__ void ph_sum3(const Ctx& C) {
    const bf16_t* GT = WSP(bf16_t, WS_RW); bf16_t* MG = WSP(bf16_t, WS_U);
    for (int row = C.wg * 8 + C.wave; row < M; row += C.G * 8) {
        const bf16_t* gp = GT + (size_t)row * 6144;
#pragma unroll
        for (int i = 0; i < 4; ++i) { const int c = (i * 64 + C.lane) * 8; float a[8], b[8], d[8];
            unpack8(*(const u32x4*)(gp + c), a); unpack8(*(const u32x4*)(gp + 2048 + c), b); unpack8(*(const u32x4*)(gp + 4096 + c), d);
#pragma unroll
            for (int e = 0; e < 8; ++e) a[e] = a[e] + b[e] + d[e];
            *(u32x4*)(MG + (size_t)row * DM + c) = pack8(a); }
    }
}

constexpr int NSTEP_LAYER = 13, STEP_FINAL = 1 + DEPTH * NSTEP_LAYER, NSTEPS = STEP_FINAL + 1;
__device__ __forceinline__ Ctx mkctx(const Args& args, LAS unsigned char* lds, int wave_s) {
    Ctx C; GAS unsigned char* wsg = (GAS unsigned char*)args.ws; asm volatile("" : "+s"(wsg)); unsigned char* ws = (unsigned char*)wsg; int wv = wave_s; asm volatile("" : "+s"(wv));
    int lane; asm volatile("v_mbcnt_lo_u32_b32 %0, -1, 0\n\tv_mbcnt_hi_u32_b32 %0, -1, %0" : "=v"(lane));
    C.out = (float*)(GAS float*)args.out; C.ws = ws; C.lds = lds; C.ctl = (unsigned*)(ws + WS_CTL);
    C.tid = wv * 64 + lane; C.lane = lane; C.wave = wv; C.G = gridDim.x; C.wg = blockIdx.x;
    return C;
}
__global__ void __launch_bounds__(512, 2) trunk_fwd(Args args) {
    extern __shared__ __attribute__((aligned(16))) unsigned char lds_raw[];
    LAS unsigned char* lds = (LAS unsigned char*)lds_raw;
    volatile LAS unsigned* misc = (volatile LAS unsigned*)(lds + LDS_MISC);
    if (threadIdx.x < 32) misc[threadIdx.x] = 0u;
    if (threadIdx.x == 0) { volatile LAS unsigned long long* tb = (volatile LAS unsigned long long*)(lds + LDS_INTBL);
#pragma unroll
        for (int i = 0; i < 27; ++i) tb[i] = (unsigned long long)args.in[i]; }
    __syncthreads();
    const int s_lo = args.s_lo, s_hi = args.s_hi;
    const int wave_s = __builtin_amdgcn_readfirstlane(threadIdx.x >> 6);
    unsigned* const barw = (unsigned*)(args.ws + WS_CTL) + CW_BAR + args.bar_idx * XCD_BAR_WORDS;
    XcdBarrier bar; bar.bar = barw; bar.x = 0; bar.st = misc;
    if (s_hi - s_lo > 1) bar = xcd_barrier_post(barw, misc);
#ifndef PMASK
#define PMASK 0xFFFFF
#endif
#define RUN(k, s) (((PMASK >> (k)) & 1) && (s) >= s_lo && (s) < s_hi)
#define SEAM(s) do { if ((s) >= s_lo && (s) + 1 < s_hi) { GAS unsigned* bw_ = (GAS unsigned*)barw; asm volatile("" : "+s"(bw_)); bar.bar = (unsigned*)bw_; int ln_; asm volatile("v_mbcnt_lo_u32_b32 %0, -1, 0\n\tv_mbcnt_hi_u32_b32 %0, -1, %0" : "=v"(ln_)); xcd_barrier(bar, wave_s == 0 && ln_ == 0); } } while (0)
    using namespace pg8;
    if (RUN(14, 0)) { const Ctx C = mkctx(args, lds, wave_s); ph_rope_tables(C); } SEAM(0);
    for (int l = 0; l < DEPTH; ++l) {
        const int sb = 1 + l * NSTEP_LAYER;
        if (RUN(0, sb + 0)) { const Ctx C = mkctx(args, lds, wave_s); ph_conv(C, l); if (l == 0) ph_norm<true>(C); else ph_norm<false>(C); } SEAM(sb + 0);
        if (RUN(1, sb + 1)) { const Ctx C = mkctx(args, lds, wave_s); Gemm g{WSP(bf16_t, WS_U), WSP(bf16_t, WS_WIN), MP, PN, DM, 0, 0}; StaticOrder S; S.init(MP, PN, C.G, C.wg);
            EpiBf16Plain E{WSP(bf16_t, WS_P), PN}; gemm_phase<EpiBf16Plain, StaticOrder, true, true>(lds, g, S, E, C.tid); }
        if (RUN(1, sb + 1)) { const Ctx C = mkctx(args, lds, wave_s); Gemm g{WSP(bf16_t, WS_WVRET), WSP(bf16_t, WS_U), 1024, MP, DM, 0, 0}; StaticOrder S; S.init(1024, MP, C.G, (C.wg + 121) % C.G);
            EpiBf16Plain E{WSP(bf16_t, WS_VTRET), MP}; gemm_phase<EpiBf16Plain, StaticOrder, true, true>(lds, g, S, E, C.tid); }
        if (RUN(1, sb + 1)) { Ctx C = mkctx(args, lds, wave_s);
            int idx = C.wg, cnt = C.G;
            if (C.G == 256) { const bool idle = C.wg >= 117 && !(C.wg >= 135 && C.wg <= 138); idx = idle ? C.wg - 117 - (C.wg > 138 ? 4 : 0) : -1; cnt = 135; }
            if (idx >= 0) { C.wg = idx; C.G = cnt; __syncthreads(); ph_convB(C, l); } }
        SEAM(sb + 1);
        if (RUN(2, sb + 2)) { const Ctx C = mkctx(args, lds, wave_s); ph_prepA(C, l); } SEAM(sb + 2);
        if (RUN(3, sb + 3)) { const Ctx C = mkctx(args, lds, wave_s);
            unsigned char* rw = C.ws + WS_RW;
            { Gemm g{WSP(bf16_t, WS_XL), WSP(bf16_t, WS_WLORA), MP, LORA_N, LORA_K, 0, 0}; StaticOrder S; S.init(MP, LORA_N, C.G, C.wg);
              EpiLora E{(float*)(rw + RW_WDEC), (bf16_t*)(rw + RW_A), (bf16_t*)(rw + RW_A + RW_ARR), inp(C, IN_W0) + l * 1024, inp(C, IN_A0) + l * 1024}; gemm_phase<EpiLora, StaticOrder, true, true>(lds, g, S, E, C.tid); }
        }
        if (RUN(3, sb + 3)) { const Ctx C = mkctx(args, lds, wave_s); Gemm g{WSP(bf16_t, WS_QN), WSP(bf16_t, WS_WUQ), MP, 1536, 512, 0, 0}; StaticOrder S; S.init(MP, 1536, C.G, (C.wg + 140) % C.G);
            EpiBf16Plain E{WSP(bf16_t, WS_Q), 1536}; gemm_phase<EpiBf16Plain, StaticOrder, true, true>(lds, g, S, E, C.tid); }
        if (RUN(3, sb + 3)) { const Ctx C = mkctx(args, lds, wave_s); Gemm g{WSP(bf16_t, WS_KVN), WSP(bf16_t, WS_WUK), MP, 1024, 256, 0, 0}; StaticOrder S; S.init(MP, 1024, C.G, (C.wg + 236) % C.G);
            EpiBf16Plain E{WSP(bf16_t, WS_KNOPE), 1024}; gemm_phase<EpiBf16Plain, StaticOrder, true, true>(lds, g, S, E, C.tid); }
        if (RUN(3, sb + 3)) { const Ctx C = mkctx(args, lds, wave_s); Gemm g{WSP(bf16_t, WS_WUV), WSP(bf16_t, WS_KVN), 1024, MP, 256, 0, 0}; StaticOrder S; S.init(1024, MP, C.G, (C.wg + 232) % C.G);
            EpiBf16Plain E{WSP(bf16_t, WS_VTMLA), MP}; gemm_phase<EpiBf16Plain, StaticOrder, true, true>(lds, g, S, E, C.tid); }
        SEAM(sb + 3);
        if (RUN(5, sb + 5)) { const Ctx C = mkctx(args, lds, wave_s); ph_qrope(C); }
        if (RUN(5, sb + 5)) { const Ctx C = mkctx(args, lds, wave_s); ph_retkv(C); }
        if (RUN(5, sb + 5)) { const Ctx C = mkctx(args, lds, wave_s); ph_rwkvpre(C, l); } SEAM(sb + 5);
        if (RUN(6, sb + 6)) { const Ctx C = mkctx(args, lds, wave_s); ph_mix(C, l); } SEAM(sb + 6);
        if (RUN(7, sb + 7)) { const Ctx C = mkctx(args, lds, wave_s); ph_post(C, l); } SEAM(sb + 7);
        if (RUN(8, sb + 8)) { const Ctx C = mkctx(args, lds, wave_s); Gemm g{WSP(bf16_t, WS_YBR), WSP(bf16_t, WS_WBR), MMAIN, 6144, 1024, 8, (size_t)MP * 1024 * 2}; BranchOrder S; S.base.init(MMAIN, DM, C.G, C.wg);
            EpiGate E{WSP(bf16_t, WS_U), WSP(bf16_t, WS_P)}; gemm_phase<EpiGate, BranchOrder, true, true>(lds, g, S, E, C.tid); }
        if (RUN(8, sb + 8)) { const Ctx C = mkctx(args, lds, wave_s); tail16<2>(C, WSP(bf16_t, WS_YBR), WSP(bf16_t, WS_WBR), 1024, nullptr, WSP(bf16_t, WS_U), WSP(bf16_t, WS_P)); }
        SEAM(sb + 8);
        if (RUN(9, sb + 9)) { const Ctx C = mkctx(args, lds, wave_s); Gemm g{WSP(bf16_t, WS_U), WSP(bf16_t, WS_WOUT), MMAIN, DM, DM, 0, 0}; StaticOrder S; S.init(MMAIN, DM, C.G, C.wg);
            EpiResid E{WSP(bf16_t, WS_H)}; gemm_phase<EpiResid, StaticOrder, true, true>(lds, g, S, E, C.tid); }
        if (RUN(9, sb + 9)) { const Ctx C = mkctx(args, lds, wave_s); tail16<0>(C, WSP(bf16_t, WS_U), WSP(bf16_t, WS_WOUT), DM, WSP(bf16_t, WS_H), nullptr, nullptr); }
        SEAM(sb + 9);
        if (RUN(10, sb + 10)) { const Ctx C = mkctx(args, lds, wave_s); ph_norm<false>(C); } SEAM(sb + 10);
        if (RUN(11, sb + 11)) { const Ctx C = mkctx(args, lds, wave_s); Gemm g{WSP(bf16_t, WS_U), WSP(bf16_t, WS_WGU), MMAIN, 2 * FFN, DM, 0, 0}; StaticOrder S; S.init(MMAIN, 2 * FFN, C.G, C.wg);
            EpiSwiglu E{WSP(bf16_t, WS_P)}; gemm_phase<EpiSwiglu, StaticOrder, true, true>(lds, g, S, E, C.tid); }
        if (RUN(11, sb + 11)) { const Ctx C = mkctx(args, lds, wave_s); tail_units<1>(C, WSP(bf16_t, WS_U), WSP(bf16_t, WS_WGU), DM, FFN / 32, nullptr, WSP(bf16_t, WS_P), nullptr); }
        SEAM(sb + 11);
        if (RUN(12, sb + 12)) { const Ctx C = mkctx(args, lds, wave_s); Gemm g{WSP(bf16_t, WS_P), WSP(bf16_t, WS_WD), MMAIN, DM, FFN, 0, 0}; StaticOrder S; S.init(MMAIN, DM, C.G, C.wg);
            EpiResid E{WSP(bf16_t, WS_H)}; gemm_phase<EpiResid, StaticOrder, true, true>(lds, g, S, E, C.tid); }
        if (RUN(12, sb + 12)) { const Ctx C = mkctx(args, lds, wave_s); tail16<0>(C, WSP(bf16_t, WS_P), WSP(bf16_t, WS_WD), FFN, WSP(bf16_t, WS_H), nullptr, nullptr); }
        SEAM(sb + 12);
    }
    if (RUN(15, STEP_FINAL)) { const Ctx C = mkctx(args, lds, wave_s); ph_final(C); }
#undef RUN
#undef SEAM
}

extern "C" void kernel_launch(void* const* d_in, const int* in_sizes, int n_in, void* d_out, int out_size, void* d_ws, size_t ws_size, hipStream_t stream) {
    static int grid = 0;
    if (grid == 0) {
        if (n_in != 27 || ws_size < WS_END) { fprintf(stderr, "kernel_launch: unexpected n_in %d or ws_size %zu (< %zu)\n", n_in, ws_size, (size_t)WS_END); grid = -1; return; }
        int dev = 0, cus = 0, per_cu = 0;
        if (hipGetDevice(&dev) != hipSuccess || hipDeviceGetAttribute(&cus, hipDeviceAttributeMultiprocessorCount, dev) != hipSuccess) { grid = -1; return; }
        if (hipFuncSetAttribute((const void*)trunk_fwd, hipFuncAttributeMaxDynamicSharedMemorySize, LDS_BYTES) != hipSuccess) { fprintf(stderr, "kernel_launch: hipFuncSetAttribute failed\n"); grid = -1; return; }
        if (hipOccupancyMaxActiveBlocksPerMultiprocessor(&per_cu, (const void*)trunk_fwd, 512, LDS_BYTES) != hipSuccess || per_cu < 1) { fprintf(stderr, "kernel_launch: occupancy query says %d\n", per_cu); }
        (void)hipGetLastError();
        grid = cus;
    }
    if (grid < 0) return;
    (void)hipMemsetAsync((char*)d_ws + WS_CTL, 0, CTL_ZERO_BYTES, stream);
    Args a{};
    for (int i = 0; i < 27; ++i) a.in[i] = (const float*)d_in[i];
    a.out = (float*)d_out; a.ws = (unsigned char*)d_ws; a.pad = 0;
#if N_LAUNCH_MODE == 1
    a.s_lo = 0; a.s_hi = NSTEPS; a.bar_idx = 0;
    hipLaunchKernelGGL(trunk_fwd, dim3(grid), dim3(512), LDS_BYTES, stream, a);
#else
    for (int s = 0; s < NSTEPS; ++s) { a.s_lo = s; a.s_hi = s + 1; a.bar_idx = 0; hipLaunchKernelGGL(trunk_fwd, dim3(grid), dim3(512), LDS_BYTES, stream, a); }
#endif
}
```
